# Optimizing an MI355X kernel written in HIP

```python
import math
import jax, jax.numpy as jnp
from jax import lax
import numpy as np

D_MODEL = 2048
BATCH = 1
SEQ = 8192
DEPTH = 4

CHUNK = 64
N_MIXERS = 2
EXPAND = 2
D_INNER = EXPAND * D_MODEL

GLA_HEADS = 4
GLA_DK = (D_MODEL // 2) // GLA_HEADS
GLA_DV = D_INNER // GLA_HEADS
GLA_QK = GLA_HEADS * GLA_DK
GLA_GATE_RANK = 16
GLA_TAU = 16.0
GLA_IN_WIDTH = 2 * GLA_QK + 2 * D_INNER + GLA_GATE_RANK

S5_GROUP = 16
S5_STATE = 64
S5_GROUPS = D_INNER // S5_GROUP
S5_GROUPS_PER_BLOCK = 16
S5_BLOCKS = S5_GROUPS // S5_GROUPS_PER_BLOCK
S5_DT_MIN = 1e-3
S5_DT_MAX = 1e-1

N_GLA_LAYERS = (DEPTH + 1) // 2
N_S5_LAYERS = DEPTH // 2

DEEPNORM_ALPHA = (2 * DEPTH) ** 0.25
DEEPNORM_BETA = (8 * DEPTH) ** -0.25
LN_EPS = 1e-5
RMS_EPS = 1e-6

kernel_name = "hybrid_gla_s5_deepnorm_adaln"


def layer_norm(x, g, b):
    xf = x.astype(jnp.float32)
    mu = jnp.mean(xf, axis=-1, keepdims=True)
    var = jnp.mean(jnp.square(xf - mu), axis=-1, keepdims=True)
    y = (xf - mu) * lax.rsqrt(var + LN_EPS) * g.astype(jnp.float32) + b.astype(jnp.float32)
    return y.astype(x.dtype)


def gla_mixer(u, w_in, gate_w2, gate_b, norm_g, w_out):
    bsz, seq_len, _ = u.shape
    n_chunks = seq_len // CHUNK
    proj = u @ w_in
    q, k, v, z, g_lr = jnp.split(
        proj, [GLA_QK, 2 * GLA_QK, 2 * GLA_QK + D_INNER, 2 * GLA_QK + 2 * D_INNER], axis=-1)
    log_alpha = jax.nn.log_sigmoid((g_lr @ gate_w2 + gate_b).astype(jnp.float32)) / GLA_TAU

    def to_chunks(t, d):
        return t.astype(jnp.float32).reshape(bsz, n_chunks, CHUNK, GLA_HEADS, d).transpose(1, 0, 3, 2, 4)

    qc = to_chunks(q, GLA_DK) * (GLA_DK ** -0.5)
    kc = to_chunks(k, GLA_DK)
    vc = to_chunks(v, GLA_DV)
    gc = to_chunks(log_alpha, GLA_DK)

    def step(state, inp):
        q_c, k_c, v_c, g_c = inp
        cum = jnp.cumsum(g_c, axis=2)
        tot = cum[:, :, -1:, :]
        k_dec = k_c * jnp.exp(tot - cum)
        state = jnp.exp(tot[:, :, 0, :, None]) * state + jnp.einsum('bhck,bhcv->bhkv', k_dec, v_c)
        o = jnp.einsum('bhck,bhkv->bhcv', q_c, state)
        return state, o

    s0 = jnp.zeros((bsz, GLA_HEADS, GLA_DK, GLA_DV), jnp.float32)
    _, o = lax.scan(step, s0, (qc, kc, vc, gc))
    o = o.transpose(1, 0, 3, 2, 4).reshape(bsz, seq_len, GLA_HEADS, GLA_DV)
    o = o * lax.rsqrt(jnp.mean(jnp.square(o), axis=-1, keepdims=True) + RMS_EPS)
    o = o.reshape(bsz, seq_len, D_INNER) * norm_g.astype(jnp.float32)
    y = o.astype(u.dtype) * jax.nn.silu(z)
    return y @ w_out


def _linear_recurrence_combine(e1, e2):
    a1r, a1i, b1r, b1i = e1
    a2r, a2i, b2r, b2i = e2
    ar = a2r * a1r - a2i * a1i
    ai = a2r * a1i + a2i * a1r
    br = a2r * b1r - a2i * b1i + b2r
    bi = a2r * b1i + a2i * b1r + b2i
    return (ar, ai, br, bi)


def s5_mixer(u_in, w_in, a_re, a_im, log_dt, b_re, b_im, c_re, c_im, d_skip, w_glu, b_glu, w_out):
    bsz, seq_len, _ = u_in.shape
    proj = u_in @ w_in
    u, z = jnp.split(proj, 2, axis=-1)
    f32 = jnp.float32
    a_re = a_re.astype(f32); a_im = a_im.astype(f32)
    b_re = b_re.astype(f32); b_im = b_im.astype(f32)
    dt = jnp.exp(log_dt.astype(f32))[:, None]
    mag = jnp.exp(a_re * dt)
    lb_re = mag * jnp.cos(a_im * dt)
    lb_im = mag * jnp.sin(a_im * dt)
    nr = lb_re - 1.0
    den = jnp.square(a_re) + jnp.square(a_im)
    coef_re = (nr * a_re + lb_im * a_im) / den
    coef_im = (lb_im * a_re - nr * a_im) / den
    bb_re = coef_re[..., None] * b_re - coef_im[..., None] * b_im
    bb_im = coef_re[..., None] * b_im + coef_im[..., None] * b_re

    uf = u.astype(f32)
    u_blocks = uf.reshape(bsz, seq_len, S5_BLOCKS, S5_GROUPS_PER_BLOCK, S5_GROUP).transpose(2, 0, 1, 3, 4)

    def blk(args):
        u_b, lr_b, li_b, br_b, bi_b, cr_b, ci_b = args
        bu_r = jnp.einsum('blgi,gpi->blgp', u_b, br_b)
        bu_i = jnp.einsum('blgi,gpi->blgp', u_b, bi_b)
        a_r = jnp.broadcast_to(lr_b, bu_r.shape)
        a_i = jnp.broadcast_to(li_b, bu_i.shape)
        _, _, x_r, x_i = lax.associative_scan(_linear_recurrence_combine, (a_r, a_i, bu_r, bu_i), axis=1)
        return jnp.einsum('blgp,gip->blgi', x_r, cr_b) - jnp.einsum('blgp,gip->blgi', x_i, ci_b)

    nb, gpb = S5_BLOCKS, S5_GROUPS_PER_BLOCK
    y = lax.map(blk, (
        u_blocks,
        lb_re.reshape(nb, gpb, S5_STATE), lb_im.reshape(nb, gpb, S5_STATE),
        bb_re.reshape(nb, gpb, S5_STATE, S5_GROUP), bb_im.reshape(nb, gpb, S5_STATE, S5_GROUP),
        c_re.astype(f32).reshape(nb, gpb, S5_GROUP, S5_STATE),
        c_im.astype(f32).reshape(nb, gpb, S5_GROUP, S5_STATE)))
    y = y.transpose(1, 2, 0, 3, 4).reshape(bsz, seq_len, D_INNER) + d_skip.astype(f32) * uf
    y = jax.nn.gelu(y)
    y = y * jax.nn.sigmoid(y @ w_glu.astype(f32) + b_glu.astype(f32))
    y = y.astype(u_in.dtype) * jax.nn.silu(z)
    return y @ w_out


def setup_inputs(seed: int = 0) -> dict:
    key = jax.random.key(seed)
    ks = jax.random.split(key, 24)
    nrm = jax.random.normal
    d, e = D_MODEL, D_INNER
    x = nrm(ks[0], (BATCH, SEQ, d), jnp.float32)
    c = nrm(ks[1], (BATCH, d), jnp.float32)
    ln_g = 1.0 + 0.01 * nrm(ks[2], (DEPTH, d), jnp.float32)
    ln_b = 0.01 * nrm(ks[3], (DEPTH, d), jnp.float32)
    ada_w = 0.2 * d ** -0.5 * nrm(ks[4], (DEPTH, d, 3 * d), jnp.float32)
    ada_b = 0.01 * nrm(ks[5], (DEPTH, 3 * d), jnp.float32)
    gla_w_in = d ** -0.5 * nrm(ks[6], (N_GLA_LAYERS, d, GLA_IN_WIDTH), jnp.float32)
    gla_gate_w2 = GLA_GATE_RANK ** -0.5 * nrm(ks[7], (N_GLA_LAYERS, GLA_GATE_RANK, GLA_QK), jnp.float32)
    gla_gate_b = 0.01 * nrm(ks[8], (N_GLA_LAYERS, GLA_QK), jnp.float32)
    gla_norm_g = 1.0 + 0.01 * nrm(ks[9], (N_GLA_LAYERS, e), jnp.float32)
    gla_w_out = DEEPNORM_BETA * e ** -0.5 * nrm(ks[10], (N_GLA_LAYERS, e, d), jnp.float32)
    s5_w_in = d ** -0.5 * nrm(ks[11], (N_S5_LAYERS, d, 2 * e), jnp.float32)
    s5_a_re = -0.5 + 0.01 * nrm(ks[12], (N_S5_LAYERS, S5_GROUPS, S5_STATE), jnp.float32)
    s5_a_im = jnp.broadcast_to(jnp.pi * jnp.arange(S5_STATE, dtype=jnp.float32),
                               (N_S5_LAYERS, S5_GROUPS, S5_STATE))
    s5_log_dt = jax.random.uniform(ks[13], (N_S5_LAYERS, S5_GROUPS), jnp.float32,
                                   math.log(S5_DT_MIN), math.log(S5_DT_MAX))
    bscale = (2 * S5_GROUP) ** -0.5
    s5_b_re = bscale * nrm(ks[14], (N_S5_LAYERS, S5_GROUPS, S5_STATE, S5_GROUP), jnp.float32)
    s5_b_im = bscale * nrm(ks[15], (N_S5_LAYERS, S5_GROUPS, S5_STATE, S5_GROUP), jnp.float32)
    cscale = S5_STATE ** -0.5
    s5_c_re = cscale * nrm(ks[16], (N_S5_LAYERS, S5_GROUPS, S5_GROUP, S5_STATE), jnp.float32)
    s5_c_im = cscale * nrm(ks[17], (N_S5_LAYERS, S5_GROUPS, S5_GROUP, S5_STATE), jnp.float32)
    s5_d = nrm(ks[18], (N_S5_LAYERS, e), jnp.float32)
    s5_w_glu = e ** -0.5 * nrm(ks[19], (N_S5_LAYERS, e, e), jnp.float32)
    s5_b_glu = 0.01 * nrm(ks[20], (N_S5_LAYERS, e), jnp.float32)
    s5_w_out = DEEPNORM_BETA * e ** -0.5 * nrm(ks[21], (N_S5_LAYERS, e, d), jnp.float32)
    return {"x": x, "c": c, "ln_g": ln_g, "ln_b": ln_b, "ada_w": ada_w, "ada_b": ada_b,
            "gla_w_in": gla_w_in, "gla_gate_w2": gla_gate_w2, "gla_gate_b": gla_gate_b,
            "gla_norm_g": gla_norm_g, "gla_w_out": gla_w_out,
            "s5_w_in": s5_w_in, "s5_a_re": s5_a_re, "s5_a_im": s5_a_im, "s5_log_dt": s5_log_dt,
            "s5_b_re": s5_b_re, "s5_b_im": s5_b_im, "s5_c_re": s5_c_re, "s5_c_im": s5_c_im,
            "s5_d": s5_d, "s5_w_glu": s5_w_glu, "s5_b_glu": s5_b_glu, "s5_w_out": s5_w_out}


def reference(x, c, ln_g, ln_b, ada_w, ada_b, gla_w_in, gla_gate_w2, gla_gate_b, gla_norm_g, gla_w_out,
              s5_w_in, s5_a_re, s5_a_im, s5_log_dt, s5_b_re, s5_b_im, s5_c_re, s5_c_im, s5_d,
              s5_w_glu, s5_b_glu, s5_w_out):
    mod = jnp.einsum('bd,lde->lbe', jax.nn.silu(c), ada_w) + ada_b[:, None, :]
    for i in range(DEPTH):
        shift, scale, gate = jnp.split(mod[i], 3, axis=-1)
        u = x * (1.0 + scale[:, None, :]) + shift[:, None, :]
        j = i // N_MIXERS
        if i % N_MIXERS == 0:
            h = gla_mixer(u, gla_w_in[j], gla_gate_w2[j], gla_gate_b[j], gla_norm_g[j], gla_w_out[j])
        else:
            h = s5_mixer(u, s5_w_in[j], s5_a_re[j], s5_a_im[j], s5_log_dt[j], s5_b_re[j], s5_b_im[j],
                         s5_c_re[j], s5_c_im[j], s5_d[j], s5_w_glu[j], s5_b_glu[j], s5_w_out[j])
        x = layer_norm(DEEPNORM_ALPHA * x + (1.0 + gate[:, None, :]) * h, ln_g[i], ln_b[i])
    return x
```

```cpp
#include <hip/hip_runtime.h>
#include <hip/hip_cooperative_groups.h>
#include <cstdio>
namespace cg = cooperative_groups;

#define LAS __attribute__((address_space(3)))
typedef unsigned short bf16_t;
typedef short bf16x8 __attribute__((ext_vector_type(8)));
typedef short s16x4 __attribute__((ext_vector_type(4)));
typedef float f32x4 __attribute__((ext_vector_type(4)));
typedef float f32x2 __attribute__((ext_vector_type(2)));
typedef unsigned u32x4 __attribute__((ext_vector_type(4)));
typedef unsigned u32x2 __attribute__((ext_vector_type(2)));

constexpr int SEQ = 8192, DM = 2048, DI = 4096, NQK = 1024;
constexpr int GLA_W = 10256;
constexpr float DN_ALPHA = 1.6817928305074290f;
constexpr int NPH = 28;
constexpr int NT = 512;
constexpr int LDS_BYTES = 131072;

constexpr size_t WS_WG   = 0;
constexpr size_t WS_WGO  = WS_WG   + 83886080;
constexpr size_t WS_WSI  = WS_WGO  + 33554432;
constexpr size_t WS_WGLU = WS_WSI  + 67108864;
constexpr size_t WS_WSO  = WS_WGLU + 67108864;
constexpr size_t WS_MG   = WS_WSO  + 33554432;
constexpr size_t WS_WE   = WS_MG   + 50331648;
constexpr size_t WS_LAMT = WS_WE   + 16777216;
constexpr size_t WS_WGT  = WS_LAMT + 131072;
constexpr size_t WS_MODP = WS_WGT  + 262144;
constexpr size_t WS_MOD  = WS_MODP + 6291456;
constexpr size_t WS_X    = WS_MOD  + 98304;
constexpr size_t WS_U    = WS_X    + 67108864;
constexpr size_t WS_ACT  = WS_U    + 33554432;
constexpr size_t ACT_UCAT = 0;
constexpr size_t ACT_QS   = 0;
constexpr size_t ACT_KT   = 16777216;
constexpr size_t ACT_GLR  = 33554432;
constexpr size_t ACT_ETOT = 34078720;
constexpr size_t ACT_SSQ  = 34603008;
constexpr size_t ACT_ZS   = 100663296;
constexpr size_t ACT_E    = 167772160;
constexpr size_t ACT_YB   = 234881024;
constexpr size_t ACT_Y2   = 301989888;
constexpr size_t ACT_END  = 369098752;
constexpr size_t WS_END   = WS_ACT + ACT_END;

struct Params {
    const float *x, *c, *ln_g, *ln_b, *ada_w, *ada_b, *gla_w_in, *gla_gate_w2, *gla_gate_b, *gla_norm_g, *gla_w_out,
        *s5_w_in, *s5_a_re, *s5_a_im, *s5_log_dt, *s5_b_re, *s5_b_im, *s5_c_re, *s5_c_im, *s5_d, *s5_w_glu, *s5_b_glu, *s5_w_out;
    float* out; unsigned char* ws; int ph_lo, ph_hi, coop, pad;
};

typedef const __attribute__((address_space(4))) Params* KP;
struct Ctx { int tid, bid, G; };

typedef __bf16 bf16v2_t __attribute__((ext_vector_type(2)));
__device__ __forceinline__ unsigned pk2(float lo, float hi) { const f32x2 v = {lo, hi}; return __builtin_bit_cast(unsigned, __builtin_convertvector(v, bf16v2_t)); }
__device__ __forceinline__ float bflo(unsigned u) { return __uint_as_float(u << 16); }
__device__ __forceinline__ float bfhi(unsigned u) { return __uint_as_float(u & 0xffff0000u); }
__device__ __forceinline__ float sigmoidf_(float x) { return 1.0f / (1.0f + __expf(-x)); }
__device__ __forceinline__ float siluf_(float x) { return x / (1.0f + __expf(-x)); }
__device__ __forceinline__ float gelu_tanh(float y) { const float a = 1.5957691216057308f * (y + 0.044715f * y * y * y); return y / (1.0f + __expf(-a)); }
__device__ __forceinline__ float wave_sum(float v) {
    v += __shfl_xor(v, 32); v += __shfl_xor(v, 16); v += __shfl_xor(v, 8); v += __shfl_xor(v, 4); v += __shfl_xor(v, 2); v += __shfl_xor(v, 1); return v;
}

namespace pg8 {
constexpr int BM = 256, BK = 64, HALF = 128, HTB = HALF * BK * 2, STAGE_BYTES = 8 * HTB, NXCD = 8, WGM = 8;
__device__ __forceinline__ int lds_byte(int r, int c) { const int st = (r >> 4) * 2 + (c >> 5), rr = r & 15, cc = c & 31, ob = rr * 64 + cc * 2; return st * 1024 + (ob ^ (((ob >> 9) & 1) << 5)); }
__device__ __forceinline__ void stage_rc(int b, int& R, int& C) { const int st = b / 1024, sb = b % 1024, swz = sb ^ (((sb >> 9) & 1) << 5); R = (st >> 1) * 16 + swz / 64; C = (st & 1) * 32 + (swz % 64) / 2; }
__device__ __forceinline__ int perm32(int rho) { const int n = rho >> 4, i = rho & 15; return 8 * (i >> 2) + 4 * n + (i & 3); }

struct Unit { const char* a; const char* b; int pm, pn, kind, aux; };

__device__ __forceinline__ void tile_map(int wgid, int nM, int nN, int& pm, int& pn) {
    const int nwg = nM * nN;
    { const int q = nwg / NXCD, r = nwg % NXCD, xcd = wgid % NXCD, off = wgid / NXCD; wgid = (xcd < r ? xcd * (q + 1) : r * (q + 1) + (xcd - r) * q) + off; }
    const int nig = WGM * nN, gid = wgid / nig, fm = gid * WGM, gsz = (nM - fm) < WGM ? (nM - fm) : WGM;
    pm = fm + ((wgid % nig) % gsz); pn = (wgid % nig) / gsz;
}

template <class Epi, class Sched>
__device__ __forceinline__ void gemm_phase(const Ctx cx, LAS unsigned char* lds, const int K, const int lda, const int ldb, const int hsB, const Sched& S, const Epi& E) {
    const int tid = cx.tid, wid = __builtin_amdgcn_readfirstlane(tid >> 6), lane = tid & 63, wr = wid >> 2, wc = wid & 3, fr = lane & 15, fq = lane >> 4;
    const int nt = K / BK;
    unsigned voffA[2], voffB[2];
#pragma unroll
    for (int i = 0; i < 2; ++i) { int R, C; stage_rc(tid * 16 + i * 8192, R, C); const int Rb = Epi::PERM ? ((R & ~31) + perm32(R & 31)) : R;
        voffA[i] = (unsigned)(R * lda + C) * 2u; voffB[i] = (unsigned)(Rb * ldb + C) * 2u; }
    const size_t kstep = (size_t)(BK * 2);
    const size_t hstepA = (size_t)HALF * lda * 2;
    const size_t hstepB = hsB ? (size_t)HALF * ldb * 2 : 0;
    const unsigned ldsw = (unsigned)wid * 1024u;
    const int aoff = lds_byte(wr * 64 + fr, fq * 8), boff = lds_byte(wc * 32 + fr, fq * 8);
#define PG8_SA(b, h) (((b) * 2 + (h)) * HTB)
#define PG8_SB(b, h) ((4 + (b) * 2 + (h)) * HTB)
#define PG8_STAGE(bufoff, gbase, voff) do { _Pragma("unroll") for (int _i = 0; _i < 2; ++_i) \
        __builtin_amdgcn_global_load_lds((const unsigned*)((const char*)(gbase) + (voff)[_i]), (LAS unsigned*)(lds + (bufoff) + ldsw + _i * 8192), 16, 0, 0); } while (0)
#define PG8_LDA(dst, b, h) do { _Pragma("unroll") for (int m = 0; m < 4; ++m) _Pragma("unroll") for (int k = 0; k < 2; ++k) dst[m][k] = *(const LAS bf16x8*)(lds + PG8_SA(b, h) + aoff + m * 2048 + k * 1024); } while (0)
#define PG8_LDB(dst, b, h) do { _Pragma("unroll") for (int n = 0; n < 2; ++n) _Pragma("unroll") for (int k = 0; k < 2; ++k) dst[n][k] = *(const LAS bf16x8*)(lds + PG8_SB(b, h) + boff + n * 2048 + k * 1024); } while (0)
#define PG8_MMA(ai, bj, At, Bt) do { __builtin_amdgcn_s_setprio(1); _Pragma("unroll") for (int m = 0; m < 4; ++m) _Pragma("unroll") for (int n = 0; n < 2; ++n) _Pragma("unroll") for (int k = 0; k < 2; ++k) \
        acc[ai][bj][m][n] = __builtin_amdgcn_mfma_f32_16x16x32_bf16(Bt[n][k], At[m][k], acc[ai][bj][m][n], 0, 0, 0); __builtin_amdgcn_s_setprio(0); } while (0)
#define PG8_WAIT_V(n) asm volatile("s_waitcnt vmcnt(" #n ")" ::: "memory")
#define PG8_WAIT_L(n) asm volatile("s_waitcnt lgkmcnt(" #n ")" ::: "memory")
#define PG8_BAR __builtin_amdgcn_s_barrier()
#define PG8_SCHED __builtin_amdgcn_sched_barrier(0)
    Unit cur, nxt; int ui = 0;
    if (!S.next(0, cur)) return;
    f32x4 acc[2][2][4][2];
#pragma unroll
    for (int a = 0; a < 2; ++a)
#pragma unroll
        for (int b = 0; b < 2; ++b)
#pragma unroll
            for (int m = 0; m < 4; ++m)
#pragma unroll
                for (int n = 0; n < 2; ++n) acc[a][b][m][n] = (f32x4){0.f, 0.f, 0.f, 0.f};
    bf16x8 At[4][2], B0[2][2], B1[2][2];
    const char* cA = cur.a; const char* cB = cur.b;
    PG8_STAGE(PG8_SB(0, 0), cB, voffB); PG8_STAGE(PG8_SA(0, 0), cA, voffA); PG8_STAGE(PG8_SB(0, 1), cB + hstepB, voffB); PG8_STAGE(PG8_SA(0, 1), cA + hstepA, voffA);
    if (wr == 1) PG8_BAR;
    PG8_WAIT_V(4); PG8_BAR;
    PG8_STAGE(PG8_SB(1, 0), cB + kstep, voffB); PG8_STAGE(PG8_SA(1, 0), cA + kstep, voffA); PG8_STAGE(PG8_SB(1, 1), cB + hstepB + kstep, voffB);
    PG8_WAIT_V(6); PG8_BAR;
    for (;;) {
        const bool has_next = S.next(ui + 1, nxt);
        const char* nA = has_next ? nxt.a : cA; const char* nB = has_next ? nxt.b : cB;
#pragma nounroll
        for (int t = 0; t < nt; t += 2) {
            const bool last = (t == nt - 2);
            const char* a1 = cA + (size_t)(t + 1) * kstep;
            const char* a2 = last ? nA : cA + (size_t)(t + 2) * kstep; const char* b2 = last ? nB : cB + (size_t)(t + 2) * kstep;
            const char* a3 = a2 + kstep; const char* b3 = b2 + kstep;
            PG8_LDB(B0, 0, 0); PG8_SCHED; PG8_LDA(At, 0, 0); PG8_STAGE(PG8_SA(1, 1), a1 + hstepA, voffA);
            PG8_WAIT_L(8); PG8_BAR; PG8_WAIT_L(0); PG8_MMA(0, 0, At, B0); PG8_BAR; PG8_SCHED;
            PG8_LDB(B1, 0, 1); PG8_STAGE(PG8_SB(0, 0), b2, voffB);
            PG8_BAR; PG8_WAIT_L(0); PG8_MMA(0, 1, At, B1); PG8_BAR;
            PG8_LDA(At, 0, 1); PG8_STAGE(PG8_SA(0, 0), a2, voffA);
            PG8_BAR; PG8_WAIT_L(0); PG8_MMA(1, 0, At, B0); PG8_BAR; PG8_SCHED;
            PG8_STAGE(PG8_SB(0, 1), b2 + hstepB, voffB);
            PG8_WAIT_V(6); PG8_BAR; PG8_MMA(1, 1, At, B1); PG8_BAR;
            PG8_LDB(B0, 1, 0); PG8_SCHED; PG8_LDA(At, 1, 0); PG8_STAGE(PG8_SA(0, 1), a2 + hstepA, voffA);
            PG8_WAIT_L(8); PG8_BAR; PG8_WAIT_L(0); PG8_MMA(0, 0, At, B0); PG8_BAR; PG8_SCHED;
            PG8_LDB(B1, 1, 1); PG8_STAGE(PG8_SB(1, 0), b3, voffB);
            PG8_BAR; PG8_WAIT_L(0); PG8_MMA(0, 1, At, B1); PG8_BAR;
            PG8_LDA(At, 1, 1); PG8_STAGE(PG8_SA(1, 0), a3, voffA);
            PG8_BAR; PG8_WAIT_L(0); PG8_MMA(1, 0, At, B0); PG8_BAR; PG8_SCHED;
            PG8_STAGE(PG8_SB(1, 1), b3 + hstepB, voffB);
            PG8_WAIT_V(6); PG8_BAR; PG8_MMA(1, 1, At, B1); PG8_BAR;
        }
        E(acc, cur, wr, wc, fr, fq);
        if (!has_next) break;
#pragma unroll
        for (int a = 0; a < 2; ++a)
#pragma unroll
            for (int b = 0; b < 2; ++b)
#pragma unroll
                for (int m = 0; m < 4; ++m)
#pragma unroll
                    for (int n = 0; n < 2; ++n) acc[a][b][m][n] = (f32x4){0.f, 0.f, 0.f, 0.f};
        cur = nxt; cA = nA; cB = nB; ++ui;
    }
    PG8_WAIT_V(0);
    if (wr == 0) PG8_BAR;
    PG8_BAR;
#undef PG8_SA
#undef PG8_SB
#undef PG8_STAGE
#undef PG8_LDA
#undef PG8_LDB
#undef PG8_MMA
#undef PG8_WAIT_V
#undef PG8_WAIT_L
#undef PG8_BAR
#undef PG8_SCHED
}
}
using pg8::Unit;
typedef f32x4 Acc[2][2][4][2];

struct SchedPlain {
    const char* A; const char* B; int nM, nN, G, c; size_t ta, tb;
    __device__ __forceinline__ bool next(int i, Unit& u) const {
        const int L = i * G + c; if (L >= nM * nN) return false;
        int pm, pn; pg8::tile_map(L, nM, nN, pm, pn);
        u.pm = pm; u.pn = pn; u.kind = 0; u.aux = 0; u.a = A + (size_t)pm * ta; u.b = B + (size_t)pn * tb; return true;
    }
};
struct SchedGlaIn {
    const char* U; const char* W; int G, c;
    __device__ __forceinline__ bool next(int i, Unit& u) const {
        int L = i * G + c; if (L >= 1280) return false;
        const size_t tstep = (size_t)256 * DM * 2;
        int pm, pn;
        if (L < 640) { pg8::tile_map(L, 32, 20, pm, pn); u.kind = 0; u.a = U + (size_t)pm * tstep; u.b = W + (size_t)pn * tstep; }
        else { pg8::tile_map(L - 640, 20, 32, pm, pn); u.kind = 1; u.a = W + (size_t)(20 + pm) * tstep; u.b = U + (size_t)pn * tstep; }
        u.pm = pm; u.pn = pn; u.aux = 0; return true;
    }
};
struct SchedGroup {
    const char* A; const char* B; size_t ga, gb, ta; int G, c;
    __device__ __forceinline__ bool next(int i, Unit& u) const {
        const int L = i * G + c; if (L >= 512) return false;
        const int g = L >> 1, pm = L & 1;
        u.pm = pm; u.pn = 0; u.kind = 0; u.aux = g; u.a = A + (size_t)g * ga + (size_t)pm * ta; u.b = B + (size_t)g * gb; return true;
    }
};

struct EpiGlaIn {
    static constexpr bool PERM = true;
    bf16_t *QS, *ZS, *KT, *VT;
    __device__ __forceinline__ void operator()(const Acc& acc, const Unit& u, int wr, int wc, int fr, int fq) const {
        const int row0 = u.pm * 256 + wr * 64 + fr, col0 = u.pn * 256 + wc * 32 + 8 * fq;
        bf16_t* base; int ld, rofs = 0, cofs = 0, mode;
        if (u.kind == 0) { if (u.pn < 4) { base = QS; ld = NQK; mode = 1; } else { base = ZS; ld = DI; cofs = -NQK; mode = 2; } }
        else { mode = 0; ld = SEQ; if (u.pm < 4) { base = KT; } else { base = VT; rofs = -NQK; } }
#pragma unroll
        for (int ai = 0; ai < 2; ++ai)
#pragma unroll
            for (int m = 0; m < 4; ++m) {
                bf16_t* rowp = base + (size_t)(row0 + rofs + ai * 128 + m * 16) * ld + col0 + cofs;
#pragma unroll
                for (int bj = 0; bj < 2; ++bj) {
                    f32x4 v0 = acc[ai][bj][m][0], v1 = acc[ai][bj][m][1];
                    if (mode == 1) { v0 *= 0.0625f; v1 *= 0.0625f; }
                    if (mode == 2) {
#pragma unroll
                        for (int j = 0; j < 4; ++j) { v0[j] = siluf_(v0[j]); v1[j] = siluf_(v1[j]); } }
                    u32x4 w; w.x = pk2(v0[0], v0[1]); w.y = pk2(v0[2], v0[3]); w.z = pk2(v1[0], v1[1]); w.w = pk2(v1[2], v1[3]);
                    *(u32x4*)(rowp + bj * 128) = w; } }
    }
};
struct EpiS5In {
    static constexpr bool PERM = true;
    bf16_t *UC, *ZS;
    __device__ __forceinline__ void operator()(const Acc& acc, const Unit& u, int wr, int wc, int fr, int fq) const {
        const int row0 = u.pm * 256 + wr * 64 + fr, col0 = u.pn * 256 + wc * 32 + 8 * fq;
        const bool isz = u.pn >= 16;
#pragma unroll
        for (int ai = 0; ai < 2; ++ai)
#pragma unroll
            for (int m = 0; m < 4; ++m) {
                const int t = row0 + ai * 128 + m * 16;
#pragma unroll
                for (int bj = 0; bj < 2; ++bj) {
                    f32x4 v0 = acc[ai][bj][m][0], v1 = acc[ai][bj][m][1];
                    const int c = col0 + bj * 128;
                    bf16_t* dst;
                    if (isz) {
#pragma unroll
                        for (int j = 0; j < 4; ++j) { v0[j] = siluf_(v0[j]); v1[j] = siluf_(v1[j]); }
                        dst = ZS + (size_t)t * DI + (c - DI);
                    } else { const int g = c >> 4, i0 = c & 15; dst = UC + ((size_t)g * 512 + (t >> 4)) * 384 + (t & 15) * 16 + i0; }
                    u32x4 w; w.x = pk2(v0[0], v0[1]); w.y = pk2(v0[2], v0[3]); w.z = pk2(v1[0], v1[1]); w.w = pk2(v1[2], v1[3]);
                    *(u32x4*)dst = w; } }
    }
};
struct EpiS5E {
    static constexpr bool PERM = false;
    float* E;
    __device__ __forceinline__ void operator()(const Acc& acc, const Unit& u, int wr, int wc, int fr, int fq) const {
        const int row0 = u.pm * 256 + wr * 64 + fr, col0 = wc * 32 + 4 * fq;
#pragma unroll
        for (int ai = 0; ai < 2; ++ai)
#pragma unroll
            for (int m = 0; m < 4; ++m) {
                float* rowp = E + ((size_t)u.aux * 512 + row0 + ai * 128 + m * 16) * 128 + col0;
#pragma unroll
                for (int n = 0; n < 2; ++n) *(f32x4*)(rowp + n * 16) = acc[ai][0][m][n]; }
    }
};
struct EpiS5Y {
    static constexpr bool PERM = true;
    const bf16_t* UC; bf16_t* YB; const float* dsk;
    __device__ __forceinline__ void operator()(const Acc& acc, const Unit& u, int wr, int wc, int fr, int fq) const {
        const int g = u.aux; const int row0 = u.pm * 256 + wr * 64 + fr, col0 = wc * 32 + 8 * fq;
#pragma unroll
        for (int bj = 0; bj < 2; ++bj) {
            const int n = col0 + bj * 128; const int tt = n >> 4, o0 = n & 15; const int ch = g * 16 + o0;
            const f32x4 d0 = *(const f32x4*)(dsk + ch), d1 = *(const f32x4*)(dsk + ch + 4);
#pragma unroll
            for (int ai = 0; ai < 2; ++ai)
#pragma unroll
                for (int m = 0; m < 4; ++m) {
                    const int c = row0 + ai * 128 + m * 16;
                    const u32x4 uu = *(const u32x4*)(UC + ((size_t)g * 512 + c) * 384 + n);
                    f32x4 v0 = acc[ai][bj][m][0], v1 = acc[ai][bj][m][1];
                    v0[0] += d0[0] * bflo(uu.x); v0[1] += d0[1] * bfhi(uu.x); v0[2] += d0[2] * bflo(uu.y); v0[3] += d0[3] * bfhi(uu.y);
                    v1[0] += d1[0] * bflo(uu.z); v1[1] += d1[1] * bfhi(uu.z); v1[2] += d1[2] * bflo(uu.w); v1[3] += d1[3] * bfhi(uu.w);
#pragma unroll
                    for (int j = 0; j < 4; ++j) { v0[j] = gelu_tanh(v0[j]); v1[j] = gelu_tanh(v1[j]); }
                    u32x4 w; w.x = pk2(v0[0], v0[1]); w.y = pk2(v0[2], v0[3]); w.z = pk2(v1[0], v1[1]); w.w = pk2(v1[2], v1[3]);
                    *(u32x4*)(YB + (size_t)(c * 16 + tt) * DI + ch) = w; } }
    }
};
struct EpiGlu {
    static constexpr bool PERM = true;
    const bf16_t *YB, *ZS; bf16_t* Y2; const float* bg;
    __device__ __forceinline__ void operator()(const Acc& acc, const Unit& u, int wr, int wc, int fr, int fq) const {
        const int row0 = u.pm * 256 + wr * 64 + fr, col0 = u.pn * 256 + wc * 32 + 8 * fq;
#pragma unroll
        for (int bj = 0; bj < 2; ++bj) {
            const int c = col0 + bj * 128;
            const f32x4 b0 = *(const f32x4*)(bg + c), b1 = *(const f32x4*)(bg + c + 4);
#pragma unroll
            for (int ai = 0; ai < 2; ++ai)
#pragma unroll
                for (int m = 0; m < 4; ++m) {
                    const size_t off = (size_t)(row0 + ai * 128 + m * 16) * DI + c;
                    const u32x4 yy = *(const u32x4*)(YB + off), zz = *(const u32x4*)(ZS + off);
                    f32x4 v0 = acc[ai][bj][m][0] + b0, v1 = acc[ai][bj][m][1] + b1;
                    v0[0] = bflo(yy.x) * bflo(zz.x) * sigmoidf_(v0[0]); v0[1] = bfhi(yy.x) * bfhi(zz.x) * sigmoidf_(v0[1]);
                    v0[2] = bflo(yy.y) * bflo(zz.y) * sigmoidf_(v0[2]); v0[3] = bfhi(yy.y) * bfhi(zz.y) * sigmoidf_(v0[3]);
                    v1[0] = bflo(yy.z) * bflo(zz.z) * sigmoidf_(v1[0]); v1[1] = bfhi(yy.z) * bfhi(zz.z) * sigmoidf_(v1[1]);
                    v1[2] = bflo(yy.w) * bflo(zz.w) * sigmoidf_(v1[2]); v1[3] = bfhi(yy.w) * bfhi(zz.w) * sigmoidf_(v1[3]);
                    u32x4 w; w.x = pk2(v0[0], v0[1]); w.y = pk2(v0[2], v0[3]); w.z = pk2(v1[0], v1[1]); w.w = pk2(v1[2], v1[3]);
                    *(u32x4*)(Y2 + off) = w; } }
    }
};
struct EpiOut {
    static constexpr bool PERM = false;
    const float* X; float* R; const float* gate;
    __device__ __forceinline__ void operator()(const Acc& acc, const Unit& u, int wr, int wc, int fr, int fq) const {
        const int row0 = u.pm * 256 + wr * 64 + fr, col0 = u.pn * 256 + wc * 32 + 4 * fq;
        f32x4 gv[2][2];
#pragma unroll
        for (int bj = 0; bj < 2; ++bj)
#pragma unroll
            for (int n = 0; n < 2; ++n) gv[bj][n] = *(const f32x4*)(gate + col0 + bj * 128 + n * 16) + 1.0f;
#pragma unroll
        for (int ai = 0; ai < 2; ++ai)
#pragma unroll
            for (int m = 0; m < 4; ++m) {
                const size_t off = (size_t)(row0 + ai * 128 + m * 16) * DM + col0;
#pragma unroll
                for (int bj = 0; bj < 2; ++bj)
#pragma unroll
                    for (int n = 0; n < 2; ++n) {
                        const f32x4 xv = *(const f32x4*)(X + off + bj * 128 + n * 16);
                        *(f32x4*)(R + off + bj * 128 + n * 16) = xv * DN_ALPHA + gv[bj][n] * acc[ai][bj][m][n]; } }
    }
};

__device__ __forceinline__ void conv_job(const Ctx cx, LAS unsigned char* lds, const float* src, const int K, const int sstride, const int col0, const int ncols, bf16_t* dst, const int ldd) {
    const int tid = cx.tid, G = cx.G;
    const int ntn = ncols >> 7, ntiles = ntn * (K >> 6);
    LAS unsigned* T = (LAS unsigned*)lds;
    const int c4 = tid & 31, rp = tid >> 5;
    f32x4 v[4];
    int t = cx.bid;
#define CONV_LOAD(tile) do { const int tk_ = (tile) / ntn, tn_ = (tile) % ntn; \
        const float* s_ = src + (size_t)(tk_ * 64 + 2 * rp) * sstride + col0 + tn_ * 128 + 4 * c4; \
        v[0] = *(const f32x4*)s_; v[1] = *(const f32x4*)(s_ + sstride); v[2] = *(const f32x4*)(s_ + (size_t)32 * sstride); v[3] = *(const f32x4*)(s_ + (size_t)33 * sstride); } while (0)
    if (t < ntiles) CONV_LOAD(t);
    for (; t < ntiles; t += G) {
#pragma unroll
        for (int j = 0; j < 4; ++j) { T[(4 * c4 + j) * 33 + rp] = pk2(v[0][j], v[1][j]); T[(4 * c4 + j) * 33 + rp + 16] = pk2(v[2][j], v[3][j]); }
        const int tn2 = t + G; if (tn2 < ntiles) CONV_LOAD(tn2);
        __syncthreads();
        { const int tk = t / ntn, tn = t % ntn; const int n = tid >> 2, qq = tid & 3;
          u32x4 w0, w1; const LAS unsigned* tp = T + n * 33 + 8 * qq;
          w0.x = tp[0]; w0.y = tp[1]; w0.z = tp[2]; w0.w = tp[3]; w1.x = tp[4]; w1.y = tp[5]; w1.z = tp[6]; w1.w = tp[7];
          bf16_t* d = dst + (size_t)(tn * 128 + n) * ldd + tk * 64 + 16 * qq;
          *(u32x4*)d = w0; *(u32x4*)(d + 8) = w1; }
        __syncthreads();
    }
#undef CONV_LOAD
}

__device__ __forceinline__ void s5_tables(const Ctx cx, KP p, LAS unsigned char* lds, const int j) {
    const int tid = cx.tid;
    LAS float* LP = (LAS float*)lds;
    LAS float* BB = LP + 17 * 64 * 2;
    LAS float* CC = BB + 2048;
    LAS float* KT = CC + 2048;
    LAS float* CF = KT + 4096;
    bf16_t* MG = (bf16_t*)(p->ws + WS_MG); bf16_t* WE = (bf16_t*)(p->ws + WS_WE); float* LT = (float*)(p->ws + WS_LAMT);
    for (int g = cx.bid; g < 256; g += cx.G) {
        __syncthreads();
        const int jg = j * 256 + g;
        if (tid < 64) {
            const float are = p->s5_a_re[jg * 64 + tid], aim = p->s5_a_im[jg * 64 + tid], dt = expf(p->s5_log_dt[jg]);
            const float mag = expf(are * dt), ang = aim * dt;
            const float lbr = mag * cosf(ang), lbi = mag * sinf(ang);
            const float nr = lbr - 1.0f, den = are * are + aim * aim;
            CF[2 * tid] = (nr * are + lbi * aim) / den; CF[2 * tid + 1] = (lbi * are - nr * aim) / den;
            for (int n = 0; n <= 16; ++n) { const float mm = expf(are * dt * (float)n), a = ang * (float)n; LP[(n * 64 + tid) * 2] = mm * cosf(a); LP[(n * 64 + tid) * 2 + 1] = mm * sinf(a); }
        }
        __syncthreads();
        for (int idx = tid; idx < 1024; idx += NT) {
            const int pp = idx >> 4;
            const float br = p->s5_b_re[(size_t)jg * 1024 + idx], bi = p->s5_b_im[(size_t)jg * 1024 + idx], cr = CF[2 * pp], ci = CF[2 * pp + 1];
            BB[idx * 2] = cr * br - ci * bi; BB[idx * 2 + 1] = cr * bi + ci * br;
            CC[idx * 2] = p->s5_c_re[(size_t)jg * 1024 + idx]; CC[idx * 2 + 1] = p->s5_c_im[(size_t)jg * 1024 + idx];
        }
        __syncthreads();
        for (int q = 0; q < 8; ++q) {
            const int idx = tid + NT * q, tau = idx >> 8, o = (idx >> 4) & 15, i = idx & 15;
            float s = 0.f;
            for (int pp = 0; pp < 64; ++pp) {
                const float Lr = LP[(tau * 64 + pp) * 2], Li = LP[(tau * 64 + pp) * 2 + 1], Cr = CC[(o * 64 + pp) * 2], Ci = CC[(o * 64 + pp) * 2 + 1];
                const float Gr = Cr * Lr - Ci * Li, Gi = Cr * Li + Ci * Lr;
                s += Gr * BB[(pp * 16 + i) * 2] - Gi * BB[(pp * 16 + i) * 2 + 1];
            }
            KT[idx] = s;
        }
        __syncthreads();
        bf16_t* Mg = MG + (size_t)g * 256 * 384;
        for (int it = 0; it < 24; ++it) {
            const int v = tid + NT * it, row = v / 48, kc = (v % 48) * 8, t = row >> 4, o = row & 15;
            float val[8];
            if (kc < 256) { const int s = kc >> 4, i0 = kc & 15;
#pragma unroll
                for (int jj = 0; jj < 8; ++jj) val[jj] = (t >= s) ? KT[((t - s) * 16 + o) * 16 + i0 + jj] : 0.f;
            } else { const int n0 = kc - 256;
#pragma unroll
                for (int jj = 0; jj < 8; ++jj) { const int pp = (n0 + jj) & 63;
                    const float Lr = LP[((t + 1) * 64 + pp) * 2], Li = LP[((t + 1) * 64 + pp) * 2 + 1], Cr = CC[(o * 64 + pp) * 2], Ci = CC[(o * 64 + pp) * 2 + 1];
                    val[jj] = (n0 < 64) ? (Cr * Lr - Ci * Li) : -(Cr * Li + Ci * Lr); } }
            u32x4 w; w.x = pk2(val[0], val[1]); w.y = pk2(val[2], val[3]); w.z = pk2(val[4], val[5]); w.w = pk2(val[6], val[7]);
            *(u32x4*)(Mg + (size_t)row * 384 + kc) = w;
        }
        bf16_t* We = WE + (size_t)g * 128 * 256;
        for (int it = 0; it < 8; ++it) {
            const int v = tid + NT * it, n = v >> 5, kc = (v & 31) * 8, s = kc >> 4, i0 = kc & 15, pp = n & 63;
            const float Lr = LP[((15 - s) * 64 + pp) * 2], Li = LP[((15 - s) * 64 + pp) * 2 + 1];
            float val[8];
#pragma unroll
            for (int jj = 0; jj < 8; ++jj) { const float Br = BB[(pp * 16 + i0 + jj) * 2], Bi = BB[(pp * 16 + i0 + jj) * 2 + 1]; val[jj] = (n < 64) ? (Lr * Br - Li * Bi) : (Lr * Bi + Li * Br); }
            u32x4 w; w.x = pk2(val[0], val[1]); w.y = pk2(val[2], val[3]); w.z = pk2(val[4], val[5]); w.w = pk2(val[6], val[7]);
            *(u32x4*)(We + (size_t)n * 256 + kc) = w;
        }
        if (tid < 128) LT[g * 128 + tid] = LP[(16 * 64 + (tid & 63)) * 2 + (tid >> 6)];
    }
    __syncthreads();
}

__device__ __forceinline__ void phase_prep(const Ctx cx, KP p, LAS unsigned char* lds) {
    const int tid = cx.tid, G = cx.G;
    float* modp = (float*)(p->ws + WS_MODP);
    for (int it = cx.bid; it < 256; it += G) {
        const int l = it >> 6, dc = it & 63;
        f32x4 a0 = {0.f, 0.f, 0.f, 0.f}, a1 = a0, a2 = a0;
        const float* wp = p->ada_w + ((size_t)l * DM + dc * 32) * 6144 + 4 * tid;
#pragma unroll 8
        for (int r = 0; r < 32; ++r) {
            const float s = siluf_(p->c[dc * 32 + r]);
            a0 += s * *(const f32x4*)(wp + (size_t)r * 6144); a1 += s * *(const f32x4*)(wp + (size_t)r * 6144 + 2048); a2 += s * *(const f32x4*)(wp + (size_t)r * 6144 + 4096);
        }
        float* o = modp + ((size_t)dc * 4 + l) * 6144 + 4 * tid;
        *(f32x4*)o = a0; *(f32x4*)(o + 2048) = a1; *(f32x4*)(o + 4096) = a2;
    }
    { float* wgt = (float*)(p->ws + WS_WGT);
      for (int idx = cx.bid * NT + tid; idx < 65536; idx += G * NT) { const int j = idx >> 15, r = (idx >> 11) & 15, d = idx & 2047; wgt[idx] = p->gla_w_in[((size_t)j * DM + d) * GLA_W + 10240 + r]; } }
    for (int j = 0; j < 2; ++j) {
        bf16_t* wg = (bf16_t*)(p->ws + WS_WG) + (size_t)j * 10240 * DM;
        const float* src = p->gla_w_in + (size_t)j * DM * GLA_W;
        conv_job(cx, lds, src, DM, GLA_W, 0, 1024, wg, DM);
        conv_job(cx, lds, src, DM, GLA_W, 6144, 4096, wg + (size_t)1024 * DM, DM);
        conv_job(cx, lds, src, DM, GLA_W, 1024, 1024, wg + (size_t)5120 * DM, DM);
        conv_job(cx, lds, src, DM, GLA_W, 2048, 4096, wg + (size_t)6144 * DM, DM);
        conv_job(cx, lds, p->gla_w_out + (size_t)j * DI * DM, DI, DM, 0, DM, (bf16_t*)(p->ws + WS_WGO) + (size_t)j * DM * DI, DI);
        conv_job(cx, lds, p->s5_w_in + (size_t)j * DM * 8192, DM, 8192, 0, 8192, (bf16_t*)(p->ws + WS_WSI) + (size_t)j * 8192 * DM, DM);
        conv_job(cx, lds, p->s5_w_glu + (size_t)j * DI * DI, DI, DI, 0, DI, (bf16_t*)(p->ws + WS_WGLU) + (size_t)j * DI * DI, DI);
        conv_job(cx, lds, p->s5_w_out + (size_t)j * DI * DM, DI, DM, 0, DM, (bf16_t*)(p->ws + WS_WSO) + (size_t)j * DM * DI, DI);
    }
    s5_tables(cx, p, lds, 0);
}

__device__ __forceinline__ void phase_mod_u0(const Ctx cx, KP p) {
    const int tid = cx.tid, G = cx.G;
    const float* modp = (const float*)(p->ws + WS_MODP); float* mod = (float*)(p->ws + WS_MOD);
    for (int idx = cx.bid * NT + tid; idx < 24576; idx += G * NT) {
        const int l = idx / 6144, e = idx % 6144; float s = p->ada_b[idx];
        for (int dc = 0; dc < 64; ++dc) s += modp[((size_t)dc * 4 + l) * 6144 + e];
        mod[idx] = s;
    }
    f32x4 sh = *(const f32x4*)(p->ada_b + 4 * tid), sc = *(const f32x4*)(p->ada_b + 2048 + 4 * tid);
    for (int dc = 0; dc < 64; ++dc) { sh += *(const f32x4*)(modp + (size_t)dc * 4 * 6144 + 4 * tid); sc += *(const f32x4*)(modp + (size_t)dc * 4 * 6144 + 2048 + 4 * tid); }
    sc += 1.0f;
    bf16_t* U = (bf16_t*)(p->ws + WS_U);
    for (int row = cx.bid; row < SEQ; row += G) {
        const f32x4 xv = *(const f32x4*)(p->x + (size_t)row * DM + 4 * tid);
        const f32x4 uv = xv * sc + sh;
        u32x2 w; w.x = pk2(uv[0], uv[1]); w.y = pk2(uv[2], uv[3]);
        *(u32x2*)(U + (size_t)row * DM + 4 * tid) = w;
    }
}

__device__ __forceinline__ void gla_glr(const Ctx cx, KP p, const int j) {
    const int tid = cx.tid, G = cx.G;
    const bf16_t* U = (const bf16_t*)(p->ws + WS_U); const float* wgt = (const float*)(p->ws + WS_WGT) + (size_t)j * 16 * DM;
    float* glr = (float*)(p->ws + WS_ACT + ACT_GLR);
    const int r = tid & 15;
    for (int t = cx.bid * 32 + (tid >> 4); t < SEQ; t += G * 32) {
        const bf16_t* up = U + (size_t)t * DM; const float* wp = wgt + (size_t)r * DM;
        float s = 0.f;
#pragma unroll 4
        for (int d = 0; d < DM; d += 8) {
            const u32x4 uu = *(const u32x4*)(up + d); const f32x4 w0 = *(const f32x4*)(wp + d), w1 = *(const f32x4*)(wp + d + 4);
            s += bflo(uu.x) * w0[0] + bfhi(uu.x) * w0[1] + bflo(uu.y) * w0[2] + bfhi(uu.y) * w0[3] + bflo(uu.z) * w1[0] + bfhi(uu.z) * w1[1] + bflo(uu.w) * w1[2] + bfhi(uu.w) * w1[3];
        }
        glr[t * 16 + r] = s;
    }
}

__device__ __forceinline__ void gla_decay(const Ctx cx, KP p, LAS unsigned char* lds, const int j) {
    const int tid = cx.tid, G = cx.G;
    { float* ssq = (float*)(p->ws + WS_ACT + ACT_SSQ); for (int idx = cx.bid * NT + tid; idx < SEQ * 4; idx += G * NT) ssq[idx] = 0.f; }
    const float* glr = (const float*)(p->ws + WS_ACT + ACT_GLR); float* etot = (float*)(p->ws + WS_ACT + ACT_ETOT);
    bf16_t* KT = (bf16_t*)(p->ws + WS_ACT + ACT_KT);
    LAS float* gl = (LAS float*)lds;
    for (int it = cx.bid; it < 256; it += G) {
        const int c = it >> 1, kk = (it & 1) * 512 + tid;
        __syncthreads();
        gl[tid] = glr[c * 1024 + tid]; gl[tid + 512] = glr[c * 1024 + 512 + tid];
        __syncthreads();
        float w2[16];
#pragma unroll
        for (int r = 0; r < 16; ++r) w2[r] = p->gla_gate_w2[((size_t)j * 16 + r) * NQK + kk];
        const float gb = p->gla_gate_b[j * NQK + kk];
        float cum[64]; float run = 0.f;
#pragma unroll
        for (int t = 0; t < 64; ++t) {
            float xx = gb;
#pragma unroll
            for (int r4 = 0; r4 < 4; ++r4) { const f32x4 gv = *(const LAS f32x4*)(gl + t * 16 + r4 * 4); xx += gv[0] * w2[r4 * 4] + gv[1] * w2[r4 * 4 + 1] + gv[2] * w2[r4 * 4 + 2] + gv[3] * w2[r4 * 4 + 3]; }
            const float la = -(fmaxf(-xx, 0.f) + log1pf(__expf(-fabsf(xx)))) * 0.0625f;
            run += la; cum[t] = run;
        }
        etot[c * 1024 + kk] = __expf(run);
        bf16_t* kp = KT + (size_t)kk * SEQ + c * 64;
#pragma unroll
        for (int q = 0; q < 8; ++q) {
            u32x4 kv = *(const u32x4*)(kp + q * 8);
            kv.x = pk2(bflo(kv.x) * __expf(run - cum[q * 8 + 0]), bfhi(kv.x) * __expf(run - cum[q * 8 + 1]));
            kv.y = pk2(bflo(kv.y) * __expf(run - cum[q * 8 + 2]), bfhi(kv.y) * __expf(run - cum[q * 8 + 3]));
            kv.z = pk2(bflo(kv.z) * __expf(run - cum[q * 8 + 4]), bfhi(kv.z) * __expf(run - cum[q * 8 + 5]));
            kv.w = pk2(bflo(kv.w) * __expf(run - cum[q * 8 + 6]), bfhi(kv.w) * __expf(run - cum[q * 8 + 7]));
            *(u32x4*)(kp + q * 8) = kv;
        }
    }
}

__device__ __forceinline__ void gla_scan(const Ctx cx, KP p, LAS unsigned char* lds, const int j) {
    const int tid = cx.tid, w = __builtin_amdgcn_readfirstlane(tid >> 6), lane = tid & 63, fr = lane & 15, fq = lane >> 4;
    const bf16_t* QS = (const bf16_t*)(p->ws + WS_ACT + ACT_QS); const bf16_t* KT = (const bf16_t*)(p->ws + WS_ACT + ACT_KT);
    const bf16_t* VT = (const bf16_t*)(p->ws + WS_ACT + ACT_Y2); const bf16_t* ZS = (const bf16_t*)(p->ws + WS_ACT + ACT_ZS);
    bf16_t* Y = (bf16_t*)(p->ws + WS_ACT + ACT_YB); const float* etot = (const float*)(p->ws + WS_ACT + ACT_ETOT); float* ssq = (float*)(p->ws + WS_ACT + ACT_SSQ);
    const float* ng = p->gla_norm_g + (size_t)j * DI;
    LAS float* red = (LAS float*)lds;
    for (int it = cx.bid; it < 256; it += cx.G) {
        const int xcd = it & 7, h = xcd >> 1, slice = (it >> 3) + 32 * (xcd & 1);
        const int dv0 = h * 1024 + 16 * slice, kb = h * 256 + 32 * w;
        const bf16_t* kdp = KT + (size_t)(kb + fr) * SEQ + 8 * fq;
        const bf16_t* vp = VT + (size_t)(dv0 + fr) * SEQ + 8 * fq;
        const bf16_t* qp = QS + (size_t)fr * NQK + kb + 4 * fq;
        const float* ep = etot + kb + 4 * fq;
        f32x4 S0 = {0.f, 0.f, 0.f, 0.f}, S1 = S0;
        bf16x8 kd00, kd01, kd10, kd11, v0, v1; s16x4 qa[4][2]; f32x4 e0, e1;
#define SCAN_LOAD(c) do { const int t0_ = (c) * 64; \
        kd00 = *(const bf16x8*)(kdp + t0_); kd01 = *(const bf16x8*)(kdp + t0_ + 32); kd10 = *(const bf16x8*)(kdp + (size_t)16 * SEQ + t0_); kd11 = *(const bf16x8*)(kdp + (size_t)16 * SEQ + t0_ + 32); \
        v0 = *(const bf16x8*)(vp + t0_); v1 = *(const bf16x8*)(vp + t0_ + 32); \
        _Pragma("unroll") for (int tt = 0; tt < 4; ++tt) { qa[tt][0] = *(const s16x4*)(qp + (size_t)(t0_ + 16 * tt) * NQK); qa[tt][1] = *(const s16x4*)(qp + (size_t)(t0_ + 16 * tt) * NQK + 16); } \
        e0 = *(const f32x4*)(ep + (c) * 1024); e1 = *(const f32x4*)(ep + (c) * 1024 + 16); } while (0)
        SCAN_LOAD(0);
        __syncthreads();
        for (int c = 0; c < 128; ++c) {
            const bf16x8 ckd00 = kd00, ckd01 = kd01, ckd10 = kd10, ckd11 = kd11, cv0 = v0, cv1 = v1; const f32x4 ce0 = e0, ce1 = e1;
            bf16x8 cq[4];
#pragma unroll
            for (int tt = 0; tt < 4; ++tt) cq[tt] = __builtin_shufflevector(qa[tt][0], qa[tt][1], 0, 1, 2, 3, 4, 5, 6, 7);
            if (c + 1 < 128) SCAN_LOAD(c + 1);
            S0 *= ce0; S1 *= ce1;
            S0 = __builtin_amdgcn_mfma_f32_16x16x32_bf16(ckd00, cv0, S0, 0, 0, 0); S0 = __builtin_amdgcn_mfma_f32_16x16x32_bf16(ckd01, cv1, S0, 0, 0, 0);
            S1 = __builtin_amdgcn_mfma_f32_16x16x32_bf16(ckd10, cv0, S1, 0, 0, 0); S1 = __builtin_amdgcn_mfma_f32_16x16x32_bf16(ckd11, cv1, S1, 0, 0, 0);
            u32x4 sbw; sbw.x = pk2(S0[0], S0[1]); sbw.y = pk2(S0[2], S0[3]); sbw.z = pk2(S1[0], S1[1]); sbw.w = pk2(S1[2], S1[3]);
            const bf16x8 sb = __builtin_bit_cast(bf16x8, sbw);
            LAS float* rb = red + (c & 1) * 8192 + w * 1024;
#pragma unroll
            for (int tt = 0; tt < 4; ++tt) {
                const f32x4 o = __builtin_amdgcn_mfma_f32_16x16x32_bf16(cq[tt], sb, (f32x4){0.f, 0.f, 0.f, 0.f}, 0, 0, 0);
#pragma unroll
                for (int jj = 0; jj < 4; ++jj) rb[(16 * tt + 4 * fq + jj) * 16 + fr] = o[jj];
            }
            __syncthreads();
            { const int t = tid >> 3, dp = (tid & 7) * 2; const LAS float* rr = red + (c & 1) * 8192 + t * 16 + dp;
              float o0 = 0.f, o1 = 0.f;
#pragma unroll
              for (int ww = 0; ww < 8; ++ww) { const f32x2 r2 = *(const LAS f32x2*)(rr + ww * 1024); o0 += r2.x; o1 += r2.y; }
              float q = o0 * o0 + o1 * o1; q += __shfl_xor(q, 1); q += __shfl_xor(q, 2); q += __shfl_xor(q, 4);
              const int tg = c * 64 + t;
              if ((tid & 7) == 0) atomicAdd(ssq + tg * 4 + h, q);
              const unsigned zz = *(const unsigned*)(ZS + (size_t)tg * DI + dv0 + dp);
              const f32x2 gg = *(const f32x2*)(ng + dv0 + dp);
              *(unsigned*)(Y + (size_t)tg * DI + dv0 + dp) = pk2(o0 * gg.x * bflo(zz), o1 * gg.y * bfhi(zz)); }
        }
#undef SCAN_LOAD
        __syncthreads();
    }
}

__device__ __forceinline__ void gla_rms(const Ctx cx, KP p) {
    const int tid = cx.tid, G = cx.G;
    bf16_t* Y = (bf16_t*)(p->ws + WS_ACT + ACT_YB); const float* ssq = (const float*)(p->ws + WS_ACT + ACT_SSQ);
    for (int v = cx.bid * NT + tid; v < SEQ * 512; v += G * NT) {
        const int t = v >> 9, col = (v & 511) * 8, h = col >> 10;
        const float rs = rsqrtf(ssq[t * 4 + h] * (1.0f / 1024.0f) + 1e-6f);
        u32x4 y = *(const u32x4*)(Y + (size_t)t * DI + col);
        y.x = pk2(bflo(y.x) * rs, bfhi(y.x) * rs); y.y = pk2(bflo(y.y) * rs, bfhi(y.y) * rs); y.z = pk2(bflo(y.z) * rs, bfhi(y.z) * rs); y.w = pk2(bflo(y.w) * rs, bfhi(y.w) * rs);
        *(u32x4*)(Y + (size_t)t * DI + col) = y;
    }
}

__device__ __forceinline__ void ln_phase(const Ctx cx, KP p, const int layer) {
    const int tid = cx.tid, w = tid >> 6, lane = tid & 63;
    const float* R = (const float*)(p->ws + WS_ACT + ACT_E); float* Xo = (layer == 3) ? p->out : (float*)(p->ws + WS_X);
    bf16_t* U = (bf16_t*)(p->ws + WS_U);
    const float* g = p->ln_g + layer * DM; const float* b = p->ln_b + layer * DM;
    const float* mod = (const float*)(p->ws + WS_MOD) + (layer < 3 ? (layer + 1) * 6144 : 0);
    for (int row = cx.bid * 8 + w; row < SEQ; row += cx.G * 8) {
        f32x4 v[8]; float s = 0.f;
#pragma unroll
        for (int i = 0; i < 8; ++i) { v[i] = *(const f32x4*)(R + (size_t)row * DM + 256 * i + 4 * lane); s += (v[i][0] + v[i][1]) + (v[i][2] + v[i][3]); }
        s = wave_sum(s); const float mu = s * (1.0f / 2048.0f);
        float q = 0.f;
#pragma unroll
        for (int i = 0; i < 8; ++i) { const f32x4 d = v[i] - mu; q += (d[0] * d[0] + d[1] * d[1]) + (d[2] * d[2] + d[3] * d[3]); }
        q = wave_sum(q); const float rs = rsqrtf(q * (1.0f / 2048.0f) + 1e-5f);
#pragma unroll
        for (int i = 0; i < 8; ++i) {
            const int col = 256 * i + 4 * lane;
            const f32x4 y = (v[i] - mu) * rs * *(const f32x4*)(g + col) + *(const f32x4*)(b + col);
            *(f32x4*)(Xo + (size_t)row * DM + col) = y;
            if (layer < 3) { const f32x4 uv = y * (*(const f32x4*)(mod + 2048 + col) + 1.0f) + *(const f32x4*)(mod + col);
                u32x2 wv; wv.x = pk2(uv[0], uv[1]); wv.y = pk2(uv[2], uv[3]); *(u32x2*)(U + (size_t)row * DM + col) = wv; }
        }
    }
}

__device__ __forceinline__ void s5_carry(const Ctx cx, KP p, LAS unsigned char* lds) {
    const int tid = cx.tid, w = __builtin_amdgcn_readfirstlane(tid >> 6), lane = tid & 63;
    const float* E = (const float*)(p->ws + WS_ACT + ACT_E); bf16_t* UC = (bf16_t*)(p->ws + WS_ACT + ACT_UCAT); const float* LT = (const float*)(p->ws + WS_LAMT);
    LAS float* endst = (LAS float*)lds;
    for (int g = cx.bid; g < 256; g += cx.G) {
        const float lr = LT[g * 128 + lane], li = LT[g * 128 + 64 + lane];
        const float* Eg = E + ((size_t)g * 512 + 64 * w) * 128 + lane;
        float xr = 0.f, xi = 0.f;
        for (int b = 0; b < 2; ++b) {
            float er[32], ei[32];
#pragma unroll
            for (int s = 0; s < 32; ++s) { er[s] = Eg[(32 * b + s) * 128]; ei[s] = Eg[(32 * b + s) * 128 + 64]; }
#pragma unroll
            for (int s = 0; s < 32; ++s) { const float nr = lr * xr - li * xi + er[s], ni = lr * xi + li * xr + ei[s]; xr = nr; xi = ni; }
        }
        __syncthreads();
        endst[w * 128 + lane] = xr; endst[w * 128 + 64 + lane] = xi;
        float pr = lr, pi = li;
#pragma unroll
        for (int q = 0; q < 6; ++q) { const float nr = pr * pr - pi * pi, ni = 2.0f * pr * pi; pr = nr; pi = ni; }
        __syncthreads();
        float cr = 0.f, ci = 0.f;
        for (int ww = 0; ww < w; ++ww) { const float tr = pr * cr - pi * ci + endst[ww * 128 + lane], ti = pr * ci + pi * cr + endst[ww * 128 + 64 + lane]; cr = tr; ci = ti; }
        xr = cr; xi = ci;
        bf16_t* Ug = UC + ((size_t)g * 512 + 64 * w) * 384 + 256 + lane;
        for (int b = 0; b < 2; ++b) {
            float er[32], ei[32];
#pragma unroll
            for (int s = 0; s < 32; ++s) { er[s] = Eg[(32 * b + s) * 128]; ei[s] = Eg[(32 * b + s) * 128 + 64]; }
#pragma unroll
            for (int s = 0; s < 32; ++s) {
                Ug[(size_t)(32 * b + s) * 384] = (bf16_t)(pk2(xr, 0.f) & 0xffffu); Ug[(size_t)(32 * b + s) * 384 + 64] = (bf16_t)(pk2(xi, 0.f) & 0xffffu);
                const float nr = lr * xr - li * xi + er[s], ni = lr * xi + li * xr + ei[s]; xr = nr; xi = ni; }
        }
    }
}

__device__ __forceinline__ void run_phase(const Ctx cx, KP p, LAS unsigned char* lds, const int ph) {
    const int G = cx.G, c = cx.bid;
    if (ph == 0) { phase_prep(cx, p, lds); return; }
    if (ph == 1) { phase_mod_u0(cx, p); return; }
    int q = ph - 2, layer;
    if (q < 6) layer = 0; else if (q < 13) { layer = 1; q -= 6; } else if (q < 19) { layer = 2; q -= 13; } else { layer = 3; q -= 19; }
    const int j = layer >> 1;
    const float* Xcur = (layer == 0) ? p->x : (const float*)(p->ws + WS_X);
    const float* gate = (const float*)(p->ws + WS_MOD) + layer * 6144 + 4096;
    unsigned char* act = p->ws + WS_ACT;
    if ((layer & 1) == 0) {
        if (q == 0) {
            gla_glr(cx, p, j);
            SchedGlaIn S{(const char*)(p->ws + WS_U), (const char*)(p->ws + WS_WG + (size_t)j * 10240 * DM * 2), G, c};
            EpiGlaIn E{(bf16_t*)(act + ACT_QS), (bf16_t*)(act + ACT_ZS), (bf16_t*)(act + ACT_KT), (bf16_t*)(act + ACT_Y2)};
            pg8::gemm_phase(cx, lds, DM, DM, DM, 1, S, E);
        } else if (q == 1) { gla_decay(cx, p, lds, j); if (layer == 2) s5_tables(cx, p, lds, 1); }
        else if (q == 2) gla_scan(cx, p, lds, j);
        else if (q == 3) gla_rms(cx, p);
        else if (q == 4) {
            SchedPlain S{(const char*)(act + ACT_YB), (const char*)(p->ws + WS_WGO + (size_t)j * DM * DI * 2), 32, 8, G, c, (size_t)256 * DI * 2, (size_t)256 * DI * 2};
            EpiOut E{Xcur, (float*)(act + ACT_E), gate};
            pg8::gemm_phase(cx, lds, DI, DI, DI, 1, S, E);
        } else ln_phase(cx, p, layer);
    } else {
        if (q == 0) {
            SchedPlain S{(const char*)(p->ws + WS_U), (const char*)(p->ws + WS_WSI + (size_t)j * 8192 * DM * 2), 32, 32, G, c, (size_t)256 * DM * 2, (size_t)256 * DM * 2};
            EpiS5In E{(bf16_t*)(act + ACT_UCAT), (bf16_t*)(act + ACT_ZS)};
            pg8::gemm_phase(cx, lds, DM, DM, DM, 1, S, E);
        } else if (q == 1) {
            SchedGroup S{(const char*)(act + ACT_UCAT), (const char*)(p->ws + WS_WE), (size_t)512 * 384 * 2, (size_t)128 * 256 * 2, (size_t)256 * 384 * 2, G, c};
            EpiS5E E{(float*)(act + ACT_E)};
            pg8::gemm_phase(cx, lds, 256, 384, 256, 0, S, E);
        } else if (q == 2) s5_carry(cx, p, lds);
        else if (q == 3) {
            SchedGroup S{(const char*)(act + ACT_UCAT), (const char*)(p->ws + WS_MG), (size_t)512 * 384 * 2, (size_t)256 * 384 * 2, (size_t)256 * 384 * 2, G, c};
            EpiS5Y E{(const bf16_t*)(act + ACT_UCAT), (bf16_t*)(act + ACT_YB), p->s5_d + (size_t)j * DI};
            pg8::gemm_phase(cx, lds, 384, 384, 384, 1, S, E);
        } else if (q == 4) {
            SchedPlain S{(const char*)(act + ACT_YB), (const char*)(p->ws + WS_WGLU + (size_t)j * DI * DI * 2), 32, 16, G, c, (size_t)256 * DI * 2, (size_t)256 * DI * 2};
            EpiGlu E{(const bf16_t*)(act + ACT_YB), (const bf16_t*)(act + ACT_ZS), (bf16_t*)(act + ACT_Y2), p->s5_b_glu + (size_t)j * DI};
            pg8::gemm_phase(cx, lds, DI, DI, DI, 1, S, E);
        } else if (q == 5) {
            SchedPlain S{(const char*)(act + ACT_Y2), (const char*)(p->ws + WS_WSO + (size_t)j * DM * DI * 2), 32, 8, G, c, (size_t)256 * DI * 2, (size_t)256 * DI * 2};
            EpiOut E{Xcur, (float*)(act + ACT_E), gate};
            pg8::gemm_phase(cx, lds, DI, DI, DI, 1, S, E);
        } else ln_phase(cx, p, layer);
    }
}

__global__ void __launch_bounds__(NT, 2) fwd_megakernel(Params p_unused) {
    extern __shared__ __attribute__((aligned(16))) unsigned char lds_raw[];
    LAS unsigned char* lds = (LAS unsigned char*)lds_raw;
    KP kp0 = (KP)__builtin_amdgcn_kernarg_segment_ptr();
    const int ph_lo = kp0->ph_lo, ph_hi = kp0->ph_hi, coop = kp0->coop;
    for (int ph = ph_lo; ph < ph_hi; ++ph) {
        KP kp = kp0; asm volatile("" : "+s"(kp));
        Ctx cx; cx.tid = threadIdx.x; cx.bid = blockIdx.x; cx.G = gridDim.x;
        asm volatile("" : "+v"(cx.tid)); asm volatile("" : "+s"(cx.bid)); asm volatile("" : "+s"(cx.G));
        run_phase(cx, kp, lds, ph);
        if (coop && ph + 1 < ph_hi) cg::this_grid().sync();
    }
}

#ifndef MK_ONE_LAUNCH
#define MK_ONE_LAUNCH 0
#endif

extern "C" void kernel_launch(void* const* d_in, const int* in_sizes, int n_in, void* d_out, int out_size, void* d_ws, size_t ws_size, hipStream_t stream) {
    static int grid = 0;
    if (grid == 0) {
        if (n_in != 23 || ws_size < WS_END) { fprintf(stderr, "kernel_launch: need 23 inputs and %zu bytes of workspace, got %d / %zu\n", (size_t)WS_END, n_in, ws_size); grid = -1; return; }
        int dev = 0, cus = 0, per_cu = 0;
        hipGetDevice(&dev); hipDeviceGetAttribute(&cus, hipDeviceAttributeMultiprocessorCount, dev);
        if (hipFuncSetAttribute((const void*)fwd_megakernel, hipFuncAttributeMaxDynamicSharedMemorySize, LDS_BYTES) != hipSuccess) { fprintf(stderr, "kernel_launch: hipFuncSetAttribute failed\n"); grid = -1; return; }
        if (hipOccupancyMaxActiveBlocksPerMultiprocessor(&per_cu, (const void*)fwd_megakernel, NT, LDS_BYTES) != hipSuccess || per_cu < 1) { fprintf(stderr, "kernel_launch: occupancy query gave %d\n", per_cu); per_cu = 1; }
        (void)hipGetLastError();
        grid = cus;
    }
    if (grid < 0) return;
    Params hp{};
    const float** pp = (const float**)&hp;
    for (int i = 0; i < 23; ++i) pp[i] = (const float*)d_in[i];
    hp.out = (float*)d_out; hp.ws = (unsigned char*)d_ws; hp.pad = 0;
#if MK_ONE_LAUNCH
    hp.ph_lo = 0; hp.ph_hi = NPH; hp.coop = 1;
    void* args[] = {&hp};
    hipError_t e = hipLaunchCooperativeKernel((const void*)fwd_megakernel, dim3(grid), dim3(NT), args, LDS_BYTES, stream);
    if (e != hipSuccess) fprintf(stderr, "cooperative launch failed: %s (grid %d)\n", hipGetErrorString(e), grid);
#else
    hp.coop = 0;
    for (int ph = 0; ph < NPH; ++ph) { hp.ph_lo = ph; hp.ph_hi = ph + 1; hipLaunchKernelGGL(fwd_megakernel, dim3(grid), dim3(NT), LDS_BYTES, stream, hp); }
#endif
}
```

```cpp
#include <hip/hip_runtime.h>
#include <hip/hip_cooperative_groups.h>
#include <cstdio>
namespace cg = cooperative_groups;

#define LAS __attribute__((address_space(3)))
typedef unsigned short bf16_t;
typedef short bf16x8 __attribute__((ext_vector_type(8)));
typedef short s16x4 __attribute__((ext_vector_type(4)));
typedef float f32x4 __attribute__((ext_vector_type(4)));
typedef float f32x2 __attribute__((ext_vector_type(2)));
typedef unsigned u32x4 __attribute__((ext_vector_type(4)));
typedef unsigned u32x2 __attribute__((ext_vector_type(2)));

constexpr int SEQ = 8192, DM = 2048, DI = 4096, NQK = 1024;
constexpr int GLA_W = 10256;
constexpr float DN_ALPHA = 1.6817928305074290f;
#ifndef MK_REPEAT_MASK
#define MK_REPEAT_MASK 0
#endif
#ifndef MK_KREP_GLU
#define MK_KREP_GLU 1
#endif
#ifndef MK_PROBE_DECAY
#define MK_PROBE_DECAY 0
#endif
constexpr int NPH = 30;
constexpr int NT = 512;
constexpr int LDS_STAGE = 131072;
constexpr int LDS_RT = LDS_STAGE + 16;
constexpr int LDS_BYTES = LDS_RT + 4096;

constexpr size_t WS_WG   = 0;
constexpr size_t WS_WGO  = WS_WG   + 83886080;
constexpr size_t WS_WSI  = WS_WGO  + 33554432;
constexpr size_t WS_WGLU = WS_WSI  + 67108864;
constexpr size_t WS_WSO  = WS_WGLU + 67108864;
constexpr size_t WS_MG   = WS_WSO  + 33554432;
constexpr size_t WS_WE   = WS_MG   + 50331648;
constexpr size_t WS_LAMT = WS_WE   + 16777216;
constexpr size_t WS_WGT  = WS_LAMT + 131072;
constexpr size_t WS_MODP = WS_WGT  + 262144;
constexpr size_t WS_MOD  = WS_MODP + 6291456;
constexpr size_t WS_X    = WS_MOD  + 98304;
constexpr size_t WS_U    = WS_X    + 67108864;
constexpr size_t WS_ACT  = WS_U    + 33554432;
constexpr size_t ACT_UCAT = 0;
constexpr size_t ACT_QS   = 0;
constexpr size_t ACT_KT   = 16777216;
constexpr size_t ACT_GLR  = 33554432;
constexpr size_t ACT_ETOT = 34078720;
constexpr size_t ACT_SSQ  = 34603008;
constexpr size_t ACT_DSEG = 42991616;
constexpr size_t ACT_KD   = 50331648;
constexpr size_t ACT_ZS   = 100663296;
constexpr size_t ACT_E    = 167772160;
constexpr size_t ACT_YB   = 234881024;
constexpr size_t ACT_Y2   = 301989888;
constexpr size_t ACT_END  = 369098752;
constexpr size_t WS_BAR   = WS_ACT + ACT_END;
constexpr size_t WS_CNT   = WS_BAR + 16384;
constexpr size_t WS_XBUF  = WS_CNT + 32768;
constexpr size_t WS_END   = WS_XBUF + 524288;

struct Params {
    const float *x, *c, *ln_g, *ln_b, *ada_w, *ada_b, *gla_w_in, *gla_gate_w2, *gla_gate_b, *gla_norm_g, *gla_w_out,
        *s5_w_in, *s5_a_re, *s5_a_im, *s5_log_dt, *s5_b_re, *s5_b_im, *s5_c_re, *s5_c_im, *s5_d, *s5_w_glu, *s5_b_glu, *s5_w_out;
    float* out; unsigned char* ws; int ph_lo, ph_hi, coop, pad;
};

typedef const __attribute__((address_space(4))) Params* KP;
struct Ctx { int tid, bid, G; };

typedef __bf16 bf16v2_t __attribute__((ext_vector_type(2)));
__device__ __forceinline__ unsigned pk2(float lo, float hi) { const f32x2 v = {lo, hi}; return __builtin_bit_cast(unsigned, __builtin_convertvector(v, bf16v2_t)); }
__device__ __forceinline__ float bflo(unsigned u) { return __uint_as_float(u << 16); }
__device__ __forceinline__ float bfhi(unsigned u) { return __uint_as_float(u & 0xffff0000u); }
__device__ __forceinline__ float sigmoidf_(float x) { return __builtin_amdgcn_rcpf(1.0f + __expf(-x)); }
__device__ __forceinline__ float siluf_(float x) { return x * __builtin_amdgcn_rcpf(1.0f + __expf(-x)); }
__device__ __forceinline__ float gelu_tanh(float y) { const float a = 1.5957691216057308f * (y + 0.044715f * y * y * y); return y * __builtin_amdgcn_rcpf(1.0f + __expf(-a)); }
__device__ __forceinline__ float wave_sum(float v) {
    v += __shfl_xor(v, 32); v += __shfl_xor(v, 16); v += __shfl_xor(v, 8); v += __shfl_xor(v, 4); v += __shfl_xor(v, 2); v += __shfl_xor(v, 1); return v;
}

namespace pg8 {
constexpr int BM = 256, BK = 64, HALF = 128, HTB = HALF * BK * 2, STAGE_BYTES = 8 * HTB, NXCD = 8, WGM = 8;
__device__ __forceinline__ int lds_byte(int r, int c) { const int st = (r >> 4) * 2 + (c >> 5), rr = r & 15, cc = c & 31, ob = rr * 64 + cc * 2; return st * 1024 + (ob ^ (((ob >> 9) & 1) << 5)); }
__device__ __forceinline__ void stage_rc(int b, int& R, int& C) { const int st = b / 1024, sb = b % 1024, swz = sb ^ (((sb >> 9) & 1) << 5); R = (st >> 1) * 16 + swz / 64; C = (st & 1) * 32 + (swz % 64) / 2; }
__device__ __forceinline__ int perm32(int rho) { const int n = rho >> 4, i = rho & 15; return 8 * (i >> 2) + 4 * n + (i & 3); }

struct Unit { const char* a; const char* b; int pm, pn, kind, aux; };

__device__ __forceinline__ void tile_map(int wgid, int nM, int nN, int& pm, int& pn) {
    const int nwg = nM * nN;
    { const int q = nwg / NXCD, r = nwg % NXCD, xcd = wgid % NXCD, off = wgid / NXCD; wgid = (xcd < r ? xcd * (q + 1) : r * (q + 1) + (xcd - r) * q) + off; }
    const int nig = WGM * nN, gid = wgid / nig, fm = gid * WGM, gsz = (nM - fm) < WGM ? (nM - fm) : WGM;
    pm = fm + ((wgid % nig) % gsz); pn = (wgid % nig) / gsz;
}

template <class Epi, class Sched, int KREP = 1>
__device__ __forceinline__ void gemm_phase(const Ctx cx, LAS unsigned char* lds, const int K, const int lda, const int ldb, const int hsB, const Sched& S, const Epi& E) {
    const int tid = cx.tid, wid = __builtin_amdgcn_readfirstlane(tid >> 6), lane = tid & 63, wr = wid >> 2, wc = wid & 3, fr = lane & 15, fq = lane >> 4;
    const int nt = K / BK;
    unsigned voffA[2], voffB[2];
#pragma unroll
    for (int i = 0; i < 2; ++i) { int R, C; stage_rc(tid * 16 + i * 8192, R, C); const int Rb = Epi::PERM ? ((R & ~31) + perm32(R & 31)) : R;
        voffA[i] = (unsigned)(R * lda + C) * 2u; voffB[i] = (unsigned)(Rb * ldb + C) * 2u; }
    const size_t kstep = (size_t)(BK * 2);
    const size_t hstepA = (size_t)HALF * lda * 2;
    const size_t hstepB = hsB ? (size_t)HALF * ldb * 2 : 0;
    const unsigned ldsw = (unsigned)wid * 1024u;
    const int aoff = lds_byte(wr * 64 + fr, fq * 8), boff = lds_byte(wc * 32 + fr, fq * 8);
#define PG8_SA(b, h) (((b) * 2 + (h)) * HTB)
#define PG8_SB(b, h) ((4 + (b) * 2 + (h)) * HTB)
#define PG8_STAGE(bufoff, gbase, voff) do { _Pragma("unroll") for (int _i = 0; _i < 2; ++_i) \
        __builtin_amdgcn_global_load_lds((const unsigned*)((const char*)(gbase) + (voff)[_i]), (LAS unsigned*)(lds + (bufoff) + ldsw + _i * 8192), 16, 0, 0); } while (0)
#define PG8_LDA(dst, b, h) do { _Pragma("unroll") for (int m = 0; m < 4; ++m) _Pragma("unroll") for (int k = 0; k < 2; ++k) dst[m][k] = *(const LAS bf16x8*)(lds + PG8_SA(b, h) + aoff + m * 2048 + k * 1024); } while (0)
#define PG8_LDB(dst, b, h) do { _Pragma("unroll") for (int n = 0; n < 2; ++n) _Pragma("unroll") for (int k = 0; k < 2; ++k) dst[n][k] = *(const LAS bf16x8*)(lds + PG8_SB(b, h) + boff + n * 2048 + k * 1024); } while (0)
#define PG8_MMA(ai, bj, At, Bt) do { __builtin_amdgcn_s_setprio(1); _Pragma("unroll") for (int m = 0; m < 4; ++m) _Pragma("unroll") for (int n = 0; n < 2; ++n) _Pragma("unroll") for (int k = 0; k < 2; ++k) \
        acc[ai][bj][m][n] = __builtin_amdgcn_mfma_f32_16x16x32_bf16(Bt[n][k], At[m][k], acc[ai][bj][m][n], 0, 0, 0); __builtin_amdgcn_s_setprio(0); } while (0)
#define PG8_WAIT_V(n) asm volatile("s_waitcnt vmcnt(" #n ")" ::: "memory")
#define PG8_WAIT_L(n) asm volatile("s_waitcnt lgkmcnt(" #n ")" ::: "memory")
#define PG8_BAR __builtin_amdgcn_s_barrier()
#define PG8_SCHED __builtin_amdgcn_sched_barrier(0)
    Unit cur, nxt; int ui = 0;
    if (!S.next(0, cur)) return;
    if constexpr (Epi::KSCALE) E.prologue(cur, lds, tid);
    f32x4 acc[2][2][4][2];
#pragma unroll
    for (int a = 0; a < 2; ++a)
#pragma unroll
        for (int b = 0; b < 2; ++b)
#pragma unroll
            for (int m = 0; m < 4; ++m)
#pragma unroll
                for (int n = 0; n < 2; ++n) acc[a][b][m][n] = (f32x4){0.f, 0.f, 0.f, 0.f};
    bf16x8 At[4][2], B0[2][2], B1[2][2];
    const char* cA = cur.a; const char* cB = cur.b;
    PG8_STAGE(PG8_SB(0, 0), cB, voffB); PG8_STAGE(PG8_SA(0, 0), cA, voffA); PG8_STAGE(PG8_SB(0, 1), cB + hstepB, voffB); PG8_STAGE(PG8_SA(0, 1), cA + hstepA, voffA);
    if (wr == 1) PG8_BAR;
    PG8_WAIT_V(4); PG8_BAR;
    PG8_STAGE(PG8_SB(1, 0), cB + kstep, voffB); PG8_STAGE(PG8_SA(1, 0), cA + kstep, voffA); PG8_STAGE(PG8_SB(1, 1), cB + hstepB + kstep, voffB);
    PG8_WAIT_V(6); PG8_BAR;
    for (;;) {
        const bool has_next = S.next(ui + 1, nxt);
        const char* nA = has_next ? nxt.a : cA; const char* nB = has_next ? nxt.b : cB;
        for (int krep = 0; krep < KREP; ++krep) {
        const char* nAr = (krep == KREP - 1) ? nA : cA; const char* nBr = (krep == KREP - 1) ? nB : cB;
#pragma nounroll
        for (int t = 0; t < nt; t += 2) {
            const bool last = (t == nt - 2);
            const char* a1 = cA + (size_t)(t + 1) * kstep;
            const char* a2 = last ? nAr : cA + (size_t)(t + 2) * kstep; const char* b2 = last ? nBr : cB + (size_t)(t + 2) * kstep;
            const char* a3 = a2 + kstep; const char* b3 = b2 + kstep;
            if constexpr (Epi::KSCALE) { if (t != 0 && (t & 15) == 0) E.kscale(acc, (t >> 4) - 1, lds, wr, fr); }
            PG8_LDB(B0, 0, 0); PG8_SCHED; PG8_LDA(At, 0, 0); PG8_STAGE(PG8_SA(1, 1), a1 + hstepA, voffA);
            PG8_WAIT_L(8); PG8_BAR; PG8_WAIT_L(0); PG8_MMA(0, 0, At, B0); PG8_BAR; PG8_SCHED;
            PG8_LDB(B1, 0, 1); PG8_STAGE(PG8_SB(0, 0), b2, voffB);
            PG8_BAR; PG8_WAIT_L(0); if (hsB) PG8_MMA(0, 1, At, B1); PG8_BAR;
            PG8_LDA(At, 0, 1); PG8_STAGE(PG8_SA(0, 0), a2, voffA);
            PG8_BAR; PG8_WAIT_L(0); PG8_MMA(1, 0, At, B0); PG8_BAR; PG8_SCHED;
            PG8_STAGE(PG8_SB(0, 1), b2 + hstepB, voffB);
            PG8_WAIT_V(6); PG8_BAR; if (hsB) PG8_MMA(1, 1, At, B1); PG8_BAR;
            PG8_LDB(B0, 1, 0); PG8_SCHED; PG8_LDA(At, 1, 0); PG8_STAGE(PG8_SA(0, 1), a2 + hstepA, voffA);
            PG8_WAIT_L(8); PG8_BAR; PG8_WAIT_L(0); PG8_MMA(0, 0, At, B0); PG8_BAR; PG8_SCHED;
            PG8_LDB(B1, 1, 1); PG8_STAGE(PG8_SB(1, 0), b3, voffB);
            PG8_BAR; PG8_WAIT_L(0); if (hsB) PG8_MMA(0, 1, At, B1); PG8_BAR;
            PG8_LDA(At, 1, 1); PG8_STAGE(PG8_SA(1, 0), a3, voffA);
            PG8_BAR; PG8_WAIT_L(0); PG8_MMA(1, 0, At, B0); PG8_BAR; PG8_SCHED;
            PG8_STAGE(PG8_SB(1, 1), b3 + hstepB, voffB);
            PG8_WAIT_V(6); PG8_BAR; if (hsB) PG8_MMA(1, 1, At, B1); PG8_BAR;
        }
        }
        if constexpr (KREP > 1) {
#pragma unroll
            for (int a = 0; a < 2; ++a)
#pragma unroll
                for (int b = 0; b < 2; ++b)
#pragma unroll
                    for (int m = 0; m < 4; ++m)
#pragma unroll
                        for (int n = 0; n < 2; ++n) acc[a][b][m][n] *= (1.0f / KREP); }
        if constexpr (!Epi::AFTER_DRAIN) E(acc, cur, wr, wc, fr, fq);
        if (!has_next) break;
#pragma unroll
        for (int a = 0; a < 2; ++a)
#pragma unroll
            for (int b = 0; b < 2; ++b)
#pragma unroll
                for (int m = 0; m < 4; ++m)
#pragma unroll
                    for (int n = 0; n < 2; ++n) acc[a][b][m][n] = (f32x4){0.f, 0.f, 0.f, 0.f};
        cur = nxt; cA = nA; cB = nB; ++ui;
    }
    PG8_WAIT_V(0);
    if (wr == 0) PG8_BAR;
    PG8_BAR;
    if constexpr (Epi::AFTER_DRAIN) E.fused(acc, cur, wr, wc, fr, fq, lds, wid, lane);
#undef PG8_SA
#undef PG8_SB
#undef PG8_STAGE
#undef PG8_LDA
#undef PG8_LDB
#undef PG8_MMA
#undef PG8_WAIT_V
#undef PG8_WAIT_L
#undef PG8_BAR
#undef PG8_SCHED
}
}
using pg8::Unit;
typedef f32x4 Acc[2][2][4][2];

struct SchedPlain {
    const char* A; const char* B; int nM, nN, G, c; size_t ta, tb; int mix;
    __device__ __forceinline__ bool next(int i, Unit& u) const {
        const int L = i * G + c; if (L >= nM * nN) return false;
        int pm, pn; pg8::tile_map(L, nM, nN, pm, pn);
        if (mix) pn = (pn & 1) ? (nN >> 1) + (pn >> 1) : (pn >> 1);
        u.pm = pm; u.pn = pn; u.kind = 0; u.aux = 0; u.a = A + (size_t)pm * ta; u.b = B + (size_t)pn * tb; return true;
    }
};
struct SchedGlaIn {
    const char* U; const char* W; int G, c;
    __device__ __forceinline__ bool next(int i, Unit& u) const {
        int L = i * G + c; if (L >= 1280) return false;
        const size_t tstep = (size_t)256 * DM * 2;
        int pm, pn;
        if (L < 640) { pg8::tile_map(L, 32, 20, pm, pn); u.kind = 0; u.a = U + (size_t)pm * tstep; u.b = W + (size_t)pn * tstep; }
        else { pg8::tile_map(L - 640, 20, 32, pm, pn); u.kind = 1; u.a = W + (size_t)(20 + pm) * tstep; u.b = U + (size_t)pn * tstep; }
        u.pm = pm; u.pn = pn; u.aux = 0; return true;
    }
};
struct SchedGroup {
    const char* A; const char* B; size_t ga, gb, ta; int G, c;
    __device__ __forceinline__ bool next(int i, Unit& u) const {
        const int L = i * G + c; if (L >= 512) return false;
        const int g = L >> 1, pm = L & 1;
        u.pm = pm; u.pn = 0; u.kind = 0; u.aux = g; u.a = A + (size_t)g * ga + (size_t)pm * ta; u.b = B + (size_t)g * gb; return true;
    }
};

struct SchedGroupLocal {
    const char* A; const char* B; size_t ga, gb, ta; int g;
    __device__ __forceinline__ bool next(int i, Unit& u) const {
        if (i >= 2) return false;
        u.pm = i; u.pn = 0; u.kind = 0; u.aux = g; u.a = A + (size_t)g * ga + (size_t)i * ta; u.b = B + (size_t)g * gb; return true;
    }
};

struct EpiGlaIn {
    static constexpr bool PERM = true, AFTER_DRAIN = false, KSCALE = false;
    bf16_t *QS, *ZS, *KT, *VT;
    __device__ __forceinline__ void operator()(const Acc& acc, const Unit& u, int wr, int wc, int fr, int fq) const {
        const int row0 = u.pm * 256 + wr * 64 + fr, col0 = u.pn * 256 + wc * 32 + 8 * fq;
        bf16_t* base; int ld, rofs = 0, cofs = 0, mode;
        if (u.kind == 0) { if (u.pn < 4) { base = QS; ld = NQK; mode = 1; } else { base = ZS; ld = DI; cofs = -NQK; mode = 2; } }
        else { mode = 0; ld = SEQ; if (u.pm < 4) { base = KT; } else { base = VT; rofs = -NQK; } }
#pragma unroll
        for (int ai = 0; ai < 2; ++ai)
#pragma unroll
            for (int m = 0; m < 4; ++m) {
                bf16_t* rowp = base + (size_t)(row0 + rofs + ai * 128 + m * 16) * ld + col0 + cofs;
#pragma unroll
                for (int bj = 0; bj < 2; ++bj) {
                    f32x4 v0 = acc[ai][bj][m][0], v1 = acc[ai][bj][m][1];
                    if (mode == 1) { v0 *= 0.0625f; v1 *= 0.0625f; }
                    if (mode == 2) {
#pragma unroll
                        for (int j = 0; j < 4; ++j) { v0[j] = siluf_(v0[j]); v1[j] = siluf_(v1[j]); } }
                    u32x4 w; w.x = pk2(v0[0], v0[1]); w.y = pk2(v0[2], v0[3]); w.z = pk2(v1[0], v1[1]); w.w = pk2(v1[2], v1[3]);
                    if (mode == 1) {
                        const int m0 = 2 * fq; bf16_t* gp = rowp + bj * 128 - 8 * fq;
                        u32x2 lo; lo.x = w.x; lo.y = w.y; u32x2 hi; hi.x = w.z; hi.y = w.w;
                        *(u32x2*)(gp + (m0 & 3) * 8 + (m0 >> 2) * 4) = lo; *(u32x2*)(gp + ((m0 + 1) & 3) * 8 + ((m0 + 1) >> 2) * 4) = hi;
                    } else *(u32x4*)(rowp + bj * 128) = w; } }
    }
};
struct EpiS5In {
    static constexpr bool PERM = true, AFTER_DRAIN = false, KSCALE = false;
    bf16_t *UC, *ZS;
    __device__ __forceinline__ void operator()(const Acc& acc, const Unit& u, int wr, int wc, int fr, int fq) const {
        const int row0 = u.pm * 256 + wr * 64 + fr, col0 = u.pn * 256 + wc * 32 + 8 * fq;
        const bool isz = u.pn >= 16;
#pragma unroll
        for (int ai = 0; ai < 2; ++ai)
#pragma unroll
            for (int m = 0; m < 4; ++m) {
                const int t = row0 + ai * 128 + m * 16;
#pragma unroll
                for (int bj = 0; bj < 2; ++bj) {
                    f32x4 v0 = acc[ai][bj][m][0], v1 = acc[ai][bj][m][1];
                    const int c = col0 + bj * 128;
                    bf16_t* dst;
                    if (isz) {
#pragma unroll
                        for (int j = 0; j < 4; ++j) { v0[j] = siluf_(v0[j]); v1[j] = siluf_(v1[j]); }
                        dst = ZS + (size_t)t * DI + (c - DI);
                    } else { const int g = c >> 4, i0 = c & 15; dst = UC + ((size_t)g * 512 + (t >> 4)) * 384 + (t & 15) * 16 + i0; }
                    u32x4 w; w.x = pk2(v0[0], v0[1]); w.y = pk2(v0[2], v0[3]); w.z = pk2(v1[0], v1[1]); w.w = pk2(v1[2], v1[3]);
                    *(u32x4*)dst = w; } }
    }
};
struct EpiS5E {
    static constexpr bool PERM = false, AFTER_DRAIN = false, KSCALE = false;
    float* E;
    __device__ __forceinline__ void operator()(const Acc& acc, const Unit& u, int wr, int wc, int fr, int fq) const {
        const int row0 = u.pm * 256 + wr * 64 + fr, col0 = wc * 32 + 4 * fq;
#pragma unroll
        for (int ai = 0; ai < 2; ++ai)
#pragma unroll
            for (int m = 0; m < 4; ++m) {
                float* rowp = E + ((size_t)u.aux * 512 + row0 + ai * 128 + m * 16) * 128 + col0;
#pragma unroll
                for (int n = 0; n < 2; ++n) *(f32x4*)(rowp + n * 16) = acc[ai][0][m][n]; }
    }
};
struct EpiS5Y {
    static constexpr bool PERM = true, AFTER_DRAIN = false, KSCALE = false;
    const bf16_t* UC; bf16_t* YB; const float* dsk;
    __device__ __forceinline__ void operator()(const Acc& acc, const Unit& u, int wr, int wc, int fr, int fq) const {
        const int g = u.aux; const int row0 = u.pm * 256 + wr * 64 + fr, col0 = wc * 32 + 8 * fq;
#pragma unroll
        for (int bj = 0; bj < 2; ++bj) {
            const int n = col0 + bj * 128; const int tt = n >> 4, o0 = n & 15; const int ch = g * 16 + o0;
            const f32x4 d0 = *(const f32x4*)(dsk + ch), d1 = *(const f32x4*)(dsk + ch + 4);
#pragma unroll
            for (int ai = 0; ai < 2; ++ai) {
                u32x4 uq[4];
#pragma unroll
                for (int m = 0; m < 4; ++m) uq[m] = *(const u32x4*)(UC + ((size_t)g * 512 + row0 + ai * 128 + m * 16) * 384 + n);
                __builtin_amdgcn_sched_barrier(0);
#pragma unroll
                for (int m = 0; m < 4; ++m) {
                    const int c = row0 + ai * 128 + m * 16; const u32x4 uu = uq[m];
                    f32x4 v0 = acc[ai][bj][m][0], v1 = acc[ai][bj][m][1];
                    v0[0] += d0[0] * bflo(uu.x); v0[1] += d0[1] * bfhi(uu.x); v0[2] += d0[2] * bflo(uu.y); v0[3] += d0[3] * bfhi(uu.y);
                    v1[0] += d1[0] * bflo(uu.z); v1[1] += d1[1] * bfhi(uu.z); v1[2] += d1[2] * bflo(uu.w); v1[3] += d1[3] * bfhi(uu.w);
#pragma unroll
                    for (int j = 0; j < 4; ++j) { v0[j] = gelu_tanh(v0[j]); v1[j] = gelu_tanh(v1[j]); }
                    u32x4 w; w.x = pk2(v0[0], v0[1]); w.y = pk2(v0[2], v0[3]); w.z = pk2(v1[0], v1[1]); w.w = pk2(v1[2], v1[3]);
                    *(u32x4*)(YB + (size_t)(c * 16 + tt) * DI + ch) = w; }
                __builtin_amdgcn_sched_barrier(0);
            } }
    }
};
struct EpiGlu {
    static constexpr bool PERM = true, AFTER_DRAIN = false, KSCALE = false;
    const bf16_t *YB, *ZS; bf16_t* Y2; const float* bg;
    __device__ __forceinline__ void operator()(const Acc& acc, const Unit& u, int wr, int wc, int fr, int fq) const {
        const int row0 = u.pm * 256 + wr * 64 + fr, col0 = u.pn * 256 + wc * 32 + 8 * fq;
#pragma unroll
        for (int bj = 0; bj < 2; ++bj) {
            const int c = col0 + bj * 128;
            const f32x4 b0 = *(const f32x4*)(bg + c), b1 = *(const f32x4*)(bg + c + 4);
#pragma unroll
            for (int ai = 0; ai < 2; ++ai) {
                u32x4 yy[4], zz[4];
#pragma unroll
                for (int m = 0; m < 4; ++m) { const size_t off = (size_t)(row0 + ai * 128 + m * 16) * DI + c; yy[m] = *(const u32x4*)(YB + off); zz[m] = *(const u32x4*)(ZS + off); }
                __builtin_amdgcn_sched_barrier(0);
#pragma unroll
                for (int m = 0; m < 4; ++m) {
                    const size_t off = (size_t)(row0 + ai * 128 + m * 16) * DI + c;
                    f32x4 v0 = acc[ai][bj][m][0] + b0, v1 = acc[ai][bj][m][1] + b1;
                    v0[0] = bflo(yy[m].x) * bflo(zz[m].x) * sigmoidf_(v0[0]); v0[1] = bfhi(yy[m].x) * bfhi(zz[m].x) * sigmoidf_(v0[1]);
                    v0[2] = bflo(yy[m].y) * bflo(zz[m].y) * sigmoidf_(v0[2]); v0[3] = bfhi(yy[m].y) * bfhi(zz[m].y) * sigmoidf_(v0[3]);
                    v1[0] = bflo(yy[m].z) * bflo(zz[m].z) * sigmoidf_(v1[0]); v1[1] = bfhi(yy[m].z) * bfhi(zz[m].z) * sigmoidf_(v1[1]);
                    v1[2] = bflo(yy[m].w) * bflo(zz[m].w) * sigmoidf_(v1[2]); v1[3] = bfhi(yy[m].w) * bfhi(zz[m].w) * sigmoidf_(v1[3]);
                    u32x4 w; w.x = pk2(v0[0], v0[1]); w.y = pk2(v0[2], v0[3]); w.z = pk2(v1[0], v1[1]); w.w = pk2(v1[2], v1[3]);
                    *(u32x4*)(Y2 + off) = w; }
                __builtin_amdgcn_sched_barrier(0);
            } }
    }
};
struct EpiOut {
    static constexpr bool PERM = false, AFTER_DRAIN = false, KSCALE = false;
    const float* X; float* R; const float* gate;
    __device__ __forceinline__ void operator()(const Acc& acc, const Unit& u, int wr, int wc, int fr, int fq) const {
        const int row0 = u.pm * 256 + wr * 64 + fr, col0 = u.pn * 256 + wc * 32 + 4 * fq;
        f32x4 gv[2][2];
#pragma unroll
        for (int bj = 0; bj < 2; ++bj)
#pragma unroll
            for (int n = 0; n < 2; ++n) gv[bj][n] = *(const f32x4*)(gate + col0 + bj * 128 + n * 16) + 1.0f;
#pragma unroll
        for (int ai = 0; ai < 2; ++ai)
#pragma unroll
            for (int m = 0; m < 4; ++m) {
                const size_t off = (size_t)(row0 + ai * 128 + m * 16) * DM + col0;
#pragma unroll
                for (int bj = 0; bj < 2; ++bj)
#pragma unroll
                    for (int n = 0; n < 2; ++n) {
                        const f32x4 xv = *(const f32x4*)(X + off + bj * 128 + n * 16);
                        *(f32x4*)(R + off + bj * 128 + n * 16) = xv * DN_ALPHA + gv[bj][n] * acc[ai][bj][m][n]; } }
    }
};

template <bool RS> struct EpiOutLn {
    static constexpr bool PERM = false, AFTER_DRAIN = true, KSCALE = RS;
    const float* part;
    __device__ __forceinline__ void prologue(const Unit& u, LAS unsigned char* lds, int tid) const {
        LAS float* RT = (LAS float*)(lds + LDS_RT);
        if (tid < 256) {
            const int t = u.pm * 256 + tid, c = t >> 6, tl = t & 63; float r[4];
#pragma unroll
            for (int h = 0; h < 4; ++h) { const float* pp = part + (((size_t)c * 4 + h) * 8) * 64 + tl; float sm = 0.f;
#pragma unroll
                for (int q = 0; q < 8; ++q) sm += pp[q * 64];
                r[h] = rsqrtf(sm * (1.0f / 1024.0f) + 1e-6f); }
            RT[tid] = r[0] / r[1]; RT[256 + tid] = r[1] / r[2]; RT[512 + tid] = r[2] / r[3]; RT[768 + tid] = r[3];
        }
        asm volatile("s_waitcnt vmcnt(0) lgkmcnt(0)" ::: "memory"); __syncthreads();
    }
    __device__ __forceinline__ void kscale(Acc& acc, int hb, LAS unsigned char* lds, int wr, int fr) const {
        const LAS float* RT = (const LAS float*)(lds + LDS_RT) + hb * 256 + wr * 64 + fr;
#pragma unroll
        for (int ai = 0; ai < 2; ++ai)
#pragma unroll
            for (int m = 0; m < 4; ++m) { const float f = RT[ai * 128 + m * 16];
#pragma unroll
                for (int bj = 0; bj < 2; ++bj)
#pragma unroll
                    for (int n = 0; n < 2; ++n) acc[ai][bj][m][n] *= f; }
    }
    const float* X; float* Xo; bf16_t* U; const float* gate; const float* lng; const float* lnb; const float* modn;
    unsigned long long* xbuf; unsigned* cnt;
    __device__ __forceinline__ void operator()(const Acc&, const Unit&, int, int, int, int) const {}
    __device__ __forceinline__ void fused(Acc& acc, const Unit& u, int wr, int wc, int fr, int fq, LAS unsigned char* lds, int wid, int lane) const {
        LAS f32x2* P = (LAS f32x2*)lds;
        LAS f32x2* S = (LAS f32x2*)(lds + 8192);
        const int row0 = u.pm * 256 + wr * 64 + fr, col0 = u.pn * 256 + wc * 32 + 4 * fq;
        if constexpr (RS) kscale(acc, 3, lds, wr, fr);
        {
            f32x4 gv[2][2];
#pragma unroll
            for (int bj = 0; bj < 2; ++bj)
#pragma unroll
                for (int n = 0; n < 2; ++n) gv[bj][n] = *(const f32x4*)(gate + col0 + bj * 128 + n * 16) + 1.0f;
#pragma unroll
            for (int ai = 0; ai < 2; ++ai)
#pragma unroll
                for (int m = 0; m < 4; ++m) {
                    const size_t off = (size_t)(row0 + ai * 128 + m * 16) * DM + col0;
#pragma unroll
                    for (int bj = 0; bj < 2; ++bj)
#pragma unroll
                        for (int n = 0; n < 2; ++n) { const f32x4 xv = *(const f32x4*)(X + off + bj * 128 + n * 16); acc[ai][bj][m][n] = xv * DN_ALPHA + gv[bj][n] * acc[ai][bj][m][n]; }
                    asm volatile("" : "+v"(acc[ai][0][m][0]), "+v"(acc[ai][0][m][1]), "+v"(acc[ai][1][m][0]), "+v"(acc[ai][1][m][1]));
                    if (m & 1) asm volatile("" ::: "memory"); }
        }
#pragma unroll
        for (int ai = 0; ai < 2; ++ai)
#pragma unroll
            for (int m = 0; m < 4; ++m) {
                float sm = 0.f;
#pragma unroll
                for (int bj = 0; bj < 2; ++bj)
#pragma unroll
                    for (int n = 0; n < 2; ++n) { const f32x4 x = acc[ai][bj][m][n]; sm += (x[0] + x[1]) + (x[2] + x[3]); }
                sm += __shfl_xor(sm, 16); sm += __shfl_xor(sm, 32);
                const float mw = sm * (1.0f / 64.0f); float q = 0.f;
#pragma unroll
                for (int bj = 0; bj < 2; ++bj)
#pragma unroll
                    for (int n = 0; n < 2; ++n) { const f32x4 d = acc[ai][bj][m][n] - mw; q += (d[0] * d[0] + d[1] * d[1]) + (d[2] * d[2] + d[3] * d[3]); }
                q += __shfl_xor(q, 16); q += __shfl_xor(q, 32);
                if (fq == 0) P[(ai * 128 + wr * 64 + m * 16 + fr) * 4 + wc] = (f32x2){mw, q};
            }
        asm volatile("s_waitcnt lgkmcnt(0)" ::: "memory"); __builtin_amdgcn_s_barrier(); asm volatile("" ::: "memory");
        const int row = wid * 32 + (lane & 31);
        if (lane < 32) {
            const f32x2 a = P[row * 4 + 0], b = P[row * 4 + 1], c = P[row * 4 + 2], d = P[row * 4 + 3];
            const float mt = (a.x + b.x + c.x + d.x) * 0.25f;
            const float da = a.x - mt, db = b.x - mt, dc = c.x - mt, dd = d.x - mt;
            const float m2 = (a.y + b.y) + (c.y + d.y) + 64.0f * ((da * da + db * db) + (dc * dc + dd * dd));
            unsigned long long* slot = xbuf + ((size_t)(u.pm * 256 + row) * 8 + u.pn);
            __hip_atomic_store(slot, ((unsigned long long)__float_as_uint(m2) << 32) | __float_as_uint(mt), __ATOMIC_RELAXED, __HIP_MEMORY_SCOPE_AGENT);
        }
        asm volatile("s_waitcnt vmcnt(0)" ::: "memory");
        if (lane == 0) __hip_atomic_fetch_add(cnt + 64 * u.pm, 1u, __ATOMIC_RELAXED, __HIP_MEMORY_SCOPE_AGENT);
        if (wid == 0) {
            for (unsigned sp = 0; sp < (1u << 22); ++sp) {
                if ((unsigned)__builtin_amdgcn_readfirstlane(__hip_atomic_load(cnt + 64 * u.pm, __ATOMIC_RELAXED, __HIP_MEMORY_SCOPE_AGENT)) >= 64u) break;
                __builtin_amdgcn_s_sleep(2);
            }
            __builtin_amdgcn_fence(__ATOMIC_ACQUIRE, "agent");
        }
        asm volatile("s_waitcnt vmcnt(0) lgkmcnt(0)" ::: "memory"); __builtin_amdgcn_s_barrier(); asm volatile("" ::: "memory");
        if (lane < 32) {
            const unsigned long long* slot = xbuf + (size_t)(u.pm * 256 + row) * 8; float mt[8], m2[8]; float ms = 0.f;
#pragma unroll
            for (int t = 0; t < 8; ++t) { const unsigned long long wv = __hip_atomic_load(slot + t, __ATOMIC_RELAXED, __HIP_MEMORY_SCOPE_AGENT); mt[t] = __uint_as_float((unsigned)wv); m2[t] = __uint_as_float((unsigned)(wv >> 32)); ms += mt[t]; }
            const float mean = ms * 0.125f; float q = 0.f;
#pragma unroll
            for (int t = 0; t < 8; ++t) { const float dm = mt[t] - mean; q += m2[t] + 256.0f * dm * dm; }
            S[row] = (f32x2){mean, rsqrtf(q * (1.0f / 2048.0f) + 1e-5f)};
        }
        asm volatile("s_waitcnt lgkmcnt(0)" ::: "memory"); __builtin_amdgcn_s_barrier(); asm volatile("" ::: "memory");
#pragma unroll
        for (int bj = 0; bj < 2; ++bj)
#pragma unroll
            for (int n = 0; n < 2; ++n) {
                const int col = col0 + bj * 128 + n * 16;
                const f32x4 g4 = *(const f32x4*)(lng + col), b4 = *(const f32x4*)(lnb + col);
                f32x4 sc4 = {0.f, 0.f, 0.f, 0.f}, sh4 = sc4;
                if (modn) { sh4 = *(const f32x4*)(modn + col); sc4 = *(const f32x4*)(modn + 2048 + col) + 1.0f; }
#pragma unroll
                for (int ai = 0; ai < 2; ++ai)
#pragma unroll
                    for (int m = 0; m < 4; ++m) {
                        const int r = ai * 128 + wr * 64 + m * 16 + fr; const f32x2 sr = S[r];
                        const size_t off = (size_t)(u.pm * 256 + r) * DM + col;
                        const f32x4 y = (acc[ai][bj][m][n] - sr.x) * sr.y * g4 + b4;
                        *(f32x4*)(Xo + off) = y;
                        if (modn) { const f32x4 uv = y * sc4 + sh4; u32x2 wv; wv.x = pk2(uv[0], uv[1]); wv.y = pk2(uv[2], uv[3]); *(u32x2*)(U + off) = wv; }
                        if (m & 1) asm volatile("" ::: "memory");
                    }
                asm volatile("" ::: "memory");
            }
    }
};

__device__ __forceinline__ void conv_job(const Ctx cx, LAS unsigned char* lds, const float* src, const int K, const int sstride, const int col0, const int ncols, bf16_t* dst, const int ldd) {
    const int tid = cx.tid, G = cx.G;
    const int ntn = ncols >> 7, ntiles = ntn * (K >> 6);
    LAS unsigned* T = (LAS unsigned*)lds;
    const int c4 = tid & 31, rp = tid >> 5;
    f32x4 va[4], vb[4];
#define CONV_LOAD(v, tile) do { const int tk_ = (tile) / ntn, tn_ = (tile) % ntn; \
        const float* s_ = src + (size_t)(tk_ * 64 + 2 * rp) * sstride + col0 + tn_ * 128 + 4 * c4; \
        v[0] = __builtin_nontemporal_load((const f32x4*)s_); v[1] = __builtin_nontemporal_load((const f32x4*)(s_ + sstride)); v[2] = __builtin_nontemporal_load((const f32x4*)(s_ + (size_t)32 * sstride)); v[3] = __builtin_nontemporal_load((const f32x4*)(s_ + (size_t)33 * sstride)); } while (0)
#define CONV_OUT(v, tile, nexttile) do { \
        _Pragma("unroll") for (int j = 0; j < 4; ++j) { T[(4 * c4 + j) * 33 + rp] = pk2(v[0][j], v[1][j]); T[(4 * c4 + j) * 33 + rp + 16] = pk2(v[2][j], v[3][j]); } \
        if ((nexttile) < ntiles) CONV_LOAD(v, nexttile); \
        __syncthreads(); \
        { const int tk = (tile) / ntn, tn = (tile) % ntn; const int n = tid >> 2, qq = tid & 3; \
          u32x4 w0, w1; const LAS unsigned* tp = T + n * 33 + 8 * qq; \
          w0.x = tp[0]; w0.y = tp[1]; w0.z = tp[2]; w0.w = tp[3]; w1.x = tp[4]; w1.y = tp[5]; w1.z = tp[6]; w1.w = tp[7]; \
          bf16_t* d = dst + (size_t)(tn * 128 + n) * ldd + tk * 64 + 16 * qq; \
          *(u32x4*)d = w0; *(u32x4*)(d + 8) = w1; } \
        __syncthreads(); } while (0)
    int t = cx.bid;
    if (t < ntiles) CONV_LOAD(va, t);
    if (t + G < ntiles) CONV_LOAD(vb, t + G);
    for (; t < ntiles; t += 2 * G) {
        CONV_OUT(va, t, t + 2 * G);
        if (t + G < ntiles) CONV_OUT(vb, t + G, t + 3 * G);
    }
#undef CONV_LOAD
#undef CONV_OUT
}

__device__ __forceinline__ void s5_tables(const Ctx cx, KP p, LAS unsigned char* lds, const int j) {
    const int tid = cx.tid;
    LAS float* LP = (LAS float*)lds;
    LAS float* BB = LP + 17 * 64 * 2;
    LAS float* CC = BB + 2048;
    LAS float* KT = CC + 2048;
    LAS float* CF = KT + 4096;
    bf16_t* MG = (bf16_t*)(p->ws + WS_MG); bf16_t* WE = (bf16_t*)(p->ws + WS_WE); float* LT = (float*)(p->ws + WS_LAMT);
    for (int g = cx.bid; g < 256; g += cx.G) {
        __syncthreads();
        const int jg = j * 256 + g;
        if (tid < 64) {
            const float are = p->s5_a_re[jg * 64 + tid], aim = p->s5_a_im[jg * 64 + tid], dt = expf(p->s5_log_dt[jg]);
            const float mag = expf(are * dt), ang = aim * dt;
            const float lbr = mag * cosf(ang), lbi = mag * sinf(ang);
            const float nr = lbr - 1.0f, den = are * are + aim * aim;
            CF[2 * tid] = (nr * are + lbi * aim) / den; CF[2 * tid + 1] = (lbi * are - nr * aim) / den;
            for (int n = 0; n <= 16; ++n) { const float mm = expf(are * dt * (float)n), a = ang * (float)n; LP[(n * 64 + tid) * 2] = mm * cosf(a); LP[(n * 64 + tid) * 2 + 1] = mm * sinf(a); }
        }
        __syncthreads();
        for (int idx = tid; idx < 1024; idx += NT) {
            const int pp = idx >> 4;
            const float br = p->s5_b_re[(size_t)jg * 1024 + idx], bi = p->s5_b_im[(size_t)jg * 1024 + idx], cr = CF[2 * pp], ci = CF[2 * pp + 1];
            BB[idx * 2] = cr * br - ci * bi; BB[idx * 2 + 1] = cr * bi + ci * br;
            CC[idx * 2] = p->s5_c_re[(size_t)jg * 1024 + idx]; CC[idx * 2 + 1] = p->s5_c_im[(size_t)jg * 1024 + idx];
        }
        __syncthreads();
        {
            const int tau = tid >> 5, o = (tid >> 1) & 15, i0 = (tid & 1) * 8;
            float acc8[8];
#pragma unroll
            for (int jj = 0; jj < 8; ++jj) acc8[jj] = 0.f;
            for (int pp = 0; pp < 64; ++pp) {
                const float Lr = LP[(tau * 64 + pp) * 2], Li = LP[(tau * 64 + pp) * 2 + 1], Cr = CC[(o * 64 + pp) * 2], Ci = CC[(o * 64 + pp) * 2 + 1];
                const float Gr = Cr * Lr - Ci * Li, Gi = Cr * Li + Ci * Lr;
                const LAS f32x4* bp = (const LAS f32x4*)(BB + (pp * 16 + i0) * 2);
#pragma unroll
                for (int v4 = 0; v4 < 4; ++v4) { const f32x4 bb = bp[v4]; acc8[2 * v4] += Gr * bb[0] - Gi * bb[1]; acc8[2 * v4 + 1] += Gr * bb[2] - Gi * bb[3]; }
            }
#pragma unroll
            for (int jj = 0; jj < 8; ++jj) KT[(tau * 16 + o) * 16 + i0 + jj] = acc8[jj];
        }
        __syncthreads();
        bf16_t* Mg = MG + (size_t)g * 256 * 384;
        for (int it = 0; it < 24; ++it) {
            const int v = tid + NT * it, row = v / 48, kc = (v % 48) * 8, t = row >> 4, o = row & 15;
            float val[8];
            if (kc < 256) { const int s = kc >> 4, i0 = kc & 15;
#pragma unroll
                for (int jj = 0; jj < 8; ++jj) val[jj] = (t >= s) ? KT[((t - s) * 16 + o) * 16 + i0 + jj] : 0.f;
            } else { const int n0 = kc - 256;
#pragma unroll
                for (int jj = 0; jj < 8; ++jj) { const int pp = (n0 + jj) & 63;
                    const float Lr = LP[((t + 1) * 64 + pp) * 2], Li = LP[((t + 1) * 64 + pp) * 2 + 1], Cr = CC[(o * 64 + pp) * 2], Ci = CC[(o * 64 + pp) * 2 + 1];
                    val[jj] = (n0 < 64) ? (Cr * Lr - Ci * Li) : -(Cr * Li + Ci * Lr); } }
            u32x4 w; w.x = pk2(val[0], val[1]); w.y = pk2(val[2], val[3]); w.z = pk2(val[4], val[5]); w.w = pk2(val[6], val[7]);
            *(u32x4*)(Mg + (size_t)row * 384 + kc) = w;
        }
        bf16_t* We = WE + (size_t)g * 128 * 256;
        for (int it = 0; it < 8; ++it) {
            const int v = tid + NT * it, n = v >> 5, kc = (v & 31) * 8, s = kc >> 4, i0 = kc & 15, pp = n & 63;
            const float Lr = LP[((15 - s) * 64 + pp) * 2], Li = LP[((15 - s) * 64 + pp) * 2 + 1];
            float val[8];
#pragma unroll
            for (int jj = 0; jj < 8; ++jj) { const float Br = BB[(pp * 16 + i0 + jj) * 2], Bi = BB[(pp * 16 + i0 + jj) * 2 + 1]; val[jj] = (n < 64) ? (Lr * Br - Li * Bi) : (Lr * Bi + Li * Br); }
            u32x4 w; w.x = pk2(val[0], val[1]); w.y = pk2(val[2], val[3]); w.z = pk2(val[4], val[5]); w.w = pk2(val[6], val[7]);
            *(u32x4*)(We + (size_t)n * 256 + kc) = w;
        }
        if (tid < 128) LT[g * 128 + tid] = LP[(16 * 64 + (tid & 63)) * 2 + (tid >> 6)];
    }
    __syncthreads();
}

__device__ __forceinline__ void phase_prep(const Ctx cx, KP p, LAS unsigned char* lds) {
    const int tid = cx.tid, G = cx.G;
    float* modp = (float*)(p->ws + WS_MODP);
    for (int it = cx.bid; it < 256; it += G) {
        const int l = it >> 6, dc = it & 63;
        f32x4 a0 = {0.f, 0.f, 0.f, 0.f}, a1 = a0, a2 = a0;
        const float* wp = p->ada_w + ((size_t)l * DM + dc * 32) * 6144 + 4 * tid;
#pragma unroll 8
        for (int r = 0; r < 32; ++r) {
            const float s = siluf_(p->c[dc * 32 + r]);
            a0 += s * __builtin_nontemporal_load((const f32x4*)(wp + (size_t)r * 6144)); a1 += s * __builtin_nontemporal_load((const f32x4*)(wp + (size_t)r * 6144 + 2048)); a2 += s * __builtin_nontemporal_load((const f32x4*)(wp + (size_t)r * 6144 + 4096));
        }
        float* o = modp + ((size_t)dc * 4 + l) * 6144 + 4 * tid;
        *(f32x4*)o = a0; *(f32x4*)(o + 2048) = a1; *(f32x4*)(o + 4096) = a2;
    }
    { bf16_t* wgt = (bf16_t*)(p->ws + WS_WGT);
      for (int idx = cx.bid * NT + tid; idx < 65536; idx += G * NT) { const int j = idx >> 15, r = (idx >> 11) & 15, d = idx & 2047; wgt[idx] = (bf16_t)(pk2(p->gla_w_in[((size_t)j * DM + d) * GLA_W + 10240 + r], 0.f) & 0xffffu); } }
    for (int j = 0; j < 2; ++j) {
        bf16_t* wg = (bf16_t*)(p->ws + WS_WG) + (size_t)j * 10240 * DM;
        const float* src = p->gla_w_in + (size_t)j * DM * GLA_W;
        conv_job(cx, lds, src, DM, GLA_W, 0, 1024, wg, DM);
        conv_job(cx, lds, src, DM, GLA_W, 6144, 4096, wg + (size_t)1024 * DM, DM);
        conv_job(cx, lds, src, DM, GLA_W, 1024, 1024, wg + (size_t)5120 * DM, DM);
        conv_job(cx, lds, src, DM, GLA_W, 2048, 4096, wg + (size_t)6144 * DM, DM);
        conv_job(cx, lds, p->gla_w_out + (size_t)j * DI * DM, DI, DM, 0, DM, (bf16_t*)(p->ws + WS_WGO) + (size_t)j * DM * DI, DI);
        conv_job(cx, lds, p->s5_w_in + (size_t)j * DM * 8192, DM, 8192, 0, 8192, (bf16_t*)(p->ws + WS_WSI) + (size_t)j * 8192 * DM, DM);
        conv_job(cx, lds, p->s5_w_glu + (size_t)j * DI * DI, DI, DI, 0, DI, (bf16_t*)(p->ws + WS_WGLU) + (size_t)j * DI * DI, DI);
        conv_job(cx, lds, p->s5_w_out + (size_t)j * DI * DM, DI, DM, 0, DM, (bf16_t*)(p->ws + WS_WSO) + (size_t)j * DM * DI, DI);
    }
    s5_tables(cx, p, lds, 0);
}

__device__ __forceinline__ void phase_mod_u0(const Ctx cx, KP p) {
    const int tid = cx.tid, G = cx.G;
    const float* modp = (const float*)(p->ws + WS_MODP); float* mod = (float*)(p->ws + WS_MOD);
    for (int idx = cx.bid * NT + tid; idx < 24576; idx += G * NT) {
        const int l = idx / 6144, e = idx % 6144; float s = p->ada_b[idx];
        for (int dc = 0; dc < 64; ++dc) s += modp[((size_t)dc * 4 + l) * 6144 + e];
        mod[idx] = s;
    }
    f32x4 sh = *(const f32x4*)(p->ada_b + 4 * tid), sc = *(const f32x4*)(p->ada_b + 2048 + 4 * tid);
    for (int dc = 0; dc < 64; ++dc) { sh += *(const f32x4*)(modp + (size_t)dc * 4 * 6144 + 4 * tid); sc += *(const f32x4*)(modp + (size_t)dc * 4 * 6144 + 2048 + 4 * tid); }
    sc += 1.0f;
    bf16_t* U = (bf16_t*)(p->ws + WS_U);
    for (int row0 = cx.bid; row0 < SEQ; row0 += 8 * G) {
        f32x4 xv[8];
#pragma unroll
        for (int i = 0; i < 8; ++i) { const int row = row0 + i * G; if (row < SEQ) xv[i] = *(const f32x4*)(p->x + (size_t)row * DM + 4 * tid); }
#pragma unroll
        for (int i = 0; i < 8; ++i) { const int row = row0 + i * G; if (row < SEQ) { const f32x4 uv = xv[i] * sc + sh; u32x2 w; w.x = pk2(uv[0], uv[1]); w.y = pk2(uv[2], uv[3]); *(u32x2*)(U + (size_t)row * DM + 4 * tid) = w; } }
    }
}

__device__ __forceinline__ void gla_glr(const Ctx cx, KP p, LAS unsigned char* lds, const int j) {
    const int tid = cx.tid, w = __builtin_amdgcn_readfirstlane(tid >> 6), lane = tid & 63, fr = lane & 15, fq = lane >> 4;
    const bf16_t* U = (const bf16_t*)(p->ws + WS_U); const bf16_t* wgt = (const bf16_t*)(p->ws + WS_WGT) + (size_t)j * 16 * DM;
    float* glr = (float*)(p->ws + WS_ACT + ACT_GLR);
    if (cx.G == 256) {
        const int task = cx.bid * 8 + w, tile = task >> 2, kq = task & 3;
        const bf16_t* up = U + (size_t)(tile * 16 + fr) * DM + kq * 512 + 8 * fq; const bf16_t* wp = wgt + (size_t)fr * DM + kq * 512 + 8 * fq;
        f32x4 acc = {0.f, 0.f, 0.f, 0.f};
#pragma unroll
        for (int sx = 0; sx < 16; ++sx) { const bf16x8 a = *(const bf16x8*)(up + 32 * sx), b = *(const bf16x8*)(wp + 32 * sx); acc = __builtin_amdgcn_mfma_f32_16x16x32_bf16(a, b, acc, 0, 0, 0); }
        LAS f32x4* red = (LAS f32x4*)lds;
        red[w * 64 + lane] = acc;
        __syncthreads();
        if (kq == 0) {
            const f32x4 t4 = (red[w * 64 + lane] + red[(w + 1) * 64 + lane]) + (red[(w + 2) * 64 + lane] + red[(w + 3) * 64 + lane]);
#pragma unroll
            for (int jj = 0; jj < 4; ++jj) glr[(tile * 16 + 4 * fq + jj) * 16 + fr] = t4[jj];
        }
        __syncthreads();
        return;
    }
    for (int tile = cx.bid + cx.G * w; tile < 512; tile += cx.G * 8) {
        const bf16_t* up = U + (size_t)(tile * 16 + fr) * DM + 8 * fq; const bf16_t* wp = wgt + (size_t)fr * DM + 8 * fq;
        f32x4 acc = {0.f, 0.f, 0.f, 0.f};
#pragma unroll 16
        for (int sx = 0; sx < 64; ++sx) { const bf16x8 a = *(const bf16x8*)(up + 32 * sx), b = *(const bf16x8*)(wp + 32 * sx); acc = __builtin_amdgcn_mfma_f32_16x16x32_bf16(a, b, acc, 0, 0, 0); }
#pragma unroll
        for (int jj = 0; jj < 4; ++jj) glr[(tile * 16 + 4 * fq + jj) * 16 + fr] = acc[jj];
    }
}

__device__ __forceinline__ void gla_decay(const Ctx cx, KP p, LAS unsigned char* lds, const int j) {
    const int tid = cx.tid, G = cx.G;
    const float* glr = (const float*)(p->ws + WS_ACT + ACT_GLR); float* etot = (float*)(p->ws + WS_ACT + ACT_ETOT);
    const bf16_t* KT = (const bf16_t*)(p->ws + WS_ACT + ACT_KT); bf16_t* KD = (bf16_t*)(p->ws + WS_ACT + ACT_KD);
    LAS float* gl = (LAS float*)lds;
    for (int it = cx.bid; it < 256; it += G) {
        const int c = it >> 1, kk = (it & 1) * 512 + tid;
        __syncthreads();
        gl[tid] = glr[c * 1024 + tid]; gl[tid + 512] = glr[c * 1024 + 512 + tid];
        __syncthreads();
        float w2[16];
#pragma unroll
        for (int r = 0; r < 16; ++r) w2[r] = p->gla_gate_w2[((size_t)j * 16 + r) * NQK + kk];
        const float gb = p->gla_gate_b[j * NQK + kk];
        const bf16_t* kp = KT + (size_t)kk * SEQ + c * 64; bf16_t* ko = KD + (size_t)kk * SEQ + c * 64;
        u32x4 kin[8];
#pragma unroll
        for (int q = 0; q < 8; ++q) kin[q] = *(const u32x4*)(kp + q * 8);
        float cum[64]; float run = 0.f;
#pragma unroll
        for (int t = 0; t < 64; ++t) {
            float xx = gb;
#pragma unroll
            for (int r4 = 0; r4 < 4; ++r4) { const f32x4 gv = *(const LAS f32x4*)(gl + t * 16 + r4 * 4); xx += gv[0] * w2[r4 * 4] + gv[1] * w2[r4 * 4 + 1] + gv[2] * w2[r4 * 4 + 2] + gv[3] * w2[r4 * 4 + 3]; }
            const float la = -(fmaxf(-xx, 0.f) + __logf(1.0f + __expf(-fabsf(xx)))) * 0.0625f;
            run += la; cum[t] = run;
        }
        etot[c * 1024 + kk] = __expf(run);
#pragma unroll
        for (int q = 0; q < 8; ++q) {
            u32x4 kv = kin[q];
            kv.x = pk2(bflo(kv.x) * __expf(run - cum[q * 8 + 0]), bfhi(kv.x) * __expf(run - cum[q * 8 + 1]));
            kv.y = pk2(bflo(kv.y) * __expf(run - cum[q * 8 + 2]), bfhi(kv.y) * __expf(run - cum[q * 8 + 3]));
            kv.z = pk2(bflo(kv.z) * __expf(run - cum[q * 8 + 4]), bfhi(kv.z) * __expf(run - cum[q * 8 + 5]));
            kv.w = pk2(bflo(kv.w) * __expf(run - cum[q * 8 + 6]), bfhi(kv.w) * __expf(run - cum[q * 8 + 7]));
            *(u32x4*)(ko + q * 8) = kv;
        }
    }
}

template <bool P2>
__device__ __forceinline__ void gla_scan2(const Ctx cx, KP p, LAS unsigned char* lds, const int j) {
    const int tid = cx.tid, w = __builtin_amdgcn_readfirstlane(tid >> 6), lane = tid & 63, fr = lane & 15, fq = lane >> 4;
    const bf16_t* QS = (const bf16_t*)(p->ws + WS_ACT + ACT_QS); const bf16_t* KT = (const bf16_t*)(p->ws + WS_ACT + ACT_KD);
    const bf16_t* VT = (const bf16_t*)(p->ws + WS_ACT + ACT_Y2); const bf16_t* ZS = (const bf16_t*)(p->ws + WS_ACT + ACT_ZS);
    bf16_t* Y = (bf16_t*)(p->ws + WS_ACT + ACT_YB); const float* etot = (const float*)(p->ws + WS_ACT + ACT_ETOT); float* part = (float*)(p->ws + WS_ACT + ACT_SSQ);
    float* SEND = (float*)(p->ws + WS_ACT + ACT_E); float* DSEG = (float*)(p->ws + WS_ACT + ACT_DSEG);
    const float* ng = p->gla_norm_g + (size_t)j * DI;
    LAS unsigned char* KD = lds;
    LAS unsigned char* QP = lds + 36864;
    LAS float* ET = (LAS float*)(lds + 36864 + 33792);
    LAS float* SQ = ET + 256;
    LAS unsigned char* ZT = lds + 73728;
    LAS unsigned char* YT = lds + 91136;
    for (int it = cx.bid; it < 256; it += cx.G) {
        const int xcd = it & 7, idx = it >> 3, P = xcd * 4 + (idx >> 3), h = P >> 3, seg = P & 7, slice = idx & 7;
        if (!P2 && seg == 7) continue;
        const int dv0 = h * 1024 + slice * 128 + 16 * w, c0 = seg * 16;
        const unsigned kgo = (unsigned)((h * 256 + (tid >> 3)) * SEQ + (tid & 7) * 8) * 2u;
        const unsigned qgo = (unsigned)((tid >> 5) * NQK + h * 256 + (tid & 31) * 8) * 2u;
        const unsigned ego = (unsigned)(h * 256 + 4 * (tid & 63)) * 4u;
        const unsigned vgo = (unsigned)((dv0 + fr) * SEQ + 8 * fq) * 2u;
        const unsigned zto = (unsigned)((tid >> 4) * DI + h * 1024 + slice * 128) * 2u + (unsigned)(tid & 15) * 16u;
        const unsigned ztl = (unsigned)(tid >> 4) * 272u + (unsigned)(tid & 15) * 16u, zfl = (unsigned)fr * 272u + (unsigned)(16 * w + 4 * fq) * 2u;
        const unsigned kl = (tid >> 3) * 144 + (tid & 7) * 16, ql = (tid >> 5) * 528 + (tid & 31) * 16;
        f32x4 S[16];
#pragma unroll
        for (int kt = 0; kt < 16; ++kt) S[kt] = (f32x4){0.f, 0.f, 0.f, 0.f};
        if (P2) {
            for (int sp = 0; sp < seg; ++sp) {
                const float* dp = DSEG + sp * 1024 + h * 256 + 4 * fq;
                const float* se = SEND + ((size_t)(((h * 8 + slice) * 8 + sp) * 8 + w) * 16) * 256 + lane * 4;
                f32x4 dd[16], ee[16];
#pragma unroll
                for (int kt = 0; kt < 16; ++kt) { dd[kt] = *(const f32x4*)(dp + 16 * kt); ee[kt] = *(const f32x4*)(se + kt * 256); }
#pragma unroll
                for (int kt = 0; kt < 16; ++kt) S[kt] = S[kt] * dd[kt] + ee[kt];
            }
        } else if (slice == 0 && tid < 256) {
            float pr = 1.0f;
            for (int c = 0; c < 16; ++c) pr *= etot[(c0 + c) * 1024 + h * 256 + tid];
            DSEG[seg * 1024 + h * 256 + tid] = pr;
        }
        f32x4 g4 = {0.f, 0.f, 0.f, 0.f};
        if (P2) g4 = *(const f32x4*)(ng + dv0 + 4 * fq);
        u32x4 rk[4], rq[4]; f32x4 re = {0.f, 0.f, 0.f, 0.f}; bf16x8 rv0, rv1; u32x4 rz2[2] = {};
#define SC_LOAD(c) do { const int c_ = (c); \
        _Pragma("unroll") for (int i = 0; i < 4; ++i) rk[i] = *(const u32x4*)((const char*)KT + (kgo + (unsigned)(i * 64 * SEQ + c_ * 64) * 2u)); \
        if (P2) { _Pragma("unroll") for (int i = 0; i < 4; ++i) rq[i] = *(const u32x4*)((const char*)QS + (qgo + (unsigned)((c_ * 64 + 16 * i) * NQK) * 2u)); } \
        if (tid < 64) re = *(const f32x4*)((const char*)etot + (ego + (unsigned)c_ * 4096u)); \
        if (P2) { rz2[0] = *(const u32x4*)((const char*)ZS + (zto + (unsigned)(c_ * 64 * DI) * 2u)); rz2[1] = *(const u32x4*)((const char*)ZS + (zto + (unsigned)((c_ * 64 + 32) * DI) * 2u)); } \
        } while (0)
#define SC_LOADV(c) do { const int cv_ = (c); rv0 = *(const bf16x8*)((const char*)VT + (vgo + (unsigned)cv_ * 128u)); rv1 = *(const bf16x8*)((const char*)VT + (vgo + (unsigned)cv_ * 128u + 64u)); } while (0)
        SC_LOAD(c0); SC_LOADV(c0);
#pragma nounroll
        for (int cc = 0; cc < 16; ++cc) {
            const int c = c0 + cc;
            __syncthreads();
            if (P2 && cc > 0) {
#pragma unroll
                for (int i = 0; i < 2; ++i) { const u32x4 yv4 = *(const LAS u32x4*)(YT + ztl + i * 32 * 272); *(u32x4*)((char*)Y + (zto + (unsigned)(((c - 1) * 64 + 32 * i) * DI) * 2u)) = yv4; } }
            if (P2 && cc > 0 && tid < 64) { float sm = 0.f;
#pragma unroll
                for (int ww = 0; ww < 8; ++ww) sm += SQ[ww * 64 + tid];
                part[(((size_t)(c - 1) * 4 + h) * 8 + slice) * 64 + tid] = sm; }
#pragma unroll
            for (int i = 0; i < 4; ++i) *(LAS u32x4*)(KD + kl + i * 9216) = rk[i];
            if (P2) {
#pragma unroll
                for (int i = 0; i < 4; ++i) *(LAS u32x4*)(QP + ql + i * 8448) = rq[i]; }
            if (tid < 64) *(LAS f32x4*)(ET + 4 * tid) = re;
            if (P2) { *(LAS u32x4*)(ZT + ztl) = rz2[0]; *(LAS u32x4*)(ZT + ztl + 32 * 272) = rz2[1]; }
            __syncthreads();
            if (cc + 1 < 16) SC_LOAD(c + 1);
#pragma unroll
            for (int kb = 0; kb < 4; ++kb) {
                f32x4 e[4]; bf16x8 a0[4], a1[4];
#pragma unroll
                for (int i = 0; i < 4; ++i) { const int kt = 4 * kb + i;
                    e[i] = *(const LAS f32x4*)(ET + 16 * kt + 4 * fq);
                    a0[i] = *(const LAS bf16x8*)(KD + (16 * kt + fr) * 144 + fq * 16); a1[i] = *(const LAS bf16x8*)(KD + (16 * kt + fr) * 144 + 64 + fq * 16); }
                __builtin_amdgcn_sched_barrier(0);
#pragma unroll
                for (int i = 0; i < 4; ++i) { const int kt = 4 * kb + i;
                    S[kt] *= e[i];
                    S[kt] = __builtin_amdgcn_mfma_f32_16x16x32_bf16(a0[i], rv0, S[kt], 0, 0, 0);
                    S[kt] = __builtin_amdgcn_mfma_f32_16x16x32_bf16(a1[i], rv1, S[kt], 0, 0, 0); }
                __builtin_amdgcn_sched_barrier(0);
            }
            if (cc + 1 < 16) SC_LOADV(c + 1);
            if (P2) {
                bf16x8 sb[8];
#pragma unroll
                for (int q = 0; q < 8; ++q) { u32x4 t4; t4.x = pk2(S[2 * q][0], S[2 * q][1]); t4.y = pk2(S[2 * q][2], S[2 * q][3]); t4.z = pk2(S[2 * q + 1][0], S[2 * q + 1][1]); t4.w = pk2(S[2 * q + 1][2], S[2 * q + 1][3]); sb[q] = __builtin_bit_cast(bf16x8, t4); }
#pragma unroll
                for (int tt = 0; tt < 4; ++tt) {
                    f32x4 o = {0.f, 0.f, 0.f, 0.f}, o2 = o;
#pragma unroll
                    for (int qh = 0; qh < 2; ++qh) {
                        bf16x8 qf[4];
#pragma unroll
                        for (int q = 0; q < 4; ++q) qf[q] = *(const LAS bf16x8*)(QP + (16 * tt + fr) * 528 + (4 * qh + q) * 64 + fq * 16);
                        __builtin_amdgcn_sched_barrier(0);
#pragma unroll
                        for (int q = 0; q < 4; q += 2) { o = __builtin_amdgcn_mfma_f32_16x16x32_bf16(sb[4 * qh + q], qf[q], o, 0, 0, 0); o2 = __builtin_amdgcn_mfma_f32_16x16x32_bf16(sb[4 * qh + q + 1], qf[q + 1], o2, 0, 0, 0); }
                        __builtin_amdgcn_sched_barrier(0);
                    }
                    o += o2;
                    float sq = (o[0] * o[0] + o[1] * o[1]) + (o[2] * o[2] + o[3] * o[3]);
                    sq += __shfl_xor(sq, 16); sq += __shfl_xor(sq, 32);
                    if (fq == 0) SQ[w * 64 + 16 * tt + fr] = sq;
                    const u32x2 zt = *(const LAS u32x2*)(ZT + zfl + tt * 16 * 272);
                    u32x2 yv; yv.x = pk2(o[0] * g4[0] * bflo(zt.x), o[1] * g4[1] * bfhi(zt.x)); yv.y = pk2(o[2] * g4[2] * bflo(zt.y), o[3] * g4[3] * bfhi(zt.y));
                    *(LAS u32x2*)(YT + zfl + tt * 16 * 272) = yv;
                }
            }
        }
#undef SC_LOAD
#undef SC_LOADV
        if (P2) { __syncthreads();
#pragma unroll
            for (int i = 0; i < 2; ++i) { const u32x4 yv4 = *(const LAS u32x4*)(YT + ztl + i * 32 * 272); *(u32x4*)((char*)Y + (zto + (unsigned)(((c0 + 15) * 64 + 32 * i) * DI) * 2u)) = yv4; }
            if (tid < 64) { float sm = 0.f;
#pragma unroll
                for (int ww = 0; ww < 8; ++ww) sm += SQ[ww * 64 + tid];
                part[(((size_t)(c0 + 15) * 4 + h) * 8 + slice) * 64 + tid] = sm; } }
        if (!P2) {
            float* se = SEND + ((size_t)(((h * 8 + slice) * 8 + seg) * 8 + w) * 16) * 256 + lane * 4;
#pragma unroll
            for (int kt = 0; kt < 16; ++kt) *(f32x4*)(se + kt * 256) = S[kt];
        }
        __syncthreads();
    }
}

__device__ __forceinline__ void gla_rms(const Ctx cx, KP p, LAS unsigned char* lds) {
    const int tid = cx.tid, G = cx.G;
    bf16_t* Y = (bf16_t*)(p->ws + WS_ACT + ACT_YB); const float* part = (const float*)(p->ws + WS_ACT + ACT_SSQ);
    LAS float* ps = (LAS float*)lds;
    LAS float* rsd = ps + 512;
    for (int it = cx.bid; it < 256; it += G) {
        const int c = it >> 1, half = it & 1;
        { const int h = tid >> 7, sg = (tid >> 5) & 3, tl = tid & 31;
          const float* pp = part + (((size_t)c * 4 + h) * 8 + sg * 2) * 64 + half * 32 + tl;
          float s = pp[0] + pp[64];
          __syncthreads();
          ps[tid] = s;
          __syncthreads();
          if (tid < 128) { const int hh = tid >> 5, t2 = tid & 31; const float tot = ps[hh * 128 + t2] + ps[hh * 128 + 32 + t2] + ps[hh * 128 + 64 + t2] + ps[hh * 128 + 96 + t2];
              rsd[tid] = rsqrtf(tot * (1.0f / 1024.0f) + 1e-6f); }
          __syncthreads(); }
        const int t0 = c * 64 + half * 32;
        for (int b = 0; b < 4; ++b) {
            u32x4 y[8];
#pragma unroll
            for (int i = 0; i < 8; ++i) { const int v = tid + (b * 8 + i) * NT; y[i] = *(const u32x4*)(Y + (size_t)(t0 + (v >> 9)) * DI + (v & 511) * 8); }
#pragma unroll
            for (int i = 0; i < 8; ++i) {
                const int v = tid + (b * 8 + i) * NT, tl = v >> 9, col = (v & 511) * 8; const float rs = rsd[(col >> 10) * 32 + tl];
                u32x4 o; o.x = pk2(bflo(y[i].x) * rs, bfhi(y[i].x) * rs); o.y = pk2(bflo(y[i].y) * rs, bfhi(y[i].y) * rs); o.z = pk2(bflo(y[i].z) * rs, bfhi(y[i].z) * rs); o.w = pk2(bflo(y[i].w) * rs, bfhi(y[i].w) * rs);
                *(u32x4*)(Y + (size_t)(t0 + tl) * DI + col) = o; }
        }
    }
}

__device__ __forceinline__ void ln_phase(const Ctx cx, KP p, const int layer) {
    const int tid = cx.tid, w = tid >> 6, lane = tid & 63;
    const float* R = (const float*)(p->ws + WS_ACT + ACT_E); float* Xo = (layer == 3) ? p->out : (float*)(p->ws + WS_X);
    bf16_t* U = (bf16_t*)(p->ws + WS_U);
    const float* g = p->ln_g + layer * DM; const float* b = p->ln_b + layer * DM;
    const float* mod = (const float*)(p->ws + WS_MOD) + (layer < 3 ? (layer + 1) * 6144 : 0);
    for (int row = cx.bid * 8 + w; row < SEQ; row += cx.G * 8) {
        f32x4 v[8]; float s = 0.f;
#pragma unroll
        for (int i = 0; i < 8; ++i) { v[i] = *(const f32x4*)(R + (size_t)row * DM + 256 * i + 4 * lane); s += (v[i][0] + v[i][1]) + (v[i][2] + v[i][3]); }
        s = wave_sum(s); const float mu = s * (1.0f / 2048.0f);
        float q = 0.f;
#pragma unroll
        for (int i = 0; i < 8; ++i) { const f32x4 d = v[i] - mu; q += (d[0] * d[0] + d[1] * d[1]) + (d[2] * d[2] + d[3] * d[3]); }
        q = wave_sum(q); const float rs = rsqrtf(q * (1.0f / 2048.0f) + 1e-5f);
#pragma unroll
        for (int i = 0; i < 8; ++i) {
            const int col = 256 * i + 4 * lane;
            const f32x4 y = (v[i] - mu) * rs * *(const f32x4*)(g + col) + *(const f32x4*)(b + col);
            *(f32x4*)(Xo + (size_t)row * DM + col) = y;
            if (layer < 3) { const f32x4 uv = y * (*(const f32x4*)(mod + 2048 + col) + 1.0f) + *(const f32x4*)(mod + col);
                u32x2 wv; wv.x = pk2(uv[0], uv[1]); wv.y = pk2(uv[2], uv[3]); *(u32x2*)(U + (size_t)row * DM + col) = wv; }
        }
    }
}

__device__ __forceinline__ void s5_carry(const Ctx cx, KP p, LAS unsigned char* lds) {
    const int tid = cx.tid, w = __builtin_amdgcn_readfirstlane(tid >> 6), lane = tid & 63;
    const float* E = (const float*)(p->ws + WS_ACT + ACT_E); bf16_t* UC = (bf16_t*)(p->ws + WS_ACT + ACT_UCAT); const float* LT = (const float*)(p->ws + WS_LAMT);
    LAS float* endst = (LAS float*)lds;
    for (int g = cx.bid; g < 256; g += cx.G) {
        const float lr = LT[g * 128 + lane], li = LT[g * 128 + 64 + lane];
        const float* Eg = E + ((size_t)g * 512 + 64 * w) * 128 + lane;
        float xr = 0.f, xi = 0.f;
        for (int b = 0; b < 2; ++b) {
            float er[32], ei[32];
#pragma unroll
            for (int s = 0; s < 32; ++s) { er[s] = Eg[(32 * b + s) * 128]; ei[s] = Eg[(32 * b + s) * 128 + 64]; }
#pragma unroll
            for (int s = 0; s < 32; ++s) { const float nr = lr * xr - li * xi + er[s], ni = lr * xi + li * xr + ei[s]; xr = nr; xi = ni; }
        }
        __syncthreads();
        endst[w * 128 + lane] = xr; endst[w * 128 + 64 + lane] = xi;
        float pr = lr, pi = li;
#pragma unroll
        for (int q = 0; q < 6; ++q) { const float nr = pr * pr - pi * pi, ni = 2.0f * pr * pi; pr = nr; pi = ni; }
        __syncthreads();
        float cr = 0.f, ci = 0.f;
        for (int ww = 0; ww < w; ++ww) { const float tr = pr * cr - pi * ci + endst[ww * 128 + lane], ti = pr * ci + pi * cr + endst[ww * 128 + 64 + lane]; cr = tr; ci = ti; }
        xr = cr; xi = ci;
        bf16_t* Ug = UC + ((size_t)g * 512 + 64 * w) * 384 + 256 + lane;
        for (int b = 0; b < 2; ++b) {
            float er[32], ei[32];
#pragma unroll
            for (int s = 0; s < 32; ++s) { er[s] = Eg[(32 * b + s) * 128]; ei[s] = Eg[(32 * b + s) * 128 + 64]; }
#pragma unroll
            for (int s = 0; s < 32; ++s) {
                Ug[(size_t)(32 * b + s) * 384] = (bf16_t)(pk2(xr, 0.f) & 0xffffu); Ug[(size_t)(32 * b + s) * 384 + 64] = (bf16_t)(pk2(xi, 0.f) & 0xffffu);
                const float nr = lr * xr - li * xi + er[s], ni = lr * xi + li * xr + ei[s]; xr = nr; xi = ni; }
        }
    }
}

#define XB_TMO      128
#define XB_XCNT(j)  (256  + 64 * (j))
#define XB_XSUB(j)  (1280 + 64 * (j))
#define XB_XGEN(j)  (2304 + 64 * (j))
#define XB_TOP      3328
#define XB_TOPGEN   3392
#define XCD_BAR_WORDS 3456
#define XB_SPIN_CAP (1u << 18)
__device__ __forceinline__ unsigned xb_ld(unsigned* p)              { return __hip_atomic_load(p, __ATOMIC_RELAXED, __HIP_MEMORY_SCOPE_AGENT); }
__device__ __forceinline__ unsigned xb_add(unsigned* p, unsigned v) { return __hip_atomic_fetch_add(p, v, __ATOMIC_RELAXED, __HIP_MEMORY_SCOPE_AGENT); }
__device__ __forceinline__ unsigned xb_xcc_id() { return (unsigned)__builtin_amdgcn_s_getreg((3 << 11) | 20) & 0xFu; }
#define XB_SPIN(cond, bar) do { unsigned _sp = 0; while (cond) { __builtin_amdgcn_s_sleep(1); \
    if ((++_sp & 255u) == 0u) { if (xb_ld(&(bar)[XB_TMO])) break; if (_sp > XB_SPIN_CAP) { atomicAdd(&(bar)[XB_TMO], 1u); break; } } } } while (0)
struct XcdBarrier { unsigned* bar; unsigned x; volatile LAS unsigned* st; };
__device__ __forceinline__ XcdBarrier xcd_barrier_post(unsigned* bar, volatile LAS unsigned* st) {
    XcdBarrier b; b.bar = bar; b.x = xb_xcc_id(); b.st = st;
    if (threadIdx.x == 0) (void)xb_add(&bar[XB_XCNT(b.x)], 1u);
    return b;
}
__device__ __forceinline__ void xcd_barrier_complete(unsigned* bar, unsigned x, unsigned& nloc, unsigned& nx) {
    const unsigned G = gridDim.x * gridDim.y * gridDim.z;
    unsigned sum, cnt, mine, sp = 0u;
    for (;;) {
        sum = 0u; cnt = 0u; mine = 0u;
#pragma unroll
        for (unsigned j = 0; j < 16; ++j) { const unsigned c = xb_ld(&bar[XB_XCNT(j)]); sum += c; cnt += (c > 0u) ? 1u : 0u; mine = (j == x) ? c : mine; }
        if (sum == G) break;
        __builtin_amdgcn_s_sleep(1);
        if ((++sp & 255u) == 0u) { if (xb_ld(&bar[XB_TMO])) break; if (sp > XB_SPIN_CAP) { atomicAdd(&bar[XB_TMO], 1u); break; } }
    }
    nloc = mine > 0u ? mine : 1u; nx = cnt > 0u ? cnt : 1u;
}
__device__ __forceinline__ void xcd_barrier(const XcdBarrier& b) {
    asm volatile("s_waitcnt vmcnt(0)" ::: "memory");
    __syncthreads();
    if (threadIdx.x == 0) {
        unsigned* bar = b.bar;
        __builtin_amdgcn_s_waitcnt(0);
        unsigned nloc = b.st[0], nx = b.st[1];
        if (nloc == 0u) { xcd_barrier_complete(bar, b.x, nloc, nx); b.st[0] = nloc; b.st[1] = nx; }
        const unsigned old = xb_add(&bar[XB_XSUB(b.x)], 1u);
        const unsigned gen = old / nloc;
        if (old + 1u == (gen + 1u) * nloc) {
            __builtin_amdgcn_fence(__ATOMIC_RELEASE, "agent");
            asm volatile("s_waitcnt vmcnt(0)" ::: "memory");
            const unsigned og = xb_add(&bar[XB_TOP], 1u);
            const unsigned tg = og / nx;
            if (og + 1u == (tg + 1u) * nx) xb_add(&bar[XB_TOPGEN], 1u);
            else XB_SPIN(xb_ld(&bar[XB_TOPGEN]) == tg, bar);
            __builtin_amdgcn_fence(__ATOMIC_ACQUIRE, "agent");
            xb_add(&bar[XB_XGEN(b.x)], 1u);
            asm volatile("s_waitcnt vmcnt(0)" ::: "memory");
        } else {
            XB_SPIN(xb_ld(&bar[XB_XGEN(b.x)]) == gen, bar);
            __builtin_amdgcn_fence(__ATOMIC_ACQUIRE, "agent");
            asm volatile("s_waitcnt vmcnt(0)" ::: "memory");
        }
    }
    __syncthreads();
}

__device__ __forceinline__ void run_phase(const Ctx cx, KP p, LAS unsigned char* lds, const int ph) {
    const int G = cx.G, c = cx.bid;
    if (ph == 0) { phase_prep(cx, p, lds); return; }
    if (ph == 1) { phase_mod_u0(cx, p); return; }
    const int layer = (ph - 2) / 7, q = (ph - 2) % 7;
    const int j = layer >> 1;
    const float* Xcur = (layer == 0) ? p->x : (const float*)(p->ws + WS_X);
    const float* gate = (const float*)(p->ws + WS_MOD) + layer * 6144 + 4096;
    unsigned char* act = p->ws + WS_ACT;
    if ((layer & 1) == 0) {
        if (q == 0) {
            gla_glr(cx, p, lds, j);
            SchedGlaIn S{(const char*)(p->ws + WS_U), (const char*)(p->ws + WS_WG + (size_t)j * 10240 * DM * 2), G, c};
            EpiGlaIn E{(bf16_t*)(act + ACT_QS), (bf16_t*)(act + ACT_ZS), (bf16_t*)(act + ACT_KT), (bf16_t*)(act + ACT_Y2)};
            pg8::gemm_phase(cx, lds, DM, DM, DM, 1, S, E);
        } else if (q == 1) { gla_decay(cx, p, lds, j); if (MK_PROBE_DECAY && layer == 0) { asm volatile("" ::: "memory"); gla_decay(cx, p, lds, j); } if (layer == 2) s5_tables(cx, p, lds, 1); }
        else if (q == 2) gla_scan2<false>(cx, p, lds, j);
        else if (q == 3) gla_scan2<true>(cx, p, lds, j);
        else if (q == 4) { if (cx.G != 256) gla_rms(cx, p, lds); }
        else if (q == 5) {
            SchedPlain S{(const char*)(act + ACT_YB), (const char*)(p->ws + WS_WGO + (size_t)j * DM * DI * 2), 32, 8, G, c, (size_t)256 * DI * 2, (size_t)256 * DI * 2, 0};
            if (cx.G == 256) {
                EpiOutLn<true> E{(const float*)(act + ACT_SSQ), Xcur, (layer == 3) ? p->out : (float*)(p->ws + WS_X), (bf16_t*)(p->ws + WS_U), gate, p->ln_g + layer * DM, p->ln_b + layer * DM,
                           (layer < 3) ? (const float*)(p->ws + WS_MOD) + (layer + 1) * 6144 : (const float*)nullptr, (unsigned long long*)(p->ws + WS_XBUF), (unsigned*)(p->ws + WS_CNT) + layer * 2048};
                pg8::gemm_phase(cx, lds, DI, DI, DI, 1, S, E);
            } else { EpiOut E{Xcur, (float*)(act + ACT_E), gate}; pg8::gemm_phase(cx, lds, DI, DI, DI, 1, S, E); }
        } else if (cx.G != 256) ln_phase(cx, p, layer);
    } else {
        if (q == 0) {
            SchedPlain S{(const char*)(p->ws + WS_U), (const char*)(p->ws + WS_WSI + (size_t)j * 8192 * DM * 2), 32, 32, G, c, (size_t)256 * DM * 2, (size_t)256 * DM * 2, 1};
            EpiS5In E{(bf16_t*)(act + ACT_UCAT), (bf16_t*)(act + ACT_ZS)};
            pg8::gemm_phase(cx, lds, DM, DM, DM, 1, S, E);
        } else if (q == 1) {
            if (cx.G == 256) {
                { SchedGroupLocal S{(const char*)(act + ACT_UCAT), (const char*)(p->ws + WS_WE), (size_t)512 * 384 * 2, (size_t)128 * 256 * 2, (size_t)256 * 384 * 2, cx.bid};
                  EpiS5E E{(float*)(act + ACT_E)};
                  pg8::gemm_phase(cx, lds, 256, 384, 256, 0, S, E); }
                asm volatile("s_waitcnt vmcnt(0)" ::: "memory"); __syncthreads();
                s5_carry(cx, p, lds);
                asm volatile("s_waitcnt vmcnt(0)" ::: "memory"); __syncthreads();
                { SchedGroupLocal S{(const char*)(act + ACT_UCAT), (const char*)(p->ws + WS_MG), (size_t)512 * 384 * 2, (size_t)256 * 384 * 2, (size_t)256 * 384 * 2, cx.bid};
                  EpiS5Y E{(const bf16_t*)(act + ACT_UCAT), (bf16_t*)(act + ACT_YB), p->s5_d + (size_t)j * DI};
                  pg8::gemm_phase(cx, lds, 384, 384, 384, 1, S, E); }
            } else {
                SchedGroup S{(const char*)(act + ACT_UCAT), (const char*)(p->ws + WS_WE), (size_t)512 * 384 * 2, (size_t)128 * 256 * 2, (size_t)256 * 384 * 2, G, c};
                EpiS5E E{(float*)(act + ACT_E)};
                pg8::gemm_phase(cx, lds, 256, 384, 256, 0, S, E);
            }
        } else if (q == 2) { if (cx.G != 256) s5_carry(cx, p, lds); }
        else if (q == 3) {
            if (cx.G != 256) {
                SchedGroup S{(const char*)(act + ACT_UCAT), (const char*)(p->ws + WS_MG), (size_t)512 * 384 * 2, (size_t)256 * 384 * 2, (size_t)256 * 384 * 2, G, c};
                EpiS5Y E{(const bf16_t*)(act + ACT_UCAT), (bf16_t*)(act + ACT_YB), p->s5_d + (size_t)j * DI};
                pg8::gemm_phase(cx, lds, 384, 384, 384, 1, S, E);
            }
        } else if (q == 4) {
            SchedPlain S{(const char*)(act + ACT_YB), (const char*)(p->ws + WS_WGLU + (size_t)j * DI * DI * 2), 32, 16, G, c, (size_t)256 * DI * 2, (size_t)256 * DI * 2, 0};
            EpiGlu E{(const bf16_t*)(act + ACT_YB), (const bf16_t*)(act + ACT_ZS), (bf16_t*)(act + ACT_Y2), p->s5_b_glu + (size_t)j * DI};
            pg8::gemm_phase<EpiGlu, SchedPlain, MK_KREP_GLU>(cx, lds, DI, DI, DI, 1, S, E);
        } else if (q == 5) {
            SchedPlain S{(const char*)(act + ACT_Y2), (const char*)(p->ws + WS_WSO + (size_t)j * DM * DI * 2), 32, 8, G, c, (size_t)256 * DI * 2, (size_t)256 * DI * 2, 0};
            if (cx.G == 256) {
                EpiOutLn<false> E{(const float*)nullptr, Xcur, (layer == 3) ? p->out : (float*)(p->ws + WS_X), (bf16_t*)(p->ws + WS_U), gate, p->ln_g + layer * DM, p->ln_b + layer * DM,
                           (layer < 3) ? (const float*)(p->ws + WS_MOD) + (layer + 1) * 6144 : (const float*)nullptr, (unsigned long long*)(p->ws + WS_XBUF), (unsigned*)(p->ws + WS_CNT) + layer * 2048};
                pg8::gemm_phase(cx, lds, DI, DI, DI, 1, S, E);
            } else { EpiOut E{Xcur, (float*)(act + ACT_E), gate}; pg8::gemm_phase(cx, lds, DI, DI, DI, 1, S, E); }
        } else if (cx.G != 256) ln_phase(cx, p, layer);
    }
}

__global__ void __launch_bounds__(NT, 2) fwd_megakernel(Params p_unused) {
    extern __shared__ __attribute__((aligned(16))) unsigned char lds_raw[];
    LAS unsigned char* lds = (LAS unsigned char*)lds_raw;
    KP kp0 = (KP)__builtin_amdgcn_kernarg_segment_ptr();
    const int ph_lo = kp0->ph_lo, ph_hi = kp0->ph_hi, coop = kp0->coop;
    XcdBarrier bar; bar.bar = (unsigned*)(kp0->ws + WS_BAR); bar.x = 0; bar.st = (volatile LAS unsigned*)(lds + LDS_STAGE);
    if (coop) { if (threadIdx.x < 4) ((LAS unsigned*)(lds + LDS_STAGE))[threadIdx.x] = 0u; __syncthreads(); bar = xcd_barrier_post((unsigned*)(kp0->ws + WS_BAR), (volatile LAS unsigned*)(lds + LDS_STAGE)); }
    for (int ph = ph_lo; ph < ph_hi; ++ph) {
        if (gridDim.x == 256 && ph >= 2 && ((ph - 2) % 7 == 6 || ((ph - 2) % 7 == 4 && (((ph - 2) / 7) & 1) == 0) || (((ph - 2) % 7 == 2 || (ph - 2) % 7 == 3) && (((ph - 2) / 7) & 1) == 1))) continue;
#if MK_REPEAT_MASK
        for (int rep = 0; rep < ((MK_REPEAT_MASK >> ph) & 1) + 1; ++rep)
#endif
        {
            KP kp = kp0; asm volatile("" : "+s"(kp));
            Ctx cx; cx.tid = threadIdx.x; cx.bid = blockIdx.x; cx.G = gridDim.x;
            asm volatile("" : "+v"(cx.tid)); asm volatile("" : "+s"(cx.bid)); asm volatile("" : "+s"(cx.G));
            run_phase(cx, kp, lds, ph);
        }
        if (coop && ph + 1 < ph_hi) { if (coop == 2) cg::this_grid().sync(); else xcd_barrier(bar); }
    }
}

#ifndef MK_ONE_LAUNCH
#define MK_ONE_LAUNCH 1
#endif

extern "C" void kernel_launch(void* const* d_in, const int* in_sizes, int n_in, void* d_out, int out_size, void* d_ws, size_t ws_size, hipStream_t stream) {
    static int grid = 0;
    if (grid == 0) {
        if (n_in != 23 || ws_size < WS_END) { fprintf(stderr, "kernel_launch: need 23 inputs and %zu bytes of workspace, got %d / %zu\n", (size_t)WS_END, n_in, ws_size); grid = -1; return; }
        int dev = 0, cus = 0, per_cu = 0;
        hipGetDevice(&dev); hipDeviceGetAttribute(&cus, hipDeviceAttributeMultiprocessorCount, dev);
        if (hipFuncSetAttribute((const void*)fwd_megakernel, hipFuncAttributeMaxDynamicSharedMemorySize, LDS_BYTES) != hipSuccess) { fprintf(stderr, "kernel_launch: hipFuncSetAttribute failed\n"); grid = -1; return; }
        if (hipOccupancyMaxActiveBlocksPerMultiprocessor(&per_cu, (const void*)fwd_megakernel, NT, LDS_BYTES) != hipSuccess || per_cu < 1) { fprintf(stderr, "kernel_launch: occupancy query gave %d\n", per_cu); per_cu = 1; }
        (void)hipGetLastError();
        grid = cus;
    }
    if (grid < 0) return;
    Params hp{};
    const float** pp = (const float**)&hp;
    for (int i = 0; i < 23; ++i) pp[i] = (const float*)d_in[i];
    hp.out = (float*)d_out; hp.ws = (unsigned char*)d_ws; hp.pad = 0;
#if MK_ONE_LAUNCH
    if (hipMemsetAsync((char*)d_ws + WS_BAR, 0, 16384 + 32768, stream) != hipSuccess) { fprintf(stderr, "kernel_launch: memset of the barrier words failed\n"); return; }
    hp.ph_lo = 0; hp.ph_hi = NPH; hp.coop = 1;
    void* args[] = {&hp};
    hipError_t e = hipLaunchCooperativeKernel((const void*)fwd_megakernel, dim3(grid), dim3(NT), args, LDS_BYTES, stream);
    if (e != hipSuccess) fprintf(stderr, "cooperative launch failed: %s (grid %d)\n", hipGetErrorString(e), grid);
#else
    hp.coop = 0;
    for (int ph = 0; ph < NPH; ++ph) { hp.ph_lo = ph; hp.ph_hi = ph + 1; hipLaunchKernelGGL(fwd_megakernel, dim3(grid), dim3(NT), LDS_BYTES, stream, hp); }
#endif
}
```

```cpp
#include <hip/hip_runtime.h>
#include <hip/hip_cooperative_groups.h>
#include <cstdio>
namespace cg = cooperative_groups;

#define LAS __attribute__((address_space(3)))
typedef unsigned short bf16_t;
typedef short bf16x8 __attribute__((ext_vector_type(8)));
typedef short s16x4 __attribute__((ext_vector_type(4)));
typedef float f32x4 __attribute__((ext_vector_type(4)));
typedef float f32x2 __attribute__((ext_vector_type(2)));
typedef unsigned u32x4 __attribute__((ext_vector_type(4)));
typedef unsigned u32x2 __attribute__((ext_vector_type(2)));

constexpr int SEQ = 8192, DM = 2048, DI = 4096, NQK = 1024;
constexpr int GLA_W = 10256;
constexpr float DN_ALPHA = 1.6817928305074290f;
#ifndef MK_REPEAT_MASK
#define MK_REPEAT_MASK 0
#endif
#ifndef MK_KREP_GLU
#define MK_KREP_GLU 1
#endif
#ifndef MK_PROBE_DECAY
#define MK_PROBE_DECAY 0
#endif
constexpr int NPH = 30;
constexpr int NT = 512;
constexpr int LDS_STAGE = 131072;
constexpr int LDS_RT = LDS_STAGE + 16;
constexpr int LDS_BYTES = LDS_RT + 4096;

constexpr size_t WS_WG   = 0;
constexpr size_t WS_WGO  = WS_WG   + 83886080;
constexpr size_t WS_WSI  = WS_WGO  + 33554432;
constexpr size_t WS_WGLU = WS_WSI  + 67108864;
constexpr size_t WS_WSO  = WS_WGLU + 67108864;
constexpr size_t WS_MG   = WS_WSO  + 33554432;
constexpr size_t WS_WE   = WS_MG   + 50331648;
constexpr size_t WS_LAMT = WS_WE   + 16777216;
constexpr size_t WS_WGT  = WS_LAMT + 131072;
constexpr size_t WS_MODP = WS_WGT  + 262144;
constexpr size_t WS_MOD  = WS_MODP + 6291456;
constexpr size_t WS_X    = WS_MOD  + 98304;
constexpr size_t WS_U    = WS_X    + 67108864;
constexpr size_t WS_ACT  = WS_U    + 33554432;
constexpr size_t ACT_UCAT = 0;
constexpr size_t ACT_QS   = 0;
constexpr size_t ACT_KT   = 16777216;
constexpr size_t ACT_GLR  = 33554432;
constexpr size_t ACT_ETOT = 34078720;
constexpr size_t ACT_SSQ  = 34603008;
constexpr size_t ACT_DSEG = 42991616;
constexpr size_t ACT_KD   = 50331648;
constexpr size_t ACT_ZS   = 100663296;
constexpr size_t ACT_E    = 167772160;
constexpr size_t ACT_YB   = 234881024;
constexpr size_t ACT_Y2   = 301989888;
constexpr size_t ACT_END  = 369098752;
constexpr size_t WS_BAR   = WS_ACT + ACT_END;
constexpr size_t WS_CNT   = WS_BAR + 16384;
constexpr size_t WS_XBUF  = WS_CNT + 32768;
constexpr size_t WS_END   = WS_XBUF + 524288;

struct Params {
    const float *x, *c, *ln_g, *ln_b, *ada_w, *ada_b, *gla_w_in, *gla_gate_w2, *gla_gate_b, *gla_norm_g, *gla_w_out,
        *s5_w_in, *s5_a_re, *s5_a_im, *s5_log_dt, *s5_b_re, *s5_b_im, *s5_c_re, *s5_c_im, *s5_d, *s5_w_glu, *s5_b_glu, *s5_w_out;
    float* out; unsigned char* ws; int ph_lo, ph_hi, coop, pad;
};

typedef const __attribute__((address_space(4))) Params* KP;
struct Ctx { int tid, bid, G; };

typedef __bf16 bf16v2_t __attribute__((ext_vector_type(2)));
__device__ __forceinline__ unsigned pk2(float lo, float hi) { const f32x2 v = {lo, hi}; return __builtin_bit_cast(unsigned, __builtin_convertvector(v, bf16v2_t)); }
__device__ __forceinline__ float bflo(unsigned u) { return __uint_as_float(u << 16); }
__device__ __forceinline__ float bfhi(unsigned u) { return __uint_as_float(u & 0xffff0000u); }
__device__ __forceinline__ float sigmoidf_(float x) { return __builtin_amdgcn_rcpf(1.0f + __expf(-x)); }
__device__ __forceinline__ float siluf_(float x) { return x * __builtin_amdgcn_rcpf(1.0f + __expf(-x)); }
__device__ __forceinline__ float gelu_tanh(float y) { const float a = 1.5957691216057308f * (y + 0.044715f * y * y * y); return y * __builtin_amdgcn_rcpf(1.0f + __expf(-a)); }
__device__ __forceinline__ float wave_sum(float v) {
    v += __shfl_xor(v, 32); v += __shfl_xor(v, 16); v += __shfl_xor(v, 8); v += __shfl_xor(v, 4); v += __shfl_xor(v, 2); v += __shfl_xor(v, 1); return v;
}

namespace pg8 {
constexpr int BM = 256, BK = 64, HALF = 128, HTB = HALF * BK * 2, STAGE_BYTES = 8 * HTB, NXCD = 8, WGM = 8;
__device__ __forceinline__ int lds_byte(int r, int c) { const int st = (r >> 4) * 2 + (c >> 5), rr = r & 15, cc = c & 31, ob = rr * 64 + cc * 2; return st * 1024 + (ob ^ (((ob >> 9) & 1) << 5)); }
__device__ __forceinline__ void stage_rc(int b, int& R, int& C) { const int st = b / 1024, sb = b % 1024, swz = sb ^ (((sb >> 9) & 1) << 5); R = (st >> 1) * 16 + swz / 64; C = (st & 1) * 32 + (swz % 64) / 2; }
__device__ __forceinline__ int perm32(int rho) { const int n = rho >> 4, i = rho & 15; return 8 * (i >> 2) + 4 * n + (i & 3); }

struct Unit { const char* a; const char* b; int pm, pn, kind, aux; };

__device__ __forceinline__ void tile_map(int wgid, int nM, int nN, int& pm, int& pn) {
    const int nwg = nM * nN;
    { const int q = nwg / NXCD, r = nwg % NXCD, xcd = wgid % NXCD, off = wgid / NXCD; wgid = (xcd < r ? xcd * (q + 1) : r * (q + 1) + (xcd - r) * q) + off; }
    const int nig = WGM * nN, gid = wgid / nig, fm = gid * WGM, gsz = (nM - fm) < WGM ? (nM - fm) : WGM;
    pm = fm + ((wgid % nig) % gsz); pn = (wgid % nig) / gsz;
}

template <class Epi, class Sched, int KREP = 1>
__device__ __forceinline__ void gemm_phase(const Ctx cx, LAS unsigned char* lds, const int K, const int lda, const int ldb, const int hsB, const Sched& S, const Epi& E) {
    const int tid = cx.tid, wid = __builtin_amdgcn_readfirstlane(tid >> 6), lane = tid & 63, wr = wid >> 2, wc = wid & 3, fr = lane & 15, fq = lane >> 4;
    const int nt = K / BK;
    unsigned voffA[2], voffB[2];
#pragma unroll
    for (int i = 0; i < 2; ++i) { int R, C; stage_rc(tid * 16 + i * 8192, R, C); const int Rb = Epi::PERM ? ((R & ~31) + perm32(R & 31)) : R;
        voffA[i] = (unsigned)(R * lda + C) * 2u; voffB[i] = (unsigned)(Rb * ldb + C) * 2u; }
    const size_t kstep = (size_t)(BK * 2);
    const size_t hstepA = (size_t)HALF * lda * 2;
    const size_t hstepB = hsB ? (size_t)HALF * ldb * 2 : 0;
    const unsigned ldsw = (unsigned)wid * 1024u;
    const int aoff = lds_byte(wr * 64 + fr, fq * 8), boff = lds_byte(wc * 32 + fr, fq * 8);
#define PG8_SA(b, h) (((b) * 2 + (h)) * HTB)
#define PG8_SB(b, h) ((4 + (b) * 2 + (h)) * HTB)
#define PG8_STAGE(bufoff, gbase, voff) do { _Pragma("unroll") for (int _i = 0; _i < 2; ++_i) { unsigned _vo = (voff)[_i]; asm volatile("" : "+v"(_vo));     \
        __builtin_amdgcn_global_load_lds((const unsigned*)((const char*)(gbase) + _vo), (LAS unsigned*)(lds + (bufoff) + ldsw + _i * 8192), 16, 0, 0); } } while (0)
#define PG8_LDA(dst, b, h) do { _Pragma("unroll") for (int m = 0; m < 4; ++m) _Pragma("unroll") for (int k = 0; k < 2; ++k) dst[m][k] = *(const LAS bf16x8*)(lds + PG8_SA(b, h) + aoff + m * 2048 + k * 1024); } while (0)
#define PG8_LDB(dst, b, h) do { _Pragma("unroll") for (int n = 0; n < 2; ++n) _Pragma("unroll") for (int k = 0; k < 2; ++k) dst[n][k] = *(const LAS bf16x8*)(lds + PG8_SB(b, h) + boff + n * 2048 + k * 1024); } while (0)
#define PG8_MMA(ai, bj, At, Bt) do { __builtin_amdgcn_s_setprio(1); _Pragma("unroll") for (int m = 0; m < 4; ++m) _Pragma("unroll") for (int n = 0; n < 2; ++n) _Pragma("unroll") for (int k = 0; k < 2; ++k) \
        acc[ai][bj][m][n] = __builtin_amdgcn_mfma_f32_16x16x32_bf16(Bt[n][k], At[m][k], acc[ai][bj][m][n], 0, 0, 0); __builtin_amdgcn_s_setprio(0); } while (0)
#define PG8_WAIT_V(n) asm volatile("s_waitcnt vmcnt(" #n ")" ::: "memory")
#define PG8_WAIT_L(n) asm volatile("s_waitcnt lgkmcnt(" #n ")" ::: "memory")
#define PG8_BAR __builtin_amdgcn_s_barrier()
#define PG8_SCHED __builtin_amdgcn_sched_barrier(0)
    Unit cur, nxt; int ui = 0;
    if (!S.next(0, cur)) return;
    if constexpr (Epi::KSCALE) E.prologue(cur, lds, tid);
    f32x4 acc[2][2][4][2];
#pragma unroll
    for (int a = 0; a < 2; ++a)
#pragma unroll
        for (int b = 0; b < 2; ++b)
#pragma unroll
            for (int m = 0; m < 4; ++m)
#pragma unroll
                for (int n = 0; n < 2; ++n) acc[a][b][m][n] = (f32x4){0.f, 0.f, 0.f, 0.f};
    bf16x8 At[4][2], B0[2][2], B1[2][2];
    const char* cA = cur.a; const char* cB = cur.b;
    PG8_STAGE(PG8_SB(0, 0), cB, voffB); PG8_STAGE(PG8_SA(0, 0), cA, voffA); PG8_STAGE(PG8_SB(0, 1), cB + hstepB, voffB); PG8_STAGE(PG8_SA(0, 1), cA + hstepA, voffA);
    if (wr == 1) PG8_BAR;
    PG8_WAIT_V(4); PG8_BAR;
    PG8_STAGE(PG8_SB(1, 0), cB + kstep, voffB); PG8_STAGE(PG8_SA(1, 0), cA + kstep, voffA); PG8_STAGE(PG8_SB(1, 1), cB + hstepB + kstep, voffB);
    PG8_WAIT_V(6); PG8_BAR;
    for (;;) {
        const bool has_next = S.next(ui + 1, nxt);
        const char* nA = has_next ? nxt.a : cA; const char* nB = has_next ? nxt.b : cB;
        for (int krep = 0; krep < KREP; ++krep) {
        const char* nAr = (krep == KREP - 1) ? nA : cA; const char* nBr = (krep == KREP - 1) ? nB : cB;
#pragma nounroll
        for (int t = 0; t < nt; t += 2) {
            const bool last = (t == nt - 2);
            const char* a1 = cA + (size_t)(t + 1) * kstep;
            const char* a2 = last ? nAr : cA + (size_t)(t + 2) * kstep; const char* b2 = last ? nBr : cB + (size_t)(t + 2) * kstep;
            const char* a3 = a2 + kstep; const char* b3 = b2 + kstep;
            if constexpr (Epi::KSCALE) { if (t != 0 && (t & 15) == 0) E.kscale(acc, (t >> 4) - 1, lds, wr, fr); }
            PG8_LDB(B0, 0, 0); PG8_SCHED; PG8_LDA(At, 0, 0); PG8_STAGE(PG8_SA(1, 1), a1 + hstepA, voffA);
            PG8_WAIT_L(8); PG8_BAR; PG8_WAIT_L(0); PG8_MMA(0, 0, At, B0); PG8_BAR; PG8_SCHED;
            PG8_LDB(B1, 0, 1); PG8_STAGE(PG8_SB(0, 0), b2, voffB);
            PG8_BAR; PG8_WAIT_L(0); PG8_MMA(0, 1, At, B1); PG8_BAR;
            PG8_LDA(At, 0, 1); PG8_STAGE(PG8_SA(0, 0), a2, voffA);
            PG8_BAR; PG8_WAIT_L(0); PG8_MMA(1, 0, At, B0); PG8_BAR; PG8_SCHED;
            PG8_STAGE(PG8_SB(0, 1), b2 + hstepB, voffB);
            PG8_WAIT_V(6); PG8_BAR; PG8_MMA(1, 1, At, B1); PG8_BAR;
            PG8_LDB(B0, 1, 0); PG8_SCHED; PG8_LDA(At, 1, 0); PG8_STAGE(PG8_SA(0, 1), a2 + hstepA, voffA);
            PG8_WAIT_L(8); PG8_BAR; PG8_WAIT_L(0); PG8_MMA(0, 0, At, B0); PG8_BAR; PG8_SCHED;
            PG8_LDB(B1, 1, 1); PG8_STAGE(PG8_SB(1, 0), b3, voffB);
            PG8_BAR; PG8_WAIT_L(0); PG8_MMA(0, 1, At, B1); PG8_BAR;
            PG8_LDA(At, 1, 1); PG8_STAGE(PG8_SA(1, 0), a3, voffA);
            PG8_BAR; PG8_WAIT_L(0); PG8_MMA(1, 0, At, B0); PG8_BAR; PG8_SCHED;
            PG8_STAGE(PG8_SB(1, 1), b3 + hstepB, voffB);
            PG8_WAIT_V(6); PG8_BAR; PG8_MMA(1, 1, At, B1); PG8_BAR;
        }
        }
        if constexpr (KREP > 1) {
#pragma unroll
            for (int a = 0; a < 2; ++a)
#pragma unroll
                for (int b = 0; b < 2; ++b)
#pragma unroll
                    for (int m = 0; m < 4; ++m)
#pragma unroll
                        for (int n = 0; n < 2; ++n) acc[a][b][m][n] *= (1.0f / KREP); }
        if constexpr (!Epi::AFTER_DRAIN) E(acc, cur, wr, wc, fr, fq);
        if (!has_next) break;
#pragma unroll
        for (int a = 0; a < 2; ++a)
#pragma unroll
            for (int b = 0; b < 2; ++b)
#pragma unroll
                for (int m = 0; m < 4; ++m)
#pragma unroll
                    for (int n = 0; n < 2; ++n) acc[a][b][m][n] = (f32x4){0.f, 0.f, 0.f, 0.f};
        cur = nxt; cA = nA; cB = nB; ++ui;
    }
    PG8_WAIT_V(0);
    if (wr == 0) PG8_BAR;
    PG8_BAR;
    if constexpr (Epi::AFTER_DRAIN) E.fused(acc, cur, wr, wc, fr, fq, lds, wid, lane);
#undef PG8_SA
#undef PG8_SB
#undef PG8_STAGE
#undef PG8_LDA
#undef PG8_LDB
#undef PG8_MMA
#undef PG8_WAIT_V
#undef PG8_WAIT_L
#undef PG8_BAR
#undef PG8_SCHED
}
}
using pg8::Unit;
typedef f32x4 Acc[2][2][4][2];

struct SchedPlain {
    const char* A; const char* B; int nM, nN, G, c; size_t ta, tb; int mix;
    __device__ __forceinline__ bool next(int i, Unit& u) const {
        const int L = i * G + c; if (L >= nM * nN) return false;
        int pm, pn; pg8::tile_map(L, nM, nN, pm, pn);
        if (mix) pn = (pn & 1) ? (nN >> 1) + (pn >> 1) : (pn >> 1);
        u.pm = pm; u.pn = pn; u.kind = 0; u.aux = 0; u.a = A + (size_t)pm * ta; u.b = B + (size_t)pn * tb; return true;
    }
};
struct SchedGlaIn {
    const char* U; const char* W; int G, c;
    __device__ __forceinline__ bool next(int i, Unit& u) const {
        int L = i * G + c; if (L >= 1280) return false;
        const size_t tstep = (size_t)256 * DM * 2;
        int pm, pn;
        if (L < 640) { pg8::tile_map(L, 32, 20, pm, pn); u.kind = 0; u.a = U + (size_t)pm * tstep; u.b = W + (size_t)pn * tstep; }
        else { pg8::tile_map(L - 640, 20, 32, pm, pn); u.kind = 1; u.a = W + (size_t)(20 + pm) * tstep; u.b = U + (size_t)pn * tstep; }
        u.pm = pm; u.pn = pn; u.aux = 0; return true;
    }
};
struct SchedGroup {
    const char* A; const char* B; size_t ga, gb, ta; int G, c;
    __device__ __forceinline__ bool next(int i, Unit& u) const {
        const int L = i * G + c; if (L >= 512) return false;
        const int g = L >> 1, pm = L & 1;
        u.pm = pm; u.pn = 0; u.kind = 0; u.aux = g; u.a = A + (size_t)g * ga + (size_t)pm * ta; u.b = B + (size_t)g * gb; return true;
    }
};

struct SchedGroupLocal {
    const char* A; const char* B; size_t ga, gb, ta; int g;
    __device__ __forceinline__ bool next(int i, Unit& u) const {
        if (i >= 2) return false;
        u.pm = i; u.pn = 0; u.kind = 0; u.aux = g; u.a = A + (size_t)g * ga + (size_t)i * ta; u.b = B + (size_t)g * gb; return true;
    }
};

struct EpiGlaIn {
    static constexpr bool PERM = true, AFTER_DRAIN = false, KSCALE = false;
    bf16_t *QS, *ZS, *KT, *VT;
    __device__ __forceinline__ void operator()(const Acc& acc, const Unit& u, int wr, int wc, int fr, int fq) const {
        const int row0 = u.pm * 256 + wr * 64 + fr, col0 = u.pn * 256 + wc * 32 + 8 * fq;
        bf16_t* base; int ld, rofs = 0, cofs = 0, mode;
        if (u.kind == 0) { if (u.pn < 4) { base = QS; ld = NQK; mode = 1; } else { base = ZS; ld = DI; cofs = -NQK; mode = 2; } }
        else { mode = 0; ld = SEQ; if (u.pm < 4) { base = KT; } else { base = VT; rofs = -NQK; } }
#pragma unroll
        for (int ai = 0; ai < 2; ++ai)
#pragma unroll
            for (int m = 0; m < 4; ++m) {
                bf16_t* rowp = base + (size_t)(row0 + rofs + ai * 128 + m * 16) * ld + col0 + cofs;
#pragma unroll
                for (int bj = 0; bj < 2; ++bj) {
                    f32x4 v0 = acc[ai][bj][m][0], v1 = acc[ai][bj][m][1];
                    if (mode == 1) { v0 *= 0.0625f; v1 *= 0.0625f; }
                    if (mode == 2) {
#pragma unroll
                        for (int j = 0; j < 4; ++j) { v0[j] = siluf_(v0[j]); v1[j] = siluf_(v1[j]); } }
                    u32x4 w; w.x = pk2(v0[0], v0[1]); w.y = pk2(v0[2], v0[3]); w.z = pk2(v1[0], v1[1]); w.w = pk2(v1[2], v1[3]);
                    if (mode == 1) {
                        const int m0 = 2 * fq; bf16_t* gp = rowp + bj * 128 - 8 * fq;
                        u32x2 lo; lo.x = w.x; lo.y = w.y; u32x2 hi; hi.x = w.z; hi.y = w.w;
                        *(u32x2*)(gp + (m0 & 3) * 8 + (m0 >> 2) * 4) = lo; *(u32x2*)(gp + ((m0 + 1) & 3) * 8 + ((m0 + 1) >> 2) * 4) = hi;
                    } else *(u32x4*)(rowp + bj * 128) = w; } }
    }
};
struct EpiS5In {
    static constexpr bool PERM = true, AFTER_DRAIN = false, KSCALE = false;
    bf16_t *UC, *ZS;
    __device__ __forceinline__ void operator()(const Acc& acc, const Unit& u, int wr, int wc, int fr, int fq) const {
        const int row0 = u.pm * 256 + wr * 64 + fr, col0 = u.pn * 256 + wc * 32 + 8 * fq;
        const bool isz = u.pn >= 16;
#pragma unroll
        for (int ai = 0; ai < 2; ++ai)
#pragma unroll
            for (int m = 0; m < 4; ++m) {
                const int t = row0 + ai * 128 + m * 16;
#pragma unroll
                for (int bj = 0; bj < 2; ++bj) {
                    f32x4 v0 = acc[ai][bj][m][0], v1 = acc[ai][bj][m][1];
                    const int c = col0 + bj * 128;
                    bf16_t* dst;
                    if (isz) {
#pragma unroll
                        for (int j = 0; j < 4; ++j) { v0[j] = siluf_(v0[j]); v1[j] = siluf_(v1[j]); }
                        dst = ZS + (size_t)t * DI + (c - DI);
                    } else { const int g = c >> 4, i0 = c & 15; dst = UC + ((size_t)g * 512 + (t >> 4)) * 384 + (t & 15) * 16 + i0; }
                    u32x4 w; w.x = pk2(v0[0], v0[1]); w.y = pk2(v0[2], v0[3]); w.z = pk2(v1[0], v1[1]); w.w = pk2(v1[2], v1[3]);
                    *(u32x4*)dst = w; } }
    }
};
struct EpiS5E {
    static constexpr bool PERM = false, AFTER_DRAIN = false, KSCALE = false;
    float* E;
    __device__ __forceinline__ void operator()(const Acc& acc, const Unit& u, int wr, int wc, int fr, int fq) const {
        const int row0 = u.pm * 256 + wr * 64 + fr, col0 = wc * 32 + 4 * fq;
#pragma unroll
        for (int ai = 0; ai < 2; ++ai)
#pragma unroll
            for (int m = 0; m < 4; ++m) {
                float* rowp = E + ((size_t)u.aux * 512 + row0 + ai * 128 + m * 16) * 128 + col0;
#pragma unroll
                for (int n = 0; n < 2; ++n) *(f32x4*)(rowp + n * 16) = acc[ai][0][m][n]; }
    }
};
struct EpiS5Y {
    static constexpr bool PERM = true, AFTER_DRAIN = false, KSCALE = false;
    const bf16_t* UC; bf16_t* YB; const float* dsk;
    __device__ __forceinline__ void operator()(const Acc& acc, const Unit& u, int wr, int wc, int fr, int fq) const {
        const int g = u.aux; const int row0 = u.pm * 256 + wr * 64 + fr, col0 = wc * 32 + 8 * fq;
#pragma unroll
        for (int bj = 0; bj < 2; ++bj) {
            const int n = col0 + bj * 128; const int tt = n >> 4, o0 = n & 15; const int ch = g * 16 + o0;
            const f32x4 d0 = *(const f32x4*)(dsk + ch), d1 = *(const f32x4*)(dsk + ch + 4);
#pragma unroll
            for (int ai = 0; ai < 2; ++ai) {
                u32x4 uq[4];
#pragma unroll
                for (int m = 0; m < 4; ++m) uq[m] = *(const u32x4*)(UC + ((size_t)g * 512 + row0 + ai * 128 + m * 16) * 384 + n);
                __builtin_amdgcn_sched_barrier(0);
#pragma unroll
                for (int m = 0; m < 4; ++m) {
                    const int c = row0 + ai * 128 + m * 16; const u32x4 uu = uq[m];
                    f32x4 v0 = acc[ai][bj][m][0], v1 = acc[ai][bj][m][1];
                    v0[0] += d0[0] * bflo(uu.x); v0[1] += d0[1] * bfhi(uu.x); v0[2] += d0[2] * bflo(uu.y); v0[3] += d0[3] * bfhi(uu.y);
                    v1[0] += d1[0] * bflo(uu.z); v1[1] += d1[1] * bfhi(uu.z); v1[2] += d1[2] * bflo(uu.w); v1[3] += d1[3] * bfhi(uu.w);
#pragma unroll
                    for (int j = 0; j < 4; ++j) { v0[j] = gelu_tanh(v0[j]); v1[j] = gelu_tanh(v1[j]); }
                    u32x4 w; w.x = pk2(v0[0], v0[1]); w.y = pk2(v0[2], v0[3]); w.z = pk2(v1[0], v1[1]); w.w = pk2(v1[2], v1[3]);
                    *(u32x4*)(YB + (size_t)(c * 16 + tt) * DI + ch) = w; }
                __builtin_amdgcn_sched_barrier(0);
            } }
    }
};
struct EpiGlu {
    static constexpr bool PERM = true, AFTER_DRAIN = false, KSCALE = false;
    const bf16_t *YB, *ZS; bf16_t* Y2; const float* bg;
    __device__ __forceinline__ void operator()(const Acc& acc, const Unit& u, int wr, int wc, int fr, int fq) const {
        const int row0 = u.pm * 256 + wr * 64 + fr, col0 = u.pn * 256 + wc * 32 + 8 * fq;
#pragma unroll
        for (int bj = 0; bj < 2; ++bj) {
            const int c = col0 + bj * 128;
            const f32x4 b0 = *(const f32x4*)(bg + c), b1 = *(const f32x4*)(bg + c + 4);
#pragma unroll
            for (int ai = 0; ai < 2; ++ai) {
                u32x4 yy[4], zz[4];
#pragma unroll
                for (int m = 0; m < 4; ++m) { const size_t off = (size_t)(row0 + ai * 128 + m * 16) * DI + c; yy[m] = *(const u32x4*)(YB + off); zz[m] = *(const u32x4*)(ZS + off); }
                __builtin_amdgcn_sched_barrier(0);
#pragma unroll
                for (int m = 0; m < 4; ++m) {
                    const size_t off = (size_t)(row0 + ai * 128 + m * 16) * DI + c;
                    f32x4 v0 = acc[ai][bj][m][0] + b0, v1 = acc[ai][bj][m][1] + b1;
                    v0[0] = bflo(yy[m].x) * bflo(zz[m].x) * sigmoidf_(v0[0]); v0[1] = bfhi(yy[m].x) * bfhi(zz[m].x) * sigmoidf_(v0[1]);
                    v0[2] = bflo(yy[m].y) * bflo(zz[m].y) * sigmoidf_(v0[2]); v0[3] = bfhi(yy[m].y) * bfhi(zz[m].y) * sigmoidf_(v0[3]);
                    v1[0] = bflo(yy[m].z) * bflo(zz[m].z) * sigmoidf_(v1[0]); v1[1] = bfhi(yy[m].z) * bfhi(zz[m].z) * sigmoidf_(v1[1]);
                    v1[2] = bflo(yy[m].w) * bflo(zz[m].w) * sigmoidf_(v1[2]); v1[3] = bfhi(yy[m].w) * bfhi(zz[m].w) * sigmoidf_(v1[3]);
                    u32x4 w; w.x = pk2(v0[0], v0[1]); w.y = pk2(v0[2], v0[3]); w.z = pk2(v1[0], v1[1]); w.w = pk2(v1[2], v1[3]);
                    *(u32x4*)(Y2 + off) = w; }
                __builtin_amdgcn_sched_barrier(0);
            } }
    }
};
struct EpiOut {
    static constexpr bool PERM = false, AFTER_DRAIN = false, KSCALE = false;
    const float* X; float* R; const float* gate;
    __device__ __forceinline__ void operator()(const Acc& acc, const Unit& u, int wr, int wc, int fr, int fq) const {
        const int row0 = u.pm * 256 + wr * 64 + fr, col0 = u.pn * 256 + wc * 32 + 4 * fq;
        f32x4 gv[2][2];
#pragma unroll
        for (int bj = 0; bj < 2; ++bj)
#pragma unroll
            for (int n = 0; n < 2; ++n) gv[bj][n] = *(const f32x4*)(gate + col0 + bj * 128 + n * 16) + 1.0f;
#pragma unroll
        for (int ai = 0; ai < 2; ++ai)
#pragma unroll
            for (int m = 0; m < 4; ++m) {
                const size_t off = (size_t)(row0 + ai * 128 + m * 16) * DM + col0;
#pragma unroll
                for (int bj = 0; bj < 2; ++bj)
#pragma unroll
                    for (int n = 0; n < 2; ++n) {
                        const f32x4 xv = *(const f32x4*)(X + off + bj * 128 + n * 16);
                        *(f32x4*)(R + off + bj * 128 + n * 16) = xv * DN_ALPHA + gv[bj][n] * acc[ai][bj][m][n]; } }
    }
};

template <bool RS> struct EpiOutLn {
    static constexpr bool PERM = false, AFTER_DRAIN = true, KSCALE = RS;
    const float* part;
    __device__ __forceinline__ void prologue(const Unit& u, LAS unsigned char* lds, int tid) const {
        LAS float* RT = (LAS float*)(lds + LDS_RT);
        if (tid < 256) {
            const int t = u.pm * 256 + tid, c = t >> 6, tl = t & 63; float r[4];
#pragma unroll
            for (int h = 0; h < 4; ++h) { const float* pp = part + (((size_t)c * 4 + h) * 8) * 64 + tl; float sm = 0.f;
#pragma unroll
                for (int q = 0; q < 8; ++q) sm += pp[q * 64];
                r[h] = rsqrtf(sm * (1.0f / 1024.0f) + 1e-6f); }
            RT[tid] = r[0] / r[1]; RT[256 + tid] = r[1] / r[2]; RT[512 + tid] = r[2] / r[3]; RT[768 + tid] = r[3];
        }
        asm volatile("s_waitcnt vmcnt(0) lgkmcnt(0)" ::: "memory"); __syncthreads();
    }
    __device__ __forceinline__ void kscale(Acc& acc, int hb, LAS unsigned char* lds, int wr, int fr) const {
        const LAS float* RT = (const LAS float*)(lds + LDS_RT) + hb * 256 + wr * 64 + fr;
#pragma unroll
        for (int ai = 0; ai < 2; ++ai)
#pragma unroll
            for (int m = 0; m < 4; ++m) { const float f = RT[ai * 128 + m * 16];
#pragma unroll
                for (int bj = 0; bj < 2; ++bj)
#pragma unroll
                    for (int n = 0; n < 2; ++n) acc[ai][bj][m][n] *= f; }
    }
    const float* X; float* Xo; bf16_t* U; const float* gate; const float* lng; const float* lnb; const float* modn;
    unsigned long long* xbuf; unsigned* cnt;
    __device__ __forceinline__ void operator()(const Acc&, const Unit&, int, int, int, int) const {}
    __device__ __forceinline__ void fused(Acc& acc, const Unit& u, int wr, int wc, int fr, int fq, LAS unsigned char* lds, int wid, int lane) const {
        LAS f32x2* P = (LAS f32x2*)lds;
        LAS f32x2* S = (LAS f32x2*)(lds + 8192);
        const int row0 = u.pm * 256 + wr * 64 + fr, col0 = u.pn * 256 + wc * 32 + 4 * fq;
        if constexpr (RS) kscale(acc, 3, lds, wr, fr);
        {
            f32x4 gv[2][2];
#pragma unroll
            for (int bj = 0; bj < 2; ++bj)
#pragma unroll
                for (int n = 0; n < 2; ++n) gv[bj][n] = *(const f32x4*)(gate + col0 + bj * 128 + n * 16) + 1.0f;
#pragma unroll
            for (int ai = 0; ai < 2; ++ai)
#pragma unroll
                for (int m = 0; m < 4; ++m) {
                    const size_t off = (size_t)(row0 + ai * 128 + m * 16) * DM + col0;
#pragma unroll
                    for (int bj = 0; bj < 2; ++bj)
#pragma unroll
                        for (int n = 0; n < 2; ++n) { const f32x4 xv = *(const f32x4*)(X + off + bj * 128 + n * 16); acc[ai][bj][m][n] = xv * DN_ALPHA + gv[bj][n] * acc[ai][bj][m][n]; }
                    asm volatile("" : "+v"(acc[ai][0][m][0]), "+v"(acc[ai][0][m][1]), "+v"(acc[ai][1][m][0]), "+v"(acc[ai][1][m][1]));
                    if (m & 1) asm volatile("" ::: "memory"); }
        }
#pragma unroll
        for (int ai = 0; ai < 2; ++ai)
#pragma unroll
            for (int m = 0; m < 4; ++m) {
                float sm = 0.f;
#pragma unroll
                for (int bj = 0; bj < 2; ++bj)
#pragma unroll
                    for (int n = 0; n < 2; ++n) { const f32x4 x = acc[ai][bj][m][n]; sm += (x[0] + x[1]) + (x[2] + x[3]); }
                sm += __shfl_xor(sm, 16); sm += __shfl_xor(sm, 32);
                const float mw = sm * (1.0f / 64.0f); float q = 0.f;
#pragma unroll
                for (int bj = 0; bj < 2; ++bj)
#pragma unroll
                    for (int n = 0; n < 2; ++n) { const f32x4 d = acc[ai][bj][m][n] - mw; q += (d[0] * d[0] + d[1] * d[1]) + (d[2] * d[2] + d[3] * d[3]); }
                q += __shfl_xor(q, 16); q += __shfl_xor(q, 32);
                if (fq == 0) P[(ai * 128 + wr * 64 + m * 16 + fr) * 4 + wc] = (f32x2){mw, q};
            }
        asm volatile("s_waitcnt lgkmcnt(0)" ::: "memory"); __builtin_amdgcn_s_barrier(); asm volatile("" ::: "memory");
        const int row = wid * 32 + (lane & 31);
        if (lane < 32) {
            const f32x2 a = P[row * 4 + 0], b = P[row * 4 + 1], c = P[row * 4 + 2], d = P[row * 4 + 3];
            const float mt = (a.x + b.x + c.x + d.x) * 0.25f;
            const float da = a.x - mt, db = b.x - mt, dc = c.x - mt, dd = d.x - mt;
            const float m2 = (a.y + b.y) + (c.y + d.y) + 64.0f * ((da * da + db * db) + (dc * dc + dd * dd));
            unsigned long long* slot = xbuf + ((size_t)(u.pm * 256 + row) * 8 + u.pn);
            __hip_atomic_store(slot, ((unsigned long long)__float_as_uint(m2) << 32) | __float_as_uint(mt), __ATOMIC_RELAXED, __HIP_MEMORY_SCOPE_AGENT);
        }
        asm volatile("s_waitcnt vmcnt(0)" ::: "memory");
        if (lane == 0) __hip_atomic_fetch_add(cnt + 64 * u.pm, 1u, __ATOMIC_RELAXED, __HIP_MEMORY_SCOPE_AGENT);
        if (wid == 0) {
            for (unsigned sp = 0; sp < (1u << 22); ++sp) {
                if ((unsigned)__builtin_amdgcn_readfirstlane(__hip_atomic_load(cnt + 64 * u.pm, __ATOMIC_RELAXED, __HIP_MEMORY_SCOPE_AGENT)) >= 64u) break;
                __builtin_amdgcn_s_sleep(2);
            }
            __builtin_amdgcn_fence(__ATOMIC_ACQUIRE, "agent");
        }
        asm volatile("s_waitcnt vmcnt(0) lgkmcnt(0)" ::: "memory"); __builtin_amdgcn_s_barrier(); asm volatile("" ::: "memory");
        if (lane < 32) {
            const unsigned long long* slot = xbuf + (size_t)(u.pm * 256 + row) * 8; float mt[8], m2[8]; float ms = 0.f;
#pragma unroll
            for (int t = 0; t < 8; ++t) { const unsigned long long wv = __hip_atomic_load(slot + t, __ATOMIC_RELAXED, __HIP_MEMORY_SCOPE_AGENT); mt[t] = __uint_as_float((unsigned)wv); m2[t] = __uint_as_float((unsigned)(wv >> 32)); ms += mt[t]; }
            const float mean = ms * 0.125f; float q = 0.f;
#pragma unroll
            for (int t = 0; t < 8; ++t) { const float dm = mt[t] - mean; q += m2[t] + 256.0f * dm * dm; }
            S[row] = (f32x2){mean, rsqrtf(q * (1.0f / 2048.0f) + 1e-5f)};
        }
        asm volatile("s_waitcnt lgkmcnt(0)" ::: "memory"); __builtin_amdgcn_s_barrier(); asm volatile("" ::: "memory");
#pragma unroll
        for (int bj = 0; bj < 2; ++bj)
#pragma unroll
            for (int n = 0; n < 2; ++n) {
                const int col = col0 + bj * 128 + n * 16;
                const f32x4 g4 = *(const f32x4*)(lng + col), b4 = *(const f32x4*)(lnb + col);
                f32x4 sc4 = {0.f, 0.f, 0.f, 0.f}, sh4 = sc4;
                if (modn) { sh4 = *(const f32x4*)(modn + col); sc4 = *(const f32x4*)(modn + 2048 + col) + 1.0f; }
#pragma unroll
                for (int ai = 0; ai < 2; ++ai)
#pragma unroll
                    for (int m = 0; m < 4; ++m) {
                        const int r = ai * 128 + wr * 64 + m * 16 + fr; const f32x2 sr = S[r];
                        const size_t off = (size_t)(u.pm * 256 + r) * DM + col;
                        const f32x4 y = (acc[ai][bj][m][n] - sr.x) * sr.y * g4 + b4;
                        *(f32x4*)(Xo + off) = y;
                        if (modn) { const f32x4 uv = y * sc4 + sh4; u32x2 wv; wv.x = pk2(uv[0], uv[1]); wv.y = pk2(uv[2], uv[3]); *(u32x2*)(U + off) = wv; }
                        if (m & 1) asm volatile("" ::: "memory");
                    }
                asm volatile("" ::: "memory");
            }
    }
};

__device__ __forceinline__ void conv_job(const Ctx cx, LAS unsigned char* lds, const float* src, const int K, const int sstride, const int col0, const int ncols, bf16_t* dst, const int ldd) {
    const int tid = cx.tid, G = cx.G;
    const int ntn = ncols >> 7, ntiles = ntn * (K >> 6);
    LAS unsigned* T = (LAS unsigned*)lds;
    const int c4 = tid & 31, rp = tid >> 5;
    f32x4 va[4], vb[4];
#define CONV_LOAD(v, tile) do { const int tk_ = (tile) / ntn, tn_ = (tile) % ntn; \
        const float* s_ = src + (size_t)(tk_ * 64 + 2 * rp) * sstride + col0 + tn_ * 128 + 4 * c4; \
        v[0] = __builtin_nontemporal_load((const f32x4*)s_); v[1] = __builtin_nontemporal_load((const f32x4*)(s_ + sstride)); v[2] = __builtin_nontemporal_load((const f32x4*)(s_ + (size_t)32 * sstride)); v[3] = __builtin_nontemporal_load((const f32x4*)(s_ + (size_t)33 * sstride)); } while (0)
#define CONV_OUT(v, tile, nexttile) do { \
        _Pragma("unroll") for (int j = 0; j < 4; ++j) { T[(4 * c4 + j) * 33 + rp] = pk2(v[0][j], v[1][j]); T[(4 * c4 + j) * 33 + rp + 16] = pk2(v[2][j], v[3][j]); } \
        if ((nexttile) < ntiles) CONV_LOAD(v, nexttile); \
        __syncthreads(); \
        { const int tk = (tile) / ntn, tn = (tile) % ntn; const int n = tid >> 2, qq = tid & 3; \
          u32x4 w0, w1; const LAS unsigned* tp = T + n * 33 + 8 * qq; \
          w0.x = tp[0]; w0.y = tp[1]; w0.z = tp[2]; w0.w = tp[3]; w1.x = tp[4]; w1.y = tp[5]; w1.z = tp[6]; w1.w = tp[7]; \
          bf16_t* d = dst + (size_t)(tn * 128 + n) * ldd + tk * 64 + 16 * qq; \
          *(u32x4*)d = w0; *(u32x4*)(d + 8) = w1; } \
        __syncthreads(); } while (0)
    int t = cx.bid;
    if (t < ntiles) CONV_LOAD(va, t);
    if (t + G < ntiles) CONV_LOAD(vb, t + G);
    for (; t < ntiles; t += 2 * G) {
        CONV_OUT(va, t, t + 2 * G);
        if (t + G < ntiles) CONV_OUT(vb, t + G, t + 3 * G);
    }
#undef CONV_LOAD
#undef CONV_OUT
}

__device__ __forceinline__ void s5_tables(const Ctx cx, KP p, LAS unsigned char* lds, const int j) {
    const int tid = cx.tid;
    LAS float* LP = (LAS float*)lds;
    LAS float* BB = LP + 17 * 64 * 2;
    LAS float* CC = BB + 2048;
    LAS float* KT = CC + 2048;
    LAS float* CF = KT + 4096;
    bf16_t* MG = (bf16_t*)(p->ws + WS_MG); bf16_t* WE = (bf16_t*)(p->ws + WS_WE); float* LT = (float*)(p->ws + WS_LAMT);
    for (int g = cx.bid; g < 256; g += cx.G) {
        __syncthreads();
        const int jg = j * 256 + g;
        if (tid < 64) {
            const float are = p->s5_a_re[jg * 64 + tid], aim = p->s5_a_im[jg * 64 + tid], dt = expf(p->s5_log_dt[jg]);
            const float mag = expf(are * dt), ang = aim * dt;
            const float lbr = mag * cosf(ang), lbi = mag * sinf(ang);
            const float nr = lbr - 1.0f, den = are * are + aim * aim;
            CF[2 * tid] = (nr * are + lbi * aim) / den; CF[2 * tid + 1] = (lbi * are - nr * aim) / den;
            for (int n = 0; n <= 16; ++n) { const float mm = expf(are * dt * (float)n), a = ang * (float)n; LP[(n * 64 + tid) * 2] = mm * cosf(a); LP[(n * 64 + tid) * 2 + 1] = mm * sinf(a); }
        }
        __syncthreads();
        for (int idx = tid; idx < 1024; idx += NT) {
            const int pp = idx >> 4;
            const float br = p->s5_b_re[(size_t)jg * 1024 + idx], bi = p->s5_b_im[(size_t)jg * 1024 + idx], cr = CF[2 * pp], ci = CF[2 * pp + 1];
            BB[idx * 2] = cr * br - ci * bi; BB[idx * 2 + 1] = cr * bi + ci * br;
            CC[idx * 2] = p->s5_c_re[(size_t)jg * 1024 + idx]; CC[idx * 2 + 1] = p->s5_c_im[(size_t)jg * 1024 + idx];
        }
        __syncthreads();
        {
            const int tau = tid >> 5, o = (tid >> 1) & 15, i0 = (tid & 1) * 8;
            float acc8[8];
#pragma unroll
            for (int jj = 0; jj < 8; ++jj) acc8[jj] = 0.f;
            for (int pp = 0; pp < 64; ++pp) {
                const float Lr = LP[(tau * 64 + pp) * 2], Li = LP[(tau * 64 + pp) * 2 + 1], Cr = CC[(o * 64 + pp) * 2], Ci = CC[(o * 64 + pp) * 2 + 1];
                const float Gr = Cr * Lr - Ci * Li, Gi = Cr * Li + Ci * Lr;
                const LAS f32x4* bp = (const LAS f32x4*)(BB + (pp * 16 + i0) * 2);
#pragma unroll
                for (int v4 = 0; v4 < 4; ++v4) { const f32x4 bb = bp[v4]; acc8[2 * v4] += Gr * bb[0] - Gi * bb[1]; acc8[2 * v4 + 1] += Gr * bb[2] - Gi * bb[3]; }
            }
#pragma unroll
            for (int jj = 0; jj < 8; ++jj) KT[(tau * 16 + o) * 16 + i0 + jj] = acc8[jj];
        }
        __syncthreads();
        bf16_t* Mg = MG + (size_t)g * 256 * 384;
        for (int it = 0; it < 24; ++it) {
            const int v = tid + NT * it, row = v / 48, kc = (v % 48) * 8, t = row >> 4, o = row & 15;
            float val[8];
            if (kc < 256) { const int s = kc >> 4, i0 = kc & 15;
#pragma unroll
                for (int jj = 0; jj < 8; ++jj) val[jj] = (t >= s) ? KT[((t - s) * 16 + o) * 16 + i0 + jj] : 0.f;
            } else { const int n0 = kc - 256;
#pragma unroll
                for (int jj = 0; jj < 8; ++jj) { const int pp = (n0 + jj) & 63;
                    const float Lr = LP[((t + 1) * 64 + pp) * 2], Li = LP[((t + 1) * 64 + pp) * 2 + 1], Cr = CC[(o * 64 + pp) * 2], Ci = CC[(o * 64 + pp) * 2 + 1];
                    val[jj] = (n0 < 64) ? (Cr * Lr - Ci * Li) : -(Cr * Li + Ci * Lr); } }
            u32x4 w; w.x = pk2(val[0], val[1]); w.y = pk2(val[2], val[3]); w.z = pk2(val[4], val[5]); w.w = pk2(val[6], val[7]);
            *(u32x4*)(Mg + (size_t)row * 384 + kc) = w;
        }
        bf16_t* We = WE + (size_t)g * 128 * 256;
        for (int it = 0; it < 8; ++it) {
            const int v = tid + NT * it, n = v >> 5, kc = (v & 31) * 8, s = kc >> 4, i0 = kc & 15, pp = n & 63;
            const float Lr = LP[((15 - s) * 64 + pp) * 2], Li = LP[((15 - s) * 64 + pp) * 2 + 1];
            float val[8];
#pragma unroll
            for (int jj = 0; jj < 8; ++jj) { const float Br = BB[(pp * 16 + i0 + jj) * 2], Bi = BB[(pp * 16 + i0 + jj) * 2 + 1]; val[jj] = (n < 64) ? (Lr * Br - Li * Bi) : (Lr * Bi + Li * Br); }
            u32x4 w; w.x = pk2(val[0], val[1]); w.y = pk2(val[2], val[3]); w.z = pk2(val[4], val[5]); w.w = pk2(val[6], val[7]);
            *(u32x4*)(We + (size_t)n * 256 + kc) = w;
        }
        if (tid < 128) LT[g * 128 + tid] = LP[(16 * 64 + (tid & 63)) * 2 + (tid >> 6)];
    }
    __syncthreads();
}

__device__ __forceinline__ void phase_prep(const Ctx cx, KP p, LAS unsigned char* lds) {
    const int tid = cx.tid, G = cx.G;
    float* modp = (float*)(p->ws + WS_MODP);
    for (int it = cx.bid; it < 256; it += G) {
        const int l = it >> 6, dc = it & 63;
        f32x4 a0 = {0.f, 0.f, 0.f, 0.f}, a1 = a0, a2 = a0;
        const float* wp = p->ada_w + ((size_t)l * DM + dc * 32) * 6144 + 4 * tid;
#pragma unroll 8
        for (int r = 0; r < 32; ++r) {
            const float s = siluf_(p->c[dc * 32 + r]);
            a0 += s * __builtin_nontemporal_load((const f32x4*)(wp + (size_t)r * 6144)); a1 += s * __builtin_nontemporal_load((const f32x4*)(wp + (size_t)r * 6144 + 2048)); a2 += s * __builtin_nontemporal_load((const f32x4*)(wp + (size_t)r * 6144 + 4096));
        }
        float* o = modp + ((size_t)dc * 4 + l) * 6144 + 4 * tid;
        *(f32x4*)o = a0; *(f32x4*)(o + 2048) = a1; *(f32x4*)(o + 4096) = a2;
    }
    { bf16_t* wgt = (bf16_t*)(p->ws + WS_WGT);
      for (int idx = cx.bid * NT + tid; idx < 65536; idx += G * NT) { const int j = idx >> 15, r = (idx >> 11) & 15, d = idx & 2047; wgt[idx] = (bf16_t)(pk2(p->gla_w_in[((size_t)j * DM + d) * GLA_W + 10240 + r], 0.f) & 0xffffu); } }
    for (int j = 0; j < 2; ++j) {
        bf16_t* wg = (bf16_t*)(p->ws + WS_WG) + (size_t)j * 10240 * DM;
        const float* src = p->gla_w_in + (size_t)j * DM * GLA_W;
        conv_job(cx, lds, src, DM, GLA_W, 0, 1024, wg, DM);
        conv_job(cx, lds, src, DM, GLA_W, 6144, 4096, wg + (size_t)1024 * DM, DM);
        conv_job(cx, lds, src, DM, GLA_W, 1024, 1024, wg + (size_t)5120 * DM, DM);
        conv_job(cx, lds, src, DM, GLA_W, 2048, 4096, wg + (size_t)6144 * DM, DM);
        conv_job(cx, lds, p->gla_w_out + (size_t)j * DI * DM, DI, DM, 0, DM, (bf16_t*)(p->ws + WS_WGO) + (size_t)j * DM * DI, DI);
        conv_job(cx, lds, p->s5_w_in + (size_t)j * DM * 8192, DM, 8192, 0, 8192, (bf16_t*)(p->ws + WS_WSI) + (size_t)j * 8192 * DM, DM);
        conv_job(cx, lds, p->s5_w_glu + (size_t)j * DI * DI, DI, DI, 0, DI, (bf16_t*)(p->ws + WS_WGLU) + (size_t)j * DI * DI, DI);
        conv_job(cx, lds, p->s5_w_out + (size_t)j * DI * DM, DI, DM, 0, DM, (bf16_t*)(p->ws + WS_WSO) + (size_t)j * DM * DI, DI);
    }
    s5_tables(cx, p, lds, 0);
}

__device__ __forceinline__ void phase_mod_u0(const Ctx cx, KP p) {
    const int tid = cx.tid, G = cx.G;
    const float* modp = (const float*)(p->ws + WS_MODP); float* mod = (float*)(p->ws + WS_MOD);
    for (int idx = cx.bid * NT + tid; idx < 24576; idx += G * NT) {
        const int l = idx / 6144, e = idx % 6144; float s = p->ada_b[idx];
        for (int dc = 0; dc < 64; ++dc) s += modp[((size_t)dc * 4 + l) * 6144 + e];
        mod[idx] = s;
    }
    f32x4 sh = *(const f32x4*)(p->ada_b + 4 * tid), sc = *(const f32x4*)(p->ada_b + 2048 + 4 * tid);
    for (int dc = 0; dc < 64; ++dc) { sh += *(const f32x4*)(modp + (size_t)dc * 4 * 6144 + 4 * tid); sc += *(const f32x4*)(modp + (size_t)dc * 4 * 6144 + 2048 + 4 * tid); }
    sc += 1.0f;
    bf16_t* U = (bf16_t*)(p->ws + WS_U);
    for (int row0 = cx.bid; row0 < SEQ; row0 += 8 * G) {
        f32x4 xv[8];
#pragma unroll
        for (int i = 0; i < 8; ++i) { const int row = row0 + i * G; if (row < SEQ) xv[i] = *(const f32x4*)(p->x + (size_t)row * DM + 4 * tid); }
#pragma unroll
        for (int i = 0; i < 8; ++i) { const int row = row0 + i * G; if (row < SEQ) { const f32x4 uv = xv[i] * sc + sh; u32x2 w; w.x = pk2(uv[0], uv[1]); w.y = pk2(uv[2], uv[3]); *(u32x2*)(U + (size_t)row * DM + 4 * tid) = w; } }
    }
}

__device__ __forceinline__ void gla_glr(const Ctx cx, KP p, const int j) {
    const int tid = cx.tid, w = __builtin_amdgcn_readfirstlane(tid >> 6), lane = tid & 63, fr = lane & 15, fq = lane >> 4;
    const bf16_t* U = (const bf16_t*)(p->ws + WS_U); const bf16_t* wgt = (const bf16_t*)(p->ws + WS_WGT) + (size_t)j * 16 * DM;
    float* glr = (float*)(p->ws + WS_ACT + ACT_GLR);
    for (int tile = cx.bid + cx.G * w; tile < 512; tile += cx.G * 8) {
        const bf16_t* up = U + (size_t)(tile * 16 + fr) * DM + 8 * fq; const bf16_t* wp = wgt + (size_t)fr * DM + 8 * fq;
        f32x4 acc = {0.f, 0.f, 0.f, 0.f};
#pragma unroll 16
        for (int sx = 0; sx < 64; ++sx) { const bf16x8 a = *(const bf16x8*)(up + 32 * sx), b = *(const bf16x8*)(wp + 32 * sx); acc = __builtin_amdgcn_mfma_f32_16x16x32_bf16(a, b, acc, 0, 0, 0); }
#pragma unroll
        for (int jj = 0; jj < 4; ++jj) glr[(tile * 16 + 4 * fq + jj) * 16 + fr] = acc[jj];
    }
}

__device__ __forceinline__ void gla_decay(const Ctx cx, KP p, LAS unsigned char* lds, const int j) {
    const int tid = cx.tid, G = cx.G;
    const float* glr = (const float*)(p->ws + WS_ACT + ACT_GLR); float* etot = (float*)(p->ws + WS_ACT + ACT_ETOT);
    const bf16_t* KT = (const bf16_t*)(p->ws + WS_ACT + ACT_KT); bf16_t* KD = (bf16_t*)(p->ws + WS_ACT + ACT_KD);
    LAS float* gl = (LAS float*)lds;
    for (int it = cx.bid; it < 256; it += G) {
        const int c = it >> 1, kk = (it & 1) * 512 + tid;
        __syncthreads();
        gl[tid] = glr[c * 1024 + tid]; gl[tid + 512] = glr[c * 1024 + 512 + tid];
        __syncthreads();
        float w2[16];
#pragma unroll
        for (int r = 0; r < 16; ++r) w2[r] = p->gla_gate_w2[((size_t)j * 16 + r) * NQK + kk];
        const float gb = p->gla_gate_b[j * NQK + kk];
        float cum[64]; float run = 0.f;
#pragma unroll
        for (int t = 0; t < 64; ++t) {
            float xx = gb;
#pragma unroll
            for (int r4 = 0; r4 < 4; ++r4) { const f32x4 gv = *(const LAS f32x4*)(gl + t * 16 + r4 * 4); xx += gv[0] * w2[r4 * 4] + gv[1] * w2[r4 * 4 + 1] + gv[2] * w2[r4 * 4 + 2] + gv[3] * w2[r4 * 4 + 3]; }
            const float la = -(fmaxf(-xx, 0.f) + __logf(1.0f + __expf(-fabsf(xx)))) * 0.0625f;
            run += la; cum[t] = run;
        }
        etot[c * 1024 + kk] = __expf(run);
        const bf16_t* kp = KT + (size_t)kk * SEQ + c * 64; bf16_t* ko = KD + (size_t)kk * SEQ + c * 64;
        u32x4 kin[8];
#pragma unroll
        for (int q = 0; q < 8; ++q) kin[q] = *(const u32x4*)(kp + q * 8);
#pragma unroll
        for (int q = 0; q < 8; ++q) {
            u32x4 kv = kin[q];
            kv.x = pk2(bflo(kv.x) * __expf(run - cum[q * 8 + 0]), bfhi(kv.x) * __expf(run - cum[q * 8 + 1]));
            kv.y = pk2(bflo(kv.y) * __expf(run - cum[q * 8 + 2]), bfhi(kv.y) * __expf(run - cum[q * 8 + 3]));
            kv.z = pk2(bflo(kv.z) * __expf(run - cum[q * 8 + 4]), bfhi(kv.z) * __expf(run - cum[q * 8 + 5]));
            kv.w = pk2(bflo(kv.w) * __expf(run - cum[q * 8 + 6]), bfhi(kv.w) * __expf(run - cum[q * 8 + 7]));
            *(u32x4*)(ko + q * 8) = kv;
        }
    }
}

template <bool P2>
__device__ __forceinline__ void gla_scan2(const Ctx cx, KP p, LAS unsigned char* lds, const int j) {
    const int tid = cx.tid, w = __builtin_amdgcn_readfirstlane(tid >> 6), lane = tid & 63, fr = lane & 15, fq = lane >> 4;
    const bf16_t* QS = (const bf16_t*)(p->ws + WS_ACT + ACT_QS); const bf16_t* KT = (const bf16_t*)(p->ws + WS_ACT + ACT_KD);
    const bf16_t* VT = (const bf16_t*)(p->ws + WS_ACT + ACT_Y2); const bf16_t* ZS = (const bf16_t*)(p->ws + WS_ACT + ACT_ZS);
    bf16_t* Y = (bf16_t*)(p->ws + WS_ACT + ACT_YB); const float* etot = (const float*)(p->ws + WS_ACT + ACT_ETOT); float* part = (float*)(p->ws + WS_ACT + ACT_SSQ);
    float* SEND = (float*)(p->ws + WS_ACT + ACT_E); float* DSEG = (float*)(p->ws + WS_ACT + ACT_DSEG);
    const float* ng = p->gla_norm_g + (size_t)j * DI;
    LAS unsigned char* KD = lds;
    LAS unsigned char* QP = lds + 36864;
    LAS float* ET = (LAS float*)(lds + 36864 + 33792);
    LAS float* SQ = ET + 256;
    LAS unsigned char* ZT = lds + 73728;
    LAS unsigned char* YT = lds + 91136;
    for (int it = cx.bid; it < 256; it += cx.G) {
        const int xcd = it & 7, idx = it >> 3, P = xcd * 4 + (idx >> 3), h = P >> 3, seg = P & 7, slice = idx & 7;
        if (!P2 && seg == 7) continue;
        const int dv0 = h * 1024 + slice * 128 + 16 * w, c0 = seg * 16;
        const unsigned kgo = (unsigned)((h * 256 + (tid >> 3)) * SEQ + (tid & 7) * 8) * 2u;
        const unsigned qgo = (unsigned)((tid >> 5) * NQK + h * 256 + (tid & 31) * 8) * 2u;
        const unsigned ego = (unsigned)(h * 256 + 4 * (tid & 63)) * 4u;
        const unsigned vgo = (unsigned)((dv0 + fr) * SEQ + 8 * fq) * 2u;
        const unsigned zto = (unsigned)((tid >> 4) * DI + h * 1024 + slice * 128) * 2u + (unsigned)(tid & 15) * 16u;
        const unsigned ztl = (unsigned)(tid >> 4) * 272u + (unsigned)(tid & 15) * 16u, zfl = (unsigned)fr * 272u + (unsigned)(16 * w + 4 * fq) * 2u;
        const unsigned kl = (tid >> 3) * 144 + (tid & 7) * 16, ql = (tid >> 5) * 528 + (tid & 31) * 16;
        f32x4 S[16];
#pragma unroll
        for (int kt = 0; kt < 16; ++kt) S[kt] = (f32x4){0.f, 0.f, 0.f, 0.f};
        if (P2) {
            for (int sp = 0; sp < seg; ++sp) {
                const float* dp = DSEG + sp * 1024 + h * 256 + 4 * fq;
                const float* se = SEND + ((size_t)(((h * 8 + slice) * 8 + sp) * 8 + w) * 16) * 256 + lane * 4;
                f32x4 dd[16], ee[16];
#pragma unroll
                for (int kt = 0; kt < 16; ++kt) { dd[kt] = *(const f32x4*)(dp + 16 * kt); ee[kt] = *(const f32x4*)(se + kt * 256); }
#pragma unroll
                for (int kt = 0; kt < 16; ++kt) S[kt] = S[kt] * dd[kt] + ee[kt];
            }
        } else if (slice == 0 && tid < 256) {
            float pr = 1.0f;
            for (int c = 0; c < 16; ++c) pr *= etot[(c0 + c) * 1024 + h * 256 + tid];
            DSEG[seg * 1024 + h * 256 + tid] = pr;
        }
        f32x4 g4 = {0.f, 0.f, 0.f, 0.f};
        if (P2) g4 = *(const f32x4*)(ng + dv0 + 4 * fq);
        u32x4 rk[4], rq[4]; f32x4 re = {0.f, 0.f, 0.f, 0.f}; bf16x8 rv0, rv1; u32x4 rz2[2] = {};
#define SC_LOAD(c) do { const int c_ = (c); \
        _Pragma("unroll") for (int i = 0; i < 4; ++i) rk[i] = *(const u32x4*)((const char*)KT + (kgo + (unsigned)(i * 64 * SEQ + c_ * 64) * 2u)); \
        if (P2) { _Pragma("unroll") for (int i = 0; i < 4; ++i) rq[i] = *(const u32x4*)((const char*)QS + (qgo + (unsigned)((c_ * 64 + 16 * i) * NQK) * 2u)); } \
        if (tid < 64) re = *(const f32x4*)((const char*)etot + (ego + (unsigned)c_ * 4096u)); \
        if (P2) { rz2[0] = *(const u32x4*)((const char*)ZS + (zto + (unsigned)(c_ * 64 * DI) * 2u)); rz2[1] = *(const u32x4*)((const char*)ZS + (zto + (unsigned)((c_ * 64 + 32) * DI) * 2u)); } \
        } while (0)
#define SC_LOADV(c) do { const int cv_ = (c); rv0 = *(const bf16x8*)((const char*)VT + (vgo + (unsigned)cv_ * 128u)); rv1 = *(const bf16x8*)((const char*)VT + (vgo + (unsigned)cv_ * 128u + 64u)); } while (0)
        SC_LOAD(c0); SC_LOADV(c0);
#pragma nounroll
        for (int cc = 0; cc < 16; ++cc) {
            const int c = c0 + cc;
            __syncthreads();
            if (P2 && cc > 0) {
#pragma unroll
                for (int i = 0; i < 2; ++i) { const u32x4 yv4 = *(const LAS u32x4*)(YT + ztl + i * 32 * 272); *(u32x4*)((char*)Y + (zto + (unsigned)(((c - 1) * 64 + 32 * i) * DI) * 2u)) = yv4; } }
            if (P2 && cc > 0 && tid < 64) { float sm = 0.f;
#pragma unroll
                for (int ww = 0; ww < 8; ++ww) sm += SQ[ww * 64 + tid];
                part[(((size_t)(c - 1) * 4 + h) * 8 + slice) * 64 + tid] = sm; }
#pragma unroll
            for (int i = 0; i < 4; ++i) *(LAS u32x4*)(KD + kl + i * 9216) = rk[i];
            if (P2) {
#pragma unroll
                for (int i = 0; i < 4; ++i) *(LAS u32x4*)(QP + ql + i * 8448) = rq[i]; }
            if (tid < 64) *(LAS f32x4*)(ET + 4 * tid) = re;
            if (P2) { *(LAS u32x4*)(ZT + ztl) = rz2[0]; *(LAS u32x4*)(ZT + ztl + 32 * 272) = rz2[1]; }
            __syncthreads();
            if (cc + 1 < 16) SC_LOAD(c + 1);
#pragma unroll
            for (int kb = 0; kb < 4; ++kb) {
                f32x4 e[4]; bf16x8 a0[4], a1[4];
#pragma unroll
                for (int i = 0; i < 4; ++i) { const int kt = 4 * kb + i;
                    e[i] = *(const LAS f32x4*)(ET + 16 * kt + 4 * fq);
                    a0[i] = *(const LAS bf16x8*)(KD + (16 * kt + fr) * 144 + fq * 16); a1[i] = *(const LAS bf16x8*)(KD + (16 * kt + fr) * 144 + 64 + fq * 16); }
                __builtin_amdgcn_sched_barrier(0);
#pragma unroll
                for (int i = 0; i < 4; ++i) { const int kt = 4 * kb + i;
                    S[kt] *= e[i];
                    S[kt] = __builtin_amdgcn_mfma_f32_16x16x32_bf16(a0[i], rv0, S[kt], 0, 0, 0);
                    S[kt] = __builtin_amdgcn_mfma_f32_16x16x32_bf16(a1[i], rv1, S[kt], 0, 0, 0); }
                __builtin_amdgcn_sched_barrier(0);
            }
            if (cc + 1 < 16) SC_LOADV(c + 1);
            if (P2) {
                bf16x8 sb[8];
#pragma unroll
                for (int q = 0; q < 8; ++q) { u32x4 t4; t4.x = pk2(S[2 * q][0], S[2 * q][1]); t4.y = pk2(S[2 * q][2], S[2 * q][3]); t4.z = pk2(S[2 * q + 1][0], S[2 * q + 1][1]); t4.w = pk2(S[2 * q + 1][2], S[2 * q + 1][3]); sb[q] = __builtin_bit_cast(bf16x8, t4); }
#pragma unroll
                for (int tt = 0; tt < 4; ++tt) {
                    f32x4 o = {0.f, 0.f, 0.f, 0.f}, o2 = o;
#pragma unroll
                    for (int qh = 0; qh < 2; ++qh) {
                        bf16x8 qf[4];
#pragma unroll
                        for (int q = 0; q < 4; ++q) qf[q] = *(const LAS bf16x8*)(QP + (16 * tt + fr) * 528 + (4 * qh + q) * 64 + fq * 16);
                        __builtin_amdgcn_sched_barrier(0);
#pragma unroll
                        for (int q = 0; q < 4; q += 2) { o = __builtin_amdgcn_mfma_f32_16x16x32_bf16(sb[4 * qh + q], qf[q], o, 0, 0, 0); o2 = __builtin_amdgcn_mfma_f32_16x16x32_bf16(sb[4 * qh + q + 1], qf[q + 1], o2, 0, 0, 0); }
                        __builtin_amdgcn_sched_barrier(0);
                    }
                    o += o2;
                    float sq = (o[0] * o[0] + o[1] * o[1]) + (o[2] * o[2] + o[3] * o[3]);
                    sq += __shfl_xor(sq, 16); sq += __shfl_xor(sq, 32);
                    if (fq == 0) SQ[w * 64 + 16 * tt + fr] = sq;
                    const u32x2 zt = *(const LAS u32x2*)(ZT + zfl + tt * 16 * 272);
                    u32x2 yv; yv.x = pk2(o[0] * g4[0] * bflo(zt.x), o[1] * g4[1] * bfhi(zt.x)); yv.y = pk2(o[2] * g4[2] * bflo(zt.y), o[3] * g4[3] * bfhi(zt.y));
                    *(LAS u32x2*)(YT + zfl + tt * 16 * 272) = yv;
                }
            }
        }
#undef SC_LOAD
#undef SC_LOADV
        if (P2) { __syncthreads();
#pragma unroll
            for (int i = 0; i < 2; ++i) { const u32x4 yv4 = *(const LAS u32x4*)(YT + ztl + i * 32 * 272); *(u32x4*)((char*)Y + (zto + (unsigned)(((c0 + 15) * 64 + 32 * i) * DI) * 2u)) = yv4; }
            if (tid < 64) { float sm = 0.f;
#pragma unroll
                for (int ww = 0; ww < 8; ++ww) sm += SQ[ww * 64 + tid];
                part[(((size_t)(c0 + 15) * 4 + h) * 8 + slice) * 64 + tid] = sm; } }
        if (!P2) {
            float* se = SEND + ((size_t)(((h * 8 + slice) * 8 + seg) * 8 + w) * 16) * 256 + lane * 4;
#pragma unroll
            for (int kt = 0; kt < 16; ++kt) *(f32x4*)(se + kt * 256) = S[kt];
        }
        __syncthreads();
    }
}

__device__ __forceinline__ void gla_rms(const Ctx cx, KP p, LAS unsigned char* lds) {
    const int tid = cx.tid, G = cx.G;
    bf16_t* Y = (bf16_t*)(p->ws + WS_ACT + ACT_YB); const float* part = (const float*)(p->ws + WS_ACT + ACT_SSQ);
    LAS float* ps = (LAS float*)lds;
    LAS float* rsd = ps + 512;
    for (int it = cx.bid; it < 256; it += G) {
        const int c = it >> 1, half = it & 1;
        { const int h = tid >> 7, sg = (tid >> 5) & 3, tl = tid & 31;
          const float* pp = part + (((size_t)c * 4 + h) * 8 + sg * 2) * 64 + half * 32 + tl;
          float s = pp[0] + pp[64];
          __syncthreads();
          ps[tid] = s;
          __syncthreads();
          if (tid < 128) { const int hh = tid >> 5, t2 = tid & 31; const float tot = ps[hh * 128 + t2] + ps[hh * 128 + 32 + t2] + ps[hh * 128 + 64 + t2] + ps[hh * 128 + 96 + t2];
              rsd[tid] = rsqrtf(tot * (1.0f / 1024.0f) + 1e-6f); }
          __syncthreads(); }
        const int t0 = c * 64 + half * 32;
        for (int b = 0; b < 4; ++b) {
            u32x4 y[8];
#pragma unroll
            for (int i = 0; i < 8; ++i) { const int v = tid + (b * 8 + i) * NT; y[i] = *(const u32x4*)(Y + (size_t)(t0 + (v >> 9)) * DI + (v & 511) * 8); }
#pragma unroll
            for (int i = 0; i < 8; ++i) {
                const int v = tid + (b * 8 + i) * NT, tl = v >> 9, col = (v & 511) * 8; const float rs = rsd[(col >> 10) * 32 + tl];
                u32x4 o; o.x = pk2(bflo(y[i].x) * rs, bfhi(y[i].x) * rs); o.y = pk2(bflo(y[i].y) * rs, bfhi(y[i].y) * rs); o.z = pk2(bflo(y[i].z) * rs, bfhi(y[i].z) * rs); o.w = pk2(bflo(y[i].w) * rs, bfhi(y[i].w) * rs);
                *(u32x4*)(Y + (size_t)(t0 + tl) * DI + col) = o; }
        }
    }
}

__device__ __forceinline__ void ln_phase(const Ctx cx, KP p, const int layer) {
    const int tid = cx.tid, w = tid >> 6, lane = tid & 63;
    const float* R = (const float*)(p->ws + WS_ACT + ACT_E); float* Xo = (layer == 3) ? p->out : (float*)(p->ws + WS_X);
    bf16_t* U = (bf16_t*)(p->ws + WS_U);
    const float* g = p->ln_g + layer * DM; const float* b = p->ln_b + layer * DM;
    const float* mod = (const float*)(p->ws + WS_MOD) + (layer < 3 ? (layer + 1) * 6144 : 0);
    for (int row = cx.bid * 8 + w; row < SEQ; row += cx.G * 8) {
        f32x4 v[8]; float s = 0.f;
#pragma unroll
        for (int i = 0; i < 8; ++i) { v[i] = *(const f32x4*)(R + (size_t)row * DM + 256 * i + 4 * lane); s += (v[i][0] + v[i][1]) + (v[i][2] + v[i][3]); }
        s = wave_sum(s); const float mu = s * (1.0f / 2048.0f);
        float q = 0.f;
#pragma unroll
        for (int i = 0; i < 8; ++i) { const f32x4 d = v[i] - mu; q += (d[0] * d[0] + d[1] * d[1]) + (d[2] * d[2] + d[3] * d[3]); }
        q = wave_sum(q); const float rs = rsqrtf(q * (1.0f / 2048.0f) + 1e-5f);
#pragma unroll
        for (int i = 0; i < 8; ++i) {
            const int col = 256 * i + 4 * lane;
            const f32x4 y = (v[i] - mu) * rs * *(const f32x4*)(g + col) + *(const f32x4*)(b + col);
            *(f32x4*)(Xo + (size_t)row * DM + col) = y;
            if (layer < 3) { const f32x4 uv = y * (*(const f32x4*)(mod + 2048 + col) + 1.0f) + *(const f32x4*)(mod + col);
                u32x2 wv; wv.x = pk2(uv[0], uv[1]); wv.y = pk2(uv[2], uv[3]); *(u32x2*)(U + (size_t)row * DM + col) = wv; }
        }
    }
}

__device__ __forceinline__ void s5_carry(const Ctx cx, KP p, LAS unsigned char* lds) {
    const int tid = cx.tid, w = __builtin_amdgcn_readfirstlane(tid >> 6), lane = tid & 63;
    const float* E = (const float*)(p->ws + WS_ACT + ACT_E); bf16_t* UC = (bf16_t*)(p->ws + WS_ACT + ACT_UCAT); const float* LT = (const float*)(p->ws + WS_LAMT);
    LAS float* endst = (LAS float*)lds;
    for (int g = cx.bid; g < 256; g += cx.G) {
        const float lr = LT[g * 128 + lane], li = LT[g * 128 + 64 + lane];
        const float* Eg = E + ((size_t)g * 512 + 64 * w) * 128 + lane;
        float xr = 0.f, xi = 0.f;
        for (int b = 0; b < 2; ++b) {
            float er[32], ei[32];
#pragma unroll
            for (int s = 0; s < 32; ++s) { er[s] = Eg[(32 * b + s) * 128]; ei[s] = Eg[(32 * b + s) * 128 + 64]; }
#pragma unroll
            for (int s = 0; s < 32; ++s) { const float nr = lr * xr - li * xi + er[s], ni = lr * xi + li * xr + ei[s]; xr = nr; xi = ni; }
        }
        __syncthreads();
        endst[w * 128 + lane] = xr; endst[w * 128 + 64 + lane] = xi;
        float pr = lr, pi = li;
#pragma unroll
        for (int q = 0; q < 6; ++q) { const float nr = pr * pr - pi * pi, ni = 2.0f * pr * pi; pr = nr; pi = ni; }
        __syncthreads();
        float cr = 0.f, ci = 0.f;
        for (int ww = 0; ww < w; ++ww) { const float tr = pr * cr - pi * ci + endst[ww * 128 + lane], ti = pr * ci + pi * cr + endst[ww * 128 + 64 + lane]; cr = tr; ci = ti; }
        xr = cr; xi = ci;
        bf16_t* Ug = UC + ((size_t)g * 512 + 64 * w) * 384 + 256 + lane;
        for (int b = 0; b < 2; ++b) {
            float er[32], ei[32];
#pragma unroll
            for (int s = 0; s < 32; ++s) { er[s] = Eg[(32 * b + s) * 128]; ei[s] = Eg[(32 * b + s) * 128 + 64]; }
#pragma unroll
            for (int s = 0; s < 32; ++s) {
                Ug[(size_t)(32 * b + s) * 384] = (bf16_t)(pk2(xr, 0.f) & 0xffffu); Ug[(size_t)(32 * b + s) * 384 + 64] = (bf16_t)(pk2(xi, 0.f) & 0xffffu);
                const float nr = lr * xr - li * xi + er[s], ni = lr * xi + li * xr + ei[s]; xr = nr; xi = ni; }
        }
    }
}

#define XB_TMO      128
#define XB_XCNT(j)  (256  + 64 * (j))
#define XB_XSUB(j)  (1280 + 64 * (j))
#define XB_XGEN(j)  (2304 + 64 * (j))
#define XB_TOP      3328
#define XB_TOPGEN   3392
#define XCD_BAR_WORDS 3456
#define XB_SPIN_CAP (1u << 18)
__device__ __forceinline__ unsigned xb_ld(unsigned* p)              { return __hip_atomic_load(p, __ATOMIC_RELAXED, __HIP_MEMORY_SCOPE_AGENT); }
__device__ __forceinline__ unsigned xb_add(unsigned* p, unsigned v) { return __hip_atomic_fetch_add(p, v, __ATOMIC_RELAXED, __HIP_MEMORY_SCOPE_AGENT); }
__device__ __forceinline__ unsigned xb_xcc_id() { return (unsigned)__builtin_amdgcn_s_getreg((3 << 11) | 20) & 0xFu; }
#define XB_SPIN(cond, bar) do { unsigned _sp = 0; while (cond) { __builtin_amdgcn_s_sleep(1); \
    if ((++_sp & 255u) == 0u) { if (xb_ld(&(bar)[XB_TMO])) break; if (_sp > XB_SPIN_CAP) { atomicAdd(&(bar)[XB_TMO], 1u); break; } } } } while (0)
struct XcdBarrier { unsigned* bar; unsigned x; volatile LAS unsigned* st; };
__device__ __forceinline__ XcdBarrier xcd_barrier_post(unsigned* bar, volatile LAS unsigned* st) {
    XcdBarrier b; b.bar = bar; b.x = xb_xcc_id(); b.st = st;
    if (threadIdx.x == 0) (void)xb_add(&bar[XB_XCNT(b.x)], 1u);
    return b;
}
__device__ __forceinline__ void xcd_barrier_complete(unsigned* bar, unsigned x, unsigned& nloc, unsigned& nx) {
    const unsigned G = gridDim.x * gridDim.y * gridDim.z;
    unsigned sum, cnt, mine, sp = 0u;
    for (;;) {
        sum = 0u; cnt = 0u; mine = 0u;
#pragma unroll
        for (unsigned j = 0; j < 16; ++j) { const unsigned c = xb_ld(&bar[XB_XCNT(j)]); sum += c; cnt += (c > 0u) ? 1u : 0u; mine = (j == x) ? c : mine; }
        if (sum == G) break;
        __builtin_amdgcn_s_sleep(1);
        if ((++sp & 255u) == 0u) { if (xb_ld(&bar[XB_TMO])) break; if (sp > XB_SPIN_CAP) { atomicAdd(&bar[XB_TMO], 1u); break; } }
    }
    nloc = mine > 0u ? mine : 1u; nx = cnt > 0u ? cnt : 1u;
}
__device__ __forceinline__ void xcd_barrier(const XcdBarrier& b) {
    asm volatile("s_waitcnt vmcnt(0)" ::: "memory");
    __syncthreads();
    if (threadIdx.x == 0) {
        unsigned* bar = b.bar;
        __builtin_amdgcn_s_waitcnt(0);
        unsigned nloc = b.st[0], nx = b.st[1];
        if (nloc == 0u) { xcd_barrier_complete(bar, b.x, nloc, nx); b.st[0] = nloc; b.st[1] = nx; }
        const unsigned old = xb_add(&bar[XB_XSUB(b.x)], 1u);
        const unsigned gen = old / nloc;
        if (old + 1u == (gen + 1u) * nloc) {
            __builtin_amdgcn_fence(__ATOMIC_RELEASE, "agent");
            asm volatile("s_waitcnt vmcnt(0)" ::: "memory");
            const unsigned og = xb_add(&bar[XB_TOP], 1u);
            const unsigned tg = og / nx;
            if (og + 1u == (tg + 1u) * nx) xb_add(&bar[XB_TOPGEN], 1u);
            else XB_SPIN(xb_ld(&bar[XB_TOPGEN]) == tg, bar);
            __builtin_amdgcn_fence(__ATOMIC_ACQUIRE, "agent");
            xb_add(&bar[XB_XGEN(b.x)], 1u);
            asm volatile("s_waitcnt vmcnt(0)" ::: "memory");
        } else {
            XB_SPIN(xb_ld(&bar[XB_XGEN(b.x)]) == gen, bar);
            __builtin_amdgcn_fence(__ATOMIC_ACQUIRE, "agent");
            asm volatile("s_waitcnt vmcnt(0)" ::: "memory");
        }
    }
    __syncthreads();
}

__device__ __forceinline__ void run_phase(const Ctx cx, KP p, LAS unsigned char* lds, const int ph) {
    const int G = cx.G, c = cx.bid;
    if (ph == 0) { phase_prep(cx, p, lds); return; }
    if (ph == 1) { phase_mod_u0(cx, p); return; }
    const int layer = (ph - 2) / 7, q = (ph - 2) % 7;
    const int j = layer >> 1;
    const float* Xcur = (layer == 0) ? p->x : (const float*)(p->ws + WS_X);
    const float* gate = (const float*)(p->ws + WS_MOD) + layer * 6144 + 4096;
    unsigned char* act = p->ws + WS_ACT;
    if ((layer & 1) == 0) {
        if (q == 0) {
            gla_glr(cx, p, j);
            SchedGlaIn S{(const char*)(p->ws + WS_U), (const char*)(p->ws + WS_WG + (size_t)j * 10240 * DM * 2), G, c};
            EpiGlaIn E{(bf16_t*)(act + ACT_QS), (bf16_t*)(act + ACT_ZS), (bf16_t*)(act + ACT_KT), (bf16_t*)(act + ACT_Y2)};
            pg8::gemm_phase(cx, lds, DM, DM, DM, 1, S, E);
        } else if (q == 1) { gla_decay(cx, p, lds, j); if (MK_PROBE_DECAY && layer == 0) { asm volatile("" ::: "memory"); gla_decay(cx, p, lds, j); } if (layer == 2) s5_tables(cx, p, lds, 1); }
        else if (q == 2) gla_scan2<false>(cx, p, lds, j);
        else if (q == 3) gla_scan2<true>(cx, p, lds, j);
        else if (q == 4) { if (cx.G != 256) gla_rms(cx, p, lds); }
        else if (q == 5) {
            SchedPlain S{(const char*)(act + ACT_YB), (const char*)(p->ws + WS_WGO + (size_t)j * DM * DI * 2), 32, 8, G, c, (size_t)256 * DI * 2, (size_t)256 * DI * 2, 0};
            if (cx.G == 256) {
                EpiOutLn<true> E{(const float*)(act + ACT_SSQ), Xcur, (layer == 3) ? p->out : (float*)(p->ws + WS_X), (bf16_t*)(p->ws + WS_U), gate, p->ln_g + layer * DM, p->ln_b + layer * DM,
                           (layer < 3) ? (const float*)(p->ws + WS_MOD) + (layer + 1) * 6144 : (const float*)nullptr, (unsigned long long*)(p->ws + WS_XBUF), (unsigned*)(p->ws + WS_CNT) + layer * 2048};
                pg8::gemm_phase(cx, lds, DI, DI, DI, 1, S, E);
            } else { EpiOut E{Xcur, (float*)(act + ACT_E), gate}; pg8::gemm_phase(cx, lds, DI, DI, DI, 1, S, E); }
        } else if (cx.G != 256) ln_phase(cx, p, layer);
    } else {
        if (q == 0) {
            SchedPlain S{(const char*)(p->ws + WS_U), (const char*)(p->ws + WS_WSI + (size_t)j * 8192 * DM * 2), 32, 32, G, c, (size_t)256 * DM * 2, (size_t)256 * DM * 2, 1};
            EpiS5In E{(bf16_t*)(act + ACT_UCAT), (bf16_t*)(act + ACT_ZS)};
            pg8::gemm_phase(cx, lds, DM, DM, DM, 1, S, E);
        } else if (q == 1) {
            if (cx.G == 256) {
                { SchedGroupLocal S{(const char*)(act + ACT_UCAT), (const char*)(p->ws + WS_WE), (size_t)512 * 384 * 2, (size_t)128 * 256 * 2, (size_t)256 * 384 * 2, cx.bid};
                  EpiS5E E{(float*)(act + ACT_E)};
                  pg8::gemm_phase(cx, lds, 256, 384, 256, 0, S, E); }
                asm volatile("s_waitcnt vmcnt(0)" ::: "memory"); __syncthreads();
                s5_carry(cx, p, lds);
                asm volatile("s_waitcnt vmcnt(0)" ::: "memory"); __syncthreads();
                { SchedGroupLocal S{(const char*)(act + ACT_UCAT), (const char*)(p->ws + WS_MG), (size_t)512 * 384 * 2, (size_t)256 * 384 * 2, (size_t)256 * 384 * 2, cx.bid};
                  EpiS5Y E{(const bf16_t*)(act + ACT_UCAT), (bf16_t*)(act + ACT_YB), p->s5_d + (size_t)j * DI};
                  pg8::gemm_phase(cx, lds, 384, 384, 384, 1, S, E); }
            } else {
                SchedGroup S{(const char*)(act + ACT_UCAT), (const char*)(p->ws + WS_WE), (size_t)512 * 384 * 2, (size_t)128 * 256 * 2, (size_t)256 * 384 * 2, G, c};
                EpiS5E E{(float*)(act + ACT_E)};
                pg8::gemm_phase(cx, lds, 256, 384, 256, 0, S, E);
            }
        } else if (q == 2) { if (cx.G != 256) s5_carry(cx, p, lds); }
        else if (q == 3) {
            if (cx.G != 256) {
                SchedGroup S{(const char*)(act + ACT_UCAT), (const char*)(p->ws + WS_MG), (size_t)512 * 384 * 2, (size_t)256 * 384 * 2, (size_t)256 * 384 * 2, G, c};
                EpiS5Y E{(const bf16_t*)(act + ACT_UCAT), (bf16_t*)(act + ACT_YB), p->s5_d + (size_t)j * DI};
                pg8::gemm_phase(cx, lds, 384, 384, 384, 1, S, E);
            }
        } else if (q == 4) {
            SchedPlain S{(const char*)(act + ACT_YB), (const char*)(p->ws + WS_WGLU + (size_t)j * DI * DI * 2), 32, 16, G, c, (size_t)256 * DI * 2, (size_t)256 * DI * 2, 0};
            EpiGlu E{(const bf16_t*)(act + ACT_YB), (const bf16_t*)(act + ACT_ZS), (bf16_t*)(act + ACT_Y2), p->s5_b_glu + (size_t)j * DI};
            pg8::gemm_phase<EpiGlu, SchedPlain, MK_KREP_GLU>(cx, lds, DI, DI, DI, 1, S, E);
        } else if (q == 5) {
            SchedPlain S{(const char*)(act + ACT_Y2), (const char*)(p->ws + WS_WSO + (size_t)j * DM * DI * 2), 32, 8, G, c, (size_t)256 * DI * 2, (size_t)256 * DI * 2, 0};
            if (cx.G == 256) {
                EpiOutLn<false> E{(const float*)nullptr, Xcur, (layer == 3) ? p->out : (float*)(p->ws + WS_X), (bf16_t*)(p->ws + WS_U), gate, p->ln_g + layer * DM, p->ln_b + layer * DM,
                           (layer < 3) ? (const float*)(p->ws + WS_MOD) + (layer + 1) * 6144 : (const float*)nullptr, (unsigned long long*)(p->ws + WS_XBUF), (unsigned*)(p->ws + WS_CNT) + layer * 2048};
                pg8::gemm_phase(cx, lds, DI, DI, DI, 1, S, E);
            } else { EpiOut E{Xcur, (float*)(act + ACT_E), gate}; pg8::gemm_phase(cx, lds, DI, DI, DI, 1, S, E); }
        } else if (cx.G != 256) ln_phase(cx, p, layer);
    }
}

__global__ void __launch_bounds__(NT, 2) fwd_megakernel(Params p_unused) {
    extern __shared__ __attribute__((aligned(16))) unsigned char lds_raw[];
    LAS unsigned char* lds = (LAS unsigned char*)lds_raw;
    KP kp0 = (KP)__builtin_amdgcn_kernarg_segment_ptr();
    const int ph_lo = kp0->ph_lo, ph_hi = kp0->ph_hi, coop = kp0->coop;
    XcdBarrier bar; bar.bar = (unsigned*)(kp0->ws + WS_BAR); bar.x = 0; bar.st = (volatile LAS unsigned*)(lds + LDS_STAGE);
    if (coop) { if (threadIdx.x < 4) ((LAS unsigned*)(lds + LDS_STAGE))[threadIdx.x] = 0u; __syncthreads(); bar = xcd_barrier_post((unsigned*)(kp0->ws + WS_BAR), (volatile LAS unsigned*)(lds + LDS_STAGE)); }
    for (int ph = ph_lo; ph < ph_hi; ++ph) {
        if (gridDim.x == 256 && ph >= 2 && ((ph - 2) % 7 == 6 || ((ph - 2) % 7 == 4 && (((ph - 2) / 7) & 1) == 0) || (((ph - 2) % 7 == 2 || (ph - 2) % 7 == 3) && (((ph - 2) / 7) & 1) == 1))) continue;
#if MK_REPEAT_MASK
        for (int rep = 0; rep < ((MK_REPEAT_MASK >> ph) & 1) + 1; ++rep)
#endif
        {
            KP kp = kp0; asm volatile("" : "+s"(kp));
            Ctx cx; cx.tid = threadIdx.x; cx.bid = blockIdx.x; cx.G = gridDim.x;
            asm volatile("" : "+v"(cx.tid)); asm volatile("" : "+s"(cx.bid)); asm volatile("" : "+s"(cx.G));
            run_phase(cx, kp, lds, ph);
        }
        if (coop && ph + 1 < ph_hi) { if (coop == 2) cg::this_grid().sync(); else xcd_barrier(bar); }
    }
}

#ifndef MK_ONE_LAUNCH
#define MK_ONE_LAUNCH 1
#endif

extern "C" void kernel_launch(void* const* d_in, const int* in_sizes, int n_in, void* d_out, int out_size, void* d_ws, size_t ws_size, hipStream_t stream) {
    static int grid = 0;
    if (grid == 0) {
        if (n_in != 23 || ws_size < WS_END) { fprintf(stderr, "kernel_launch: need 23 inputs and %zu bytes of workspace, got %d / %zu\n", (size_t)WS_END, n_in, ws_size); grid = -1; return; }
        int dev = 0, cus = 0, per_cu = 0;
        hipGetDevice(&dev); hipDeviceGetAttribute(&cus, hipDeviceAttributeMultiprocessorCount, dev);
        if (hipFuncSetAttribute((const void*)fwd_megakernel, hipFuncAttributeMaxDynamicSharedMemorySize, LDS_BYTES) != hipSuccess) { fprintf(stderr, "kernel_launch: hipFuncSetAttribute failed\n"); grid = -1; return; }
        if (hipOccupancyMaxActiveBlocksPerMultiprocessor(&per_cu, (const void*)fwd_megakernel, NT, LDS_BYTES) != hipSuccess || per_cu < 1) { fprintf(stderr, "kernel_launch: occupancy query gave %d\n", per_cu); per_cu = 1; }
        (void)hipGetLastError();
        grid = cus;
    }
    if (grid < 0) return;
    Params hp{};
    const float** pp = (const float**)&hp;
    for (int i = 0; i < 23; ++i) pp[i] = (const float*)d_in[i];
    hp.out = (float*)d_out; hp.ws = (unsigned char*)d_ws; hp.pad = 0;
#if MK_ONE_LAUNCH
    if (hipMemsetAsync((char*)d_ws + WS_BAR, 0, 16384 + 32768, stream) != hipSuccess) { fprintf(stderr, "kernel_launch: memset of the barrier words failed\n"); return; }
    hp.ph_lo = 0; hp.ph_hi = NPH; hp.coop = 1;
    void* args[] = {&hp};
    hipError_t e = hipLaunchCooperativeKernel((const void*)fwd_megakernel, dim3(grid), dim3(NT), args, LDS_BYTES, stream);
    if (e != hipSuccess) fprintf(stderr, "cooperative launch failed: %s (grid %d)\n", hipGetErrorString(e), grid);
#else
    hp.coop = 0;
    for (int ph = 0; ph < NPH; ++ph) { hp.ph_lo = ph; hp.ph_hi = ph + 1; hipLaunchKernelGGL(fwd_megakernel, dim3(grid), dim3(NT), LDS_BYTES, stream, hp); }
#endif
}
```

```cpp
#include <hip/hip_runtime.h>
#include <hip/hip_cooperative_groups.h>
#include <cstdio>
namespace cg = cooperative_groups;

#define LAS __attribute__((address_space(3)))
typedef unsigned short bf16_t;
typedef short bf16x8 __attribute__((ext_vector_type(8)));
typedef short s16x4 __attribute__((ext_vector_type(4)));
typedef float f32x4 __attribute__((ext_vector_type(4)));
typedef float f32x2 __attribute__((ext_vector_type(2)));
typedef unsigned u32x4 __attribute__((ext_vector_type(4)));
typedef unsigned u32x2 __attribute__((ext_vector_type(2)));

constexpr int SEQ = 8192, DM = 2048, DI = 4096, NQK = 1024;
constexpr int GLA_W = 10256;
constexpr float DN_ALPHA = 1.6817928305074290f;
#ifndef MK_REPEAT_MASK
#define MK_REPEAT_MASK 0
#endif
#ifndef MK_KREP_GLU
#define MK_KREP_GLU 1
#endif
#ifndef MK_PROBE_DECAY
#define MK_PROBE_DECAY 0
#endif
constexpr int NPH = 30;
constexpr int NT = 512;
constexpr int LDS_STAGE = 131072;
constexpr int LDS_RT = LDS_STAGE + 16;
constexpr int LDS_BYTES = LDS_RT + 4096;

constexpr size_t WS_WG   = 0;
constexpr size_t WS_WGO  = WS_WG   + 83886080;
constexpr size_t WS_WSI  = WS_WGO  + 33554432;
constexpr size_t WS_WGLU = WS_WSI  + 67108864;
constexpr size_t WS_WSO  = WS_WGLU + 67108864;
constexpr size_t WS_MG   = WS_WSO  + 33554432;
constexpr size_t WS_WE   = WS_MG   + 50331648;
constexpr size_t WS_LAMT = WS_WE   + 16777216;
constexpr size_t WS_WGT  = WS_LAMT + 131072;
constexpr size_t WS_MODP = WS_WGT  + 262144;
constexpr size_t WS_MOD  = WS_MODP + 6291456;
constexpr size_t WS_X    = WS_MOD  + 98304;
constexpr size_t WS_U    = WS_X    + 67108864;
constexpr size_t WS_ACT  = WS_U    + 33554432;
constexpr size_t ACT_UCAT = 0;
constexpr size_t ACT_QS   = 0;
constexpr size_t ACT_KT   = 16777216;
constexpr size_t ACT_GLR  = 33554432;
constexpr size_t ACT_ETOT = 34078720;
constexpr size_t ACT_SSQ  = 34603008;
constexpr size_t ACT_DSEG = 42991616;
constexpr size_t ACT_KD   = 50331648;
constexpr size_t ACT_ZS   = 100663296;
constexpr size_t ACT_E    = 167772160;
constexpr size_t ACT_YB   = 234881024;
constexpr size_t ACT_Y2   = 301989888;
constexpr size_t ACT_END  = 369098752;
constexpr size_t WS_BAR   = WS_ACT + ACT_END;
constexpr size_t WS_CNT   = WS_BAR + 16384;
constexpr size_t WS_XBUF  = WS_CNT + 32768;
constexpr size_t WS_END   = WS_XBUF + 524288;

struct Params {
    const float *x, *c, *ln_g, *ln_b, *ada_w, *ada_b, *gla_w_in, *gla_gate_w2, *gla_gate_b, *gla_norm_g, *gla_w_out,
        *s5_w_in, *s5_a_re, *s5_a_im, *s5_log_dt, *s5_b_re, *s5_b_im, *s5_c_re, *s5_c_im, *s5_d, *s5_w_glu, *s5_b_glu, *s5_w_out;
    float* out; unsigned char* ws; int ph_lo, ph_hi, coop, pad;
};

typedef const __attribute__((address_space(4))) Params* KP;
struct Ctx { int tid, bid, G; };

typedef __bf16 bf16v2_t __attribute__((ext_vector_type(2)));
__device__ __forceinline__ unsigned pk2(float lo, float hi) { const f32x2 v = {lo, hi}; return __builtin_bit_cast(unsigned, __builtin_convertvector(v, bf16v2_t)); }
__device__ __forceinline__ float bflo(unsigned u) { return __uint_as_float(u << 16); }
__device__ __forceinline__ float bfhi(unsigned u) { return __uint_as_float(u & 0xffff0000u); }
__device__ __forceinline__ float sigmoidf_(float x) { return __builtin_amdgcn_rcpf(1.0f + __expf(-x)); }
__device__ __forceinline__ float siluf_(float x) { return x * __builtin_amdgcn_rcpf(1.0f + __expf(-x)); }
__device__ __forceinline__ float gelu_tanh(float y) { const float a = 1.5957691216057308f * (y + 0.044715f * y * y * y); return y * __builtin_amdgcn_rcpf(1.0f + __expf(-a)); }
__device__ __forceinline__ float wave_sum(float v) {
    v += __shfl_xor(v, 32); v += __shfl_xor(v, 16); v += __shfl_xor(v, 8); v += __shfl_xor(v, 4); v += __shfl_xor(v, 2); v += __shfl_xor(v, 1); return v;
}

namespace pg8 {
constexpr int BM = 256, BK = 64, HALF = 128, HTB = HALF * BK * 2, STAGE_BYTES = 8 * HTB, NXCD = 8, WGM = 8;
__device__ __forceinline__ int lds_byte(int r, int c) { const int st = (r >> 4) * 2 + (c >> 5), rr = r & 15, cc = c & 31, ob = rr * 64 + cc * 2; return st * 1024 + (ob ^ (((ob >> 9) & 1) << 5)); }
__device__ __forceinline__ void stage_rc(int b, int& R, int& C) { const int st = b / 1024, sb = b % 1024, swz = sb ^ (((sb >> 9) & 1) << 5); R = (st >> 1) * 16 + swz / 64; C = (st & 1) * 32 + (swz % 64) / 2; }
__device__ __forceinline__ int perm32(int rho) { const int n = rho >> 4, i = rho & 15; return 8 * (i >> 2) + 4 * n + (i & 3); }

struct Unit { const char* a; const char* b; int pm, pn, kind, aux; };

__device__ __forceinline__ void tile_map(int wgid, int nM, int nN, int& pm, int& pn) {
    const int nwg = nM * nN;
    { const int q = nwg / NXCD, r = nwg % NXCD, xcd = wgid % NXCD, off = wgid / NXCD; wgid = (xcd < r ? xcd * (q + 1) : r * (q + 1) + (xcd - r) * q) + off; }
    const int nig = WGM * nN, gid = wgid / nig, fm = gid * WGM, gsz = (nM - fm) < WGM ? (nM - fm) : WGM;
    pm = fm + ((wgid % nig) % gsz); pn = (wgid % nig) / gsz;
}

template <class Epi, class Sched, int KREP = 1>
__device__ __forceinline__ void gemm_phase(const Ctx cx, LAS unsigned char* lds, const int K, const int lda, const int ldb, const int hsB, const Sched& S, const Epi& E) {
    const int tid = cx.tid, wid = __builtin_amdgcn_readfirstlane(tid >> 6), lane = tid & 63, wr = wid >> 2, wc = wid & 3, fr = lane & 15, fq = lane >> 4;
    const int nt = K / BK;
    unsigned voffA[2], voffB[2];
#pragma unroll
    for (int i = 0; i < 2; ++i) { int R, C; stage_rc(tid * 16 + i * 8192, R, C); const int Rb = Epi::PERM ? ((R & ~31) + perm32(R & 31)) : R;
        voffA[i] = (unsigned)(R * lda + C) * 2u; voffB[i] = (unsigned)(Rb * ldb + C) * 2u; }
    const size_t kstep = (size_t)(BK * 2);
    const size_t hstepA = (size_t)HALF * lda * 2;
    const size_t hstepB = hsB ? (size_t)HALF * ldb * 2 : 0;
    const unsigned ldsw = (unsigned)wid * 1024u;
    const int aoff = lds_byte(wr * 64 + fr, fq * 8), boff = lds_byte(wc * 32 + fr, fq * 8);
#define PG8_SA(b, h) (((b) * 2 + (h)) * HTB)
#define PG8_SB(b, h) ((4 + (b) * 2 + (h)) * HTB)
#define PG8_STAGE(bufoff, gbase, voff) do { _Pragma("unroll") for (int _i = 0; _i < 2; ++_i) { unsigned _vo = (voff)[_i]; asm volatile("" : "+v"(_vo));     \
        __builtin_amdgcn_global_load_lds((const unsigned*)((const char*)(gbase) + _vo), (LAS unsigned*)(lds + (bufoff) + ldsw + _i * 8192), 16, 0, 0); } } while (0)
#define PG8_LDA(dst, b, h) do { _Pragma("unroll") for (int m = 0; m < 4; ++m) _Pragma("unroll") for (int k = 0; k < 2; ++k) dst[m][k] = *(const LAS bf16x8*)(lds + PG8_SA(b, h) + aoff + m * 2048 + k * 1024); } while (0)
#define PG8_LDB(dst, b, h) do { _Pragma("unroll") for (int n = 0; n < 2; ++n) _Pragma("unroll") for (int k = 0; k < 2; ++k) dst[n][k] = *(const LAS bf16x8*)(lds + PG8_SB(b, h) + boff + n * 2048 + k * 1024); } while (0)
#define PG8_MMA(ai, bj, At, Bt) do { __builtin_amdgcn_s_setprio(1); _Pragma("unroll") for (int m = 0; m < 4; ++m) _Pragma("unroll") for (int n = 0; n < 2; ++n) _Pragma("unroll") for (int k = 0; k < 2; ++k) \
        acc[ai][bj][m][n] = __builtin_amdgcn_mfma_f32_16x16x32_bf16(Bt[n][k], At[m][k], acc[ai][bj][m][n], 0, 0, 0); __builtin_amdgcn_s_setprio(0); } while (0)
#define PG8_WAIT_V(n) asm volatile("s_waitcnt vmcnt(" #n ")" ::: "memory")
#define PG8_WAIT_L(n) asm volatile("s_waitcnt lgkmcnt(" #n ")" ::: "memory")
#define PG8_BAR __builtin_amdgcn_s_barrier()
#define PG8_SCHED __builtin_amdgcn_sched_barrier(0)
    Unit cur, nxt; int ui = 0;
    if (!S.next(0, cur)) return;
    if constexpr (Epi::KSCALE) E.prologue(cur, lds, tid);
    f32x4 acc[2][2][4][2];
#pragma unroll
    for (int a = 0; a < 2; ++a)
#pragma unroll
        for (int b = 0; b < 2; ++b)
#pragma unroll
            for (int m = 0; m < 4; ++m)
#pragma unroll
                for (int n = 0; n < 2; ++n) acc[a][b][m][n] = (f32x4){0.f, 0.f, 0.f, 0.f};
    bf16x8 At[4][2], B0[2][2], B1[2][2];
    const char* cA = cur.a; const char* cB = cur.b;
    PG8_STAGE(PG8_SB(0, 0), cB, voffB); PG8_STAGE(PG8_SA(0, 0), cA, voffA); PG8_STAGE(PG8_SB(0, 1), cB + hstepB, voffB); PG8_STAGE(PG8_SA(0, 1), cA + hstepA, voffA);
    if (wr == 1) PG8_BAR;
    PG8_WAIT_V(4); PG8_BAR;
    PG8_STAGE(PG8_SB(1, 0), cB + kstep, voffB); PG8_STAGE(PG8_SA(1, 0), cA + kstep, voffA); PG8_STAGE(PG8_SB(1, 1), cB + hstepB + kstep, voffB);
    PG8_WAIT_V(6); PG8_BAR;
    for (;;) {
        const bool has_next = S.next(ui + 1, nxt);
        const char* nA = has_next ? nxt.a : cA; const char* nB = has_next ? nxt.b : cB;
        for (int krep = 0; krep < KREP; ++krep) {
        const char* nAr = (krep == KREP - 1) ? nA : cA; const char* nBr = (krep == KREP - 1) ? nB : cB;
#pragma nounroll
        for (int t = 0; t < nt; t += 2) {
            const bool last = (t == nt - 2);
            const bool fin = last && !has_next && (krep == KREP - 1);
            const char* a1 = cA + (size_t)(t + 1) * kstep;
            const char* a2 = last ? nAr : cA + (size_t)(t + 2) * kstep; const char* b2 = last ? nBr : cB + (size_t)(t + 2) * kstep;
            const char* a3 = a2 + kstep; const char* b3 = b2 + kstep;
            if constexpr (Epi::KSCALE) { if (t != 0 && (t & 15) == 0) E.kscale(acc, (t >> 4) - 1, lds, wr, fr); }
            PG8_LDB(B0, 0, 0); PG8_SCHED; PG8_LDA(At, 0, 0); PG8_STAGE(PG8_SA(1, 1), a1 + hstepA, voffA);
            PG8_WAIT_L(8); PG8_BAR; PG8_WAIT_L(0); PG8_MMA(0, 0, At, B0); PG8_BAR; PG8_SCHED;
            PG8_LDB(B1, 0, 1); if (!fin) PG8_STAGE(PG8_SB(0, 0), b2, voffB);
            PG8_BAR; PG8_WAIT_L(0); if (hsB) PG8_MMA(0, 1, At, B1); PG8_BAR;
            PG8_LDA(At, 0, 1); if (!fin) PG8_STAGE(PG8_SA(0, 0), a2, voffA);
            PG8_BAR; PG8_WAIT_L(0); PG8_MMA(1, 0, At, B0); PG8_BAR; PG8_SCHED;
            if (!fin) PG8_STAGE(PG8_SB(0, 1), b2 + hstepB, voffB);
            if (fin) PG8_WAIT_V(0); else PG8_WAIT_V(6);
            PG8_BAR; if (hsB) PG8_MMA(1, 1, At, B1); PG8_BAR;
            PG8_LDB(B0, 1, 0); PG8_SCHED; PG8_LDA(At, 1, 0); if (!fin) PG8_STAGE(PG8_SA(0, 1), a2 + hstepA, voffA);
            PG8_WAIT_L(8); PG8_BAR; PG8_WAIT_L(0); PG8_MMA(0, 0, At, B0); PG8_BAR; PG8_SCHED;
            PG8_LDB(B1, 1, 1); if (!fin) PG8_STAGE(PG8_SB(1, 0), b3, voffB);
            PG8_BAR; PG8_WAIT_L(0); if (hsB) PG8_MMA(0, 1, At, B1); PG8_BAR;
            PG8_LDA(At, 1, 1); if (!fin) PG8_STAGE(PG8_SA(1, 0), a3, voffA);
            PG8_BAR; PG8_WAIT_L(0); PG8_MMA(1, 0, At, B0); PG8_BAR; PG8_SCHED;
            if (!fin) PG8_STAGE(PG8_SB(1, 1), b3 + hstepB, voffB);
            if (!fin) PG8_WAIT_V(6);
            PG8_BAR; if (hsB) PG8_MMA(1, 1, At, B1); PG8_BAR;
        }
        }
        if constexpr (KREP > 1) {
#pragma unroll
            for (int a = 0; a < 2; ++a)
#pragma unroll
                for (int b = 0; b < 2; ++b)
#pragma unroll
                    for (int m = 0; m < 4; ++m)
#pragma unroll
                        for (int n = 0; n < 2; ++n) acc[a][b][m][n] *= (1.0f / KREP); }
        if constexpr (!Epi::AFTER_DRAIN) E(acc, cur, wr, wc, fr, fq);
        if (!has_next) break;
#pragma unroll
        for (int a = 0; a < 2; ++a)
#pragma unroll
            for (int b = 0; b < 2; ++b)
#pragma unroll
                for (int m = 0; m < 4; ++m)
#pragma unroll
                    for (int n = 0; n < 2; ++n) acc[a][b][m][n] = (f32x4){0.f, 0.f, 0.f, 0.f};
        cur = nxt; cA = nA; cB = nB; ++ui;
    }
    PG8_WAIT_V(0);
    if (wr == 0) PG8_BAR;
    PG8_BAR;
    if constexpr (Epi::AFTER_DRAIN) E.fused(acc, cur, wr, wc, fr, fq, lds, wid, lane);
#undef PG8_SA
#undef PG8_SB
#undef PG8_STAGE
#undef PG8_LDA
#undef PG8_LDB
#undef PG8_MMA
#undef PG8_WAIT_V
#undef PG8_WAIT_L
#undef PG8_BAR
#undef PG8_SCHED
}
}
using pg8::Unit;
typedef f32x4 Acc[2][2][4][2];

struct SchedPlain {
    const char* A; const char* B; int nM, nN, G, c; size_t ta, tb; int mix;
    __device__ __forceinline__ bool next(int i, Unit& u) const {
        const int L = i * G + c; if (L >= nM * nN) return false;
        int pm, pn; pg8::tile_map(L, nM, nN, pm, pn);
        if (mix) pn = (pn & 1) ? (nN >> 1) + (pn >> 1) : (pn >> 1);
        u.pm = pm; u.pn = pn; u.kind = 0; u.aux = 0; u.a = A + (size_t)pm * ta; u.b = B + (size_t)pn * tb; return true;
    }
};
struct SchedGlaIn {
    const char* U; const char* W; int G, c;
    __device__ __forceinline__ bool next(int i, Unit& u) const {
        int L = i * G + c; if (L >= 1280) return false;
        const size_t tstep = (size_t)256 * DM * 2;
        int pm, pn;
        if (L < 640) { pg8::tile_map(L, 32, 20, pm, pn); u.kind = 0; u.a = U + (size_t)pm * tstep; u.b = W + (size_t)pn * tstep; }
        else { pg8::tile_map(L - 640, 20, 32, pm, pn); u.kind = 1; u.a = W + (size_t)(20 + pm) * tstep; u.b = U + (size_t)pn * tstep; }
        u.pm = pm; u.pn = pn; u.aux = 0; return true;
    }
};
struct SchedGroup {
    const char* A; const char* B; size_t ga, gb, ta; int G, c;
    __device__ __forceinline__ bool next(int i, Unit& u) const {
        const int L = i * G + c; if (L >= 512) return false;
        const int g = L >> 1, pm = L & 1;
        u.pm = pm; u.pn = 0; u.kind = 0; u.aux = g; u.a = A + (size_t)g * ga + (size_t)pm * ta; u.b = B + (size_t)g * gb; return true;
    }
};

struct SchedGroupLocal {
    const char* A; const char* B; size_t ga, gb, ta; int g;
    __device__ __forceinline__ bool next(int i, Unit& u) const {
        if (i >= 2) return false;
        u.pm = i; u.pn = 0; u.kind = 0; u.aux = g; u.a = A + (size_t)g * ga + (size_t)i * ta; u.b = B + (size_t)g * gb; return true;
    }
};

struct EpiGlaIn {
    static constexpr bool PERM = true, AFTER_DRAIN = false, KSCALE = false;
    bf16_t *QS, *ZS, *KT, *VT;
    __device__ __forceinline__ void operator()(const Acc& acc, const Unit& u, int wr, int wc, int fr, int fq) const {
        const int row0 = u.pm * 256 + wr * 64 + fr, col0 = u.pn * 256 + wc * 32 + 8 * fq;
        bf16_t* base; int ld, rofs = 0, cofs = 0, mode;
        if (u.kind == 0) { if (u.pn < 4) { base = QS; ld = NQK; mode = 1; } else { base = ZS; ld = DI; cofs = -NQK; mode = 2; } }
        else { mode = 0; ld = SEQ; if (u.pm < 4) { base = KT; } else { base = VT; rofs = -NQK; } }
#pragma unroll
        for (int ai = 0; ai < 2; ++ai)
#pragma unroll
            for (int m = 0; m < 4; ++m) {
                bf16_t* rowp = base + (size_t)(row0 + rofs + ai * 128 + m * 16) * ld + col0 + cofs;
#pragma unroll
                for (int bj = 0; bj < 2; ++bj) {
                    f32x4 v0 = acc[ai][bj][m][0], v1 = acc[ai][bj][m][1];
                    if (mode == 1) { v0 *= 0.0625f; v1 *= 0.0625f; }
                    if (mode == 2) {
#pragma unroll
                        for (int j = 0; j < 4; ++j) { v0[j] = siluf_(v0[j]); v1[j] = siluf_(v1[j]); } }
                    u32x4 w; w.x = pk2(v0[0], v0[1]); w.y = pk2(v0[2], v0[3]); w.z = pk2(v1[0], v1[1]); w.w = pk2(v1[2], v1[3]);
                    if (mode == 1) {
                        const int m0 = 2 * fq; bf16_t* gp = rowp + bj * 128 - 8 * fq;
                        u32x2 lo; lo.x = w.x; lo.y = w.y; u32x2 hi; hi.x = w.z; hi.y = w.w;
                        *(u32x2*)(gp + (m0 & 3) * 8 + (m0 >> 2) * 4) = lo; *(u32x2*)(gp + ((m0 + 1) & 3) * 8 + ((m0 + 1) >> 2) * 4) = hi;
                    } else *(u32x4*)(rowp + bj * 128) = w; } }
    }
};
struct EpiS5In {
    static constexpr bool PERM = true, AFTER_DRAIN = false, KSCALE = false;
    bf16_t *UC, *ZS;
    __device__ __forceinline__ void operator()(const Acc& acc, const Unit& u, int wr, int wc, int fr, int fq) const {
        const int row0 = u.pm * 256 + wr * 64 + fr, col0 = u.pn * 256 + wc * 32 + 8 * fq;
        const bool isz = u.pn >= 16;
#pragma unroll
        for (int ai = 0; ai < 2; ++ai)
#pragma unroll
            for (int m = 0; m < 4; ++m) {
                const int t = row0 + ai * 128 + m * 16;
#pragma unroll
                for (int bj = 0; bj < 2; ++bj) {
                    f32x4 v0 = acc[ai][bj][m][0], v1 = acc[ai][bj][m][1];
                    const int c = col0 + bj * 128;
                    bf16_t* dst;
                    if (isz) {
#pragma unroll
                        for (int j = 0; j < 4; ++j) { v0[j] = siluf_(v0[j]); v1[j] = siluf_(v1[j]); }
                        dst = ZS + (size_t)t * DI + (c - DI);
                    } else { const int g = c >> 4, i0 = c & 15; dst = UC + ((size_t)g * 512 + (t >> 4)) * 384 + (t & 15) * 16 + i0; }
                    u32x4 w; w.x = pk2(v0[0], v0[1]); w.y = pk2(v0[2], v0[3]); w.z = pk2(v1[0], v1[1]); w.w = pk2(v1[2], v1[3]);
                    *(u32x4*)dst = w; } }
    }
};
struct EpiS5E {
    static constexpr bool PERM = false, AFTER_DRAIN = false, KSCALE = false;
    float* E;
    __device__ __forceinline__ void operator()(const Acc& acc, const Unit& u, int wr, int wc, int fr, int fq) const {
        const int row0 = u.pm * 256 + wr * 64 + fr, col0 = wc * 32 + 4 * fq;
#pragma unroll
        for (int ai = 0; ai < 2; ++ai)
#pragma unroll
            for (int m = 0; m < 4; ++m) {
                float* rowp = E + ((size_t)u.aux * 512 + row0 + ai * 128 + m * 16) * 128 + col0;
#pragma unroll
                for (int n = 0; n < 2; ++n) *(f32x4*)(rowp + n * 16) = acc[ai][0][m][n]; }
    }
};
struct EpiS5Y {
    static constexpr bool PERM = true, AFTER_DRAIN = false, KSCALE = false;
    const bf16_t* UC; bf16_t* YB; const float* dsk;
    __device__ __forceinline__ void operator()(const Acc& acc, const Unit& u, int wr, int wc, int fr, int fq) const {
        const int g = u.aux; const int row0 = u.pm * 256 + wr * 64 + fr, col0 = wc * 32 + 8 * fq;
#pragma unroll
        for (int bj = 0; bj < 2; ++bj) {
            const int n = col0 + bj * 128; const int tt = n >> 4, o0 = n & 15; const int ch = g * 16 + o0;
            const f32x4 d0 = *(const f32x4*)(dsk + ch), d1 = *(const f32x4*)(dsk + ch + 4);
#pragma unroll
            for (int ai = 0; ai < 2; ++ai) {
                u32x4 uq[4];
#pragma unroll
                for (int m = 0; m < 4; ++m) uq[m] = *(const u32x4*)(UC + ((size_t)g * 512 + row0 + ai * 128 + m * 16) * 384 + n);
                __builtin_amdgcn_sched_barrier(0);
#pragma unroll
                for (int m = 0; m < 4; ++m) {
                    const int c = row0 + ai * 128 + m * 16; const u32x4 uu = uq[m];
                    f32x4 v0 = acc[ai][bj][m][0], v1 = acc[ai][bj][m][1];
                    v0[0] += d0[0] * bflo(uu.x); v0[1] += d0[1] * bfhi(uu.x); v0[2] += d0[2] * bflo(uu.y); v0[3] += d0[3] * bfhi(uu.y);
                    v1[0] += d1[0] * bflo(uu.z); v1[1] += d1[1] * bfhi(uu.z); v1[2] += d1[2] * bflo(uu.w); v1[3] += d1[3] * bfhi(uu.w);
#pragma unroll
                    for (int j = 0; j < 4; ++j) { v0[j] = gelu_tanh(v0[j]); v1[j] = gelu_tanh(v1[j]); }
                    u32x4 w; w.x = pk2(v0[0], v0[1]); w.y = pk2(v0[2], v0[3]); w.z = pk2(v1[0], v1[1]); w.w = pk2(v1[2], v1[3]);
                    *(u32x4*)(YB + (size_t)(c * 16 + tt) * DI + ch) = w; }
                __builtin_amdgcn_sched_barrier(0);
            } }
    }
};
struct EpiGlu {
    static constexpr bool PERM = true, AFTER_DRAIN = false, KSCALE = false;
    const bf16_t *YB, *ZS; bf16_t* Y2; const float* bg;
    __device__ __forceinline__ void operator()(const Acc& acc, const Unit& u, int wr, int wc, int fr, int fq) const {
        const int row0 = u.pm * 256 + wr * 64 + fr, col0 = u.pn * 256 + wc * 32 + 8 * fq;
#pragma unroll
        for (int bj = 0; bj < 2; ++bj) {
            const int c = col0 + bj * 128;
            const f32x4 b0 = *(const f32x4*)(bg + c), b1 = *(const f32x4*)(bg + c + 4);
#pragma unroll
            for (int ai = 0; ai < 2; ++ai) {
                u32x4 yy[4], zz[4];
#pragma unroll
                for (int m = 0; m < 4; ++m) { const size_t off = (size_t)(row0 + ai * 128 + m * 16) * DI + c; yy[m] = *(const u32x4*)(YB + off); zz[m] = *(const u32x4*)(ZS + off); }
                __builtin_amdgcn_sched_barrier(0);
#pragma unroll
                for (int m = 0; m < 4; ++m) {
                    const size_t off = (size_t)(row0 + ai * 128 + m * 16) * DI + c;
                    f32x4 v0 = acc[ai][bj][m][0] + b0, v1 = acc[ai][bj][m][1] + b1;
                    v0[0] = bflo(yy[m].x) * bflo(zz[m].x) * sigmoidf_(v0[0]); v0[1] = bfhi(yy[m].x) * bfhi(zz[m].x) * sigmoidf_(v0[1]);
                    v0[2] = bflo(yy[m].y) * bflo(zz[m].y) * sigmoidf_(v0[2]); v0[3] = bfhi(yy[m].y) * bfhi(zz[m].y) * sigmoidf_(v0[3]);
                    v1[0] = bflo(yy[m].z) * bflo(zz[m].z) * sigmoidf_(v1[0]); v1[1] = bfhi(yy[m].z) * bfhi(zz[m].z) * sigmoidf_(v1[1]);
                    v1[2] = bflo(yy[m].w) * bflo(zz[m].w) * sigmoidf_(v1[2]); v1[3] = bfhi(yy[m].w) * bfhi(zz[m].w) * sigmoidf_(v1[3]);
                    u32x4 w; w.x = pk2(v0[0], v0[1]); w.y = pk2(v0[2], v0[3]); w.z = pk2(v1[0], v1[1]); w.w = pk2(v1[2], v1[3]);
                    *(u32x4*)(Y2 + off) = w; }
                __builtin_amdgcn_sched_barrier(0);
            } }
    }
};
struct EpiOut {
    static constexpr bool PERM = false, AFTER_DRAIN = false, KSCALE = false;
    const float* X; float* R; const float* gate;
    __device__ __forceinline__ void operator()(const Acc& acc, const Unit& u, int wr, int wc, int fr, int fq) const {
        const int row0 = u.pm * 256 + wr * 64 + fr, col0 = u.pn * 256 + wc * 32 + 4 * fq;
        f32x4 gv[2][2];
#pragma unroll
        for (int bj = 0; bj < 2; ++bj)
#pragma unroll
            for (int n = 0; n < 2; ++n) gv[bj][n] = *(const f32x4*)(gate + col0 + bj * 128 + n * 16) + 1.0f;
#pragma unroll
        for (int ai = 0; ai < 2; ++ai)
#pragma unroll
            for (int m = 0; m < 4; ++m) {
                const size_t off = (size_t)(row0 + ai * 128 + m * 16) * DM + col0;
#pragma unroll
                for (int bj = 0; bj < 2; ++bj)
#pragma unroll
                    for (int n = 0; n < 2; ++n) {
                        const f32x4 xv = *(const f32x4*)(X + off + bj * 128 + n * 16);
                        *(f32x4*)(R + off + bj * 128 + n * 16) = xv * DN_ALPHA + gv[bj][n] * acc[ai][bj][m][n]; } }
    }
};

template <bool RS> struct EpiOutLn {
    static constexpr bool PERM = false, AFTER_DRAIN = true, KSCALE = RS;
    const float* part;
    __device__ __forceinline__ void prologue(const Unit& u, LAS unsigned char* lds, int tid) const {
        LAS float* RT = (LAS float*)(lds + LDS_RT);
        if (tid < 256) {
            const int t = u.pm * 256 + tid, c = t >> 6, tl = t & 63; float r[4];
#pragma unroll
            for (int h = 0; h < 4; ++h) { const float* pp = part + (((size_t)c * 4 + h) * 8) * 64 + tl; float sm = 0.f;
#pragma unroll
                for (int q = 0; q < 8; ++q) sm += pp[q * 64];
                r[h] = rsqrtf(sm * (1.0f / 1024.0f) + 1e-6f); }
            RT[tid] = r[0] / r[1]; RT[256 + tid] = r[1] / r[2]; RT[512 + tid] = r[2] / r[3]; RT[768 + tid] = r[3];
        }
        asm volatile("s_waitcnt vmcnt(0) lgkmcnt(0)" ::: "memory"); __syncthreads();
    }
    __device__ __forceinline__ void kscale(Acc& acc, int hb, LAS unsigned char* lds, int wr, int fr) const {
        const LAS float* RT = (const LAS float*)(lds + LDS_RT) + hb * 256 + wr * 64 + fr;
#pragma unroll
        for (int ai = 0; ai < 2; ++ai)
#pragma unroll
            for (int m = 0; m < 4; ++m) { const float f = RT[ai * 128 + m * 16];
#pragma unroll
                for (int bj = 0; bj < 2; ++bj)
#pragma unroll
                    for (int n = 0; n < 2; ++n) acc[ai][bj][m][n] *= f; }
    }
    const float* X; float* Xo; bf16_t* U; const float* gate; const float* lng; const float* lnb; const float* modn;
    unsigned long long* xbuf; unsigned* cnt;
    __device__ __forceinline__ void operator()(const Acc&, const Unit&, int, int, int, int) const {}
    __device__ __forceinline__ void fused(Acc& acc, const Unit& u, int wr, int wc, int fr, int fq, LAS unsigned char* lds, int wid, int lane) const {
        LAS f32x2* P = (LAS f32x2*)lds;
        LAS f32x2* S = (LAS f32x2*)(lds + 8192);
        const int row0 = u.pm * 256 + wr * 64 + fr, col0 = u.pn * 256 + wc * 32 + 4 * fq;
        if constexpr (RS) kscale(acc, 3, lds, wr, fr);
        {
            f32x4 gv[2][2];
#pragma unroll
            for (int bj = 0; bj < 2; ++bj)
#pragma unroll
                for (int n = 0; n < 2; ++n) gv[bj][n] = *(const f32x4*)(gate + col0 + bj * 128 + n * 16) + 1.0f;
#pragma unroll
            for (int ai = 0; ai < 2; ++ai)
#pragma unroll
                for (int m = 0; m < 4; ++m) {
                    const size_t off = (size_t)(row0 + ai * 128 + m * 16) * DM + col0;
#pragma unroll
                    for (int bj = 0; bj < 2; ++bj)
#pragma unroll
                        for (int n = 0; n < 2; ++n) { const f32x4 xv = *(const f32x4*)(X + off + bj * 128 + n * 16); acc[ai][bj][m][n] = xv * DN_ALPHA + gv[bj][n] * acc[ai][bj][m][n]; }
                    asm volatile("" : "+v"(acc[ai][0][m][0]), "+v"(acc[ai][0][m][1]), "+v"(acc[ai][1][m][0]), "+v"(acc[ai][1][m][1]));
                    if (m & 1) asm volatile("" ::: "memory"); }
        }
#pragma unroll
        for (int ai = 0; ai < 2; ++ai)
#pragma unroll
            for (int m = 0; m < 4; ++m) {
                float sm = 0.f;
#pragma unroll
                for (int bj = 0; bj < 2; ++bj)
#pragma unroll
                    for (int n = 0; n < 2; ++n) { const f32x4 x = acc[ai][bj][m][n]; sm += (x[0] + x[1]) + (x[2] + x[3]); }
                sm += __shfl_xor(sm, 16); sm += __shfl_xor(sm, 32);
                const float mw = sm * (1.0f / 64.0f); float q = 0.f;
#pragma unroll
                for (int bj = 0; bj < 2; ++bj)
#pragma unroll
                    for (int n = 0; n < 2; ++n) { const f32x4 d = acc[ai][bj][m][n] - mw; q += (d[0] * d[0] + d[1] * d[1]) + (d[2] * d[2] + d[3] * d[3]); }
                q += __shfl_xor(q, 16); q += __shfl_xor(q, 32);
                if (fq == 0) P[(ai * 128 + wr * 64 + m * 16 + fr) * 4 + wc] = (f32x2){mw, q};
            }
        asm volatile("s_waitcnt lgkmcnt(0)" ::: "memory"); __builtin_amdgcn_s_barrier(); asm volatile("" ::: "memory");
        const int row = wid * 32 + (lane & 31);
        if (lane < 32) {
            const f32x2 a = P[row * 4 + 0], b = P[row * 4 + 1], c = P[row * 4 + 2], d = P[row * 4 + 3];
            const float mt = (a.x + b.x + c.x + d.x) * 0.25f;
            const float da = a.x - mt, db = b.x - mt, dc = c.x - mt, dd = d.x - mt;
            const float m2 = (a.y + b.y) + (c.y + d.y) + 64.0f * ((da * da + db * db) + (dc * dc + dd * dd));
            unsigned long long* slot = xbuf + ((size_t)(u.pm * 256 + row) * 8 + u.pn);
            __hip_atomic_store(slot, ((unsigned long long)__float_as_uint(m2) << 32) | __float_as_uint(mt), __ATOMIC_RELAXED, __HIP_MEMORY_SCOPE_AGENT);
        }
        asm volatile("s_waitcnt vmcnt(0)" ::: "memory");
        if (lane == 0) __hip_atomic_fetch_add(cnt + 64 * u.pm, 1u, __ATOMIC_RELAXED, __HIP_MEMORY_SCOPE_AGENT);
        if (wid == 0) {
            for (unsigned sp = 0; sp < (1u << 22); ++sp) {
                if ((unsigned)__builtin_amdgcn_readfirstlane(__hip_atomic_load(cnt + 64 * u.pm, __ATOMIC_RELAXED, __HIP_MEMORY_SCOPE_AGENT)) >= 64u) break;
                __builtin_amdgcn_s_sleep(2);
            }
            __builtin_amdgcn_fence(__ATOMIC_ACQUIRE, "agent");
        }
        asm volatile("s_waitcnt vmcnt(0) lgkmcnt(0)" ::: "memory"); __builtin_amdgcn_s_barrier(); asm volatile("" ::: "memory");
        if (lane < 32) {
            const unsigned long long* slot = xbuf + (size_t)(u.pm * 256 + row) * 8; float mt[8], m2[8]; float ms = 0.f;
#pragma unroll
            for (int t = 0; t < 8; ++t) { const unsigned long long wv = __hip_atomic_load(slot + t, __ATOMIC_RELAXED, __HIP_MEMORY_SCOPE_AGENT); mt[t] = __uint_as_float((unsigned)wv); m2[t] = __uint_as_float((unsigned)(wv >> 32)); ms += mt[t]; }
            const float mean = ms * 0.125f; float q = 0.f;
#pragma unroll
            for (int t = 0; t < 8; ++t) { const float dm = mt[t] - mean; q += m2[t] + 256.0f * dm * dm; }
            S[row] = (f32x2){mean, rsqrtf(q * (1.0f / 2048.0f) + 1e-5f)};
        }
        asm volatile("s_waitcnt lgkmcnt(0)" ::: "memory"); __builtin_amdgcn_s_barrier(); asm volatile("" ::: "memory");
#pragma unroll
        for (int bj = 0; bj < 2; ++bj)
#pragma unroll
            for (int n = 0; n < 2; ++n) {
                const int col = col0 + bj * 128 + n * 16;
                const f32x4 g4 = *(const f32x4*)(lng + col), b4 = *(const f32x4*)(lnb + col);
                f32x4 sc4 = {0.f, 0.f, 0.f, 0.f}, sh4 = sc4;
                if (modn) { sh4 = *(const f32x4*)(modn + col); sc4 = *(const f32x4*)(modn + 2048 + col) + 1.0f; }
#pragma unroll
                for (int ai = 0; ai < 2; ++ai)
#pragma unroll
                    for (int m = 0; m < 4; ++m) {
                        const int r = ai * 128 + wr * 64 + m * 16 + fr; const f32x2 sr = S[r];
                        const size_t off = (size_t)(u.pm * 256 + r) * DM + col;
                        const f32x4 y = (acc[ai][bj][m][n] - sr.x) * sr.y * g4 + b4;
                        *(f32x4*)(Xo + off) = y;
                        if (modn) { const f32x4 uv = y * sc4 + sh4; u32x2 wv; wv.x = pk2(uv[0], uv[1]); wv.y = pk2(uv[2], uv[3]); *(u32x2*)(U + off) = wv; }
                        if (m & 1) asm volatile("" ::: "memory");
                    }
                asm volatile("" ::: "memory");
            }
    }
};

__device__ __forceinline__ void conv_job(const Ctx cx, LAS unsigned char* lds, const float* src, const int K, const int sstride, const int col0, const int ncols, bf16_t* dst, const int ldd) {
    const int tid = cx.tid, G = cx.G;
    const int ntn = ncols >> 7, ntiles = ntn * (K >> 6);
    LAS unsigned* T = (LAS unsigned*)lds;
    const int c4 = tid & 31, rp = tid >> 5;
    f32x4 va[4], vb[4];
#define CONV_LOAD(v, tile) do { const int tk_ = (tile) / ntn, tn_ = (tile) % ntn; \
        const float* s_ = src + (size_t)(tk_ * 64 + 2 * rp) * sstride + col0 + tn_ * 128 + 4 * c4; \
        v[0] = __builtin_nontemporal_load((const f32x4*)s_); v[1] = __builtin_nontemporal_load((const f32x4*)(s_ + sstride)); v[2] = __builtin_nontemporal_load((const f32x4*)(s_ + (size_t)32 * sstride)); v[3] = __builtin_nontemporal_load((const f32x4*)(s_ + (size_t)33 * sstride)); } while (0)
#define CONV_OUT(v, tile, nexttile) do { \
        _Pragma("unroll") for (int j = 0; j < 4; ++j) { T[(4 * c4 + j) * 33 + rp] = pk2(v[0][j], v[1][j]); T[(4 * c4 + j) * 33 + rp + 16] = pk2(v[2][j], v[3][j]); } \
        if ((nexttile) < ntiles) CONV_LOAD(v, nexttile); \
        __syncthreads(); \
        { const int tk = (tile) / ntn, tn = (tile) % ntn; const int n = tid >> 2, qq = tid & 3; \
          u32x4 w0, w1; const LAS unsigned* tp = T + n * 33 + 8 * qq; \
          w0.x = tp[0]; w0.y = tp[1]; w0.z = tp[2]; w0.w = tp[3]; w1.x = tp[4]; w1.y = tp[5]; w1.z = tp[6]; w1.w = tp[7]; \
          bf16_t* d = dst + (size_t)(tn * 128 + n) * ldd + tk * 64 + 16 * qq; \
          *(u32x4*)d = w0; *(u32x4*)(d + 8) = w1; } \
        __syncthreads(); } while (0)
    int t = cx.bid;
    if (t < ntiles) CONV_LOAD(va, t);
    if (t + G < ntiles) CONV_LOAD(vb, t + G);
    for (; t < ntiles; t += 2 * G) {
        CONV_OUT(va, t, t + 2 * G);
        if (t + G < ntiles) CONV_OUT(vb, t + G, t + 3 * G);
    }
#undef CONV_LOAD
#undef CONV_OUT
}

__device__ __forceinline__ void s5_tables(const Ctx cx, KP p, LAS unsigned char* lds, const int j) {
    const int tid = cx.tid;
    LAS float* LP = (LAS float*)lds;
    LAS float* BB = LP + 17 * 64 * 2;
    LAS float* CC = BB + 2048;
    LAS float* KT = CC + 2048;
    LAS float* CF = KT + 4096;
    bf16_t* MG = (bf16_t*)(p->ws + WS_MG); bf16_t* WE = (bf16_t*)(p->ws + WS_WE); float* LT = (float*)(p->ws + WS_LAMT);
    for (int g = cx.bid; g < 256; g += cx.G) {
        __syncthreads();
        const int jg = j * 256 + g;
        if (tid < 64) {
            const float are = p->s5_a_re[jg * 64 + tid], aim = p->s5_a_im[jg * 64 + tid], dt = expf(p->s5_log_dt[jg]);
            const float mag = expf(are * dt), ang = aim * dt;
            const float lbr = mag * cosf(ang), lbi = mag * sinf(ang);
            const float nr = lbr - 1.0f, den = are * are + aim * aim;
            CF[2 * tid] = (nr * are + lbi * aim) / den; CF[2 * tid + 1] = (lbi * are - nr * aim) / den;
            for (int n = 0; n <= 16; ++n) { const float mm = expf(are * dt * (float)n), a = ang * (float)n; LP[(n * 64 + tid) * 2] = mm * cosf(a); LP[(n * 64 + tid) * 2 + 1] = mm * sinf(a); }
        }
        __syncthreads();
        for (int idx = tid; idx < 1024; idx += NT) {
            const int pp = idx >> 4;
            const float br = p->s5_b_re[(size_t)jg * 1024 + idx], bi = p->s5_b_im[(size_t)jg * 1024 + idx], cr = CF[2 * pp], ci = CF[2 * pp + 1];
            BB[idx * 2] = cr * br - ci * bi; BB[idx * 2 + 1] = cr * bi + ci * br;
            CC[idx * 2] = p->s5_c_re[(size_t)jg * 1024 + idx]; CC[idx * 2 + 1] = p->s5_c_im[(size_t)jg * 1024 + idx];
        }
        __syncthreads();
        {
            const int tau = tid >> 5, o = (tid >> 1) & 15, i0 = (tid & 1) * 8;
            float acc8[8];
#pragma unroll
            for (int jj = 0; jj < 8; ++jj) acc8[jj] = 0.f;
            for (int pp = 0; pp < 64; ++pp) {
                const float Lr = LP[(tau * 64 + pp) * 2], Li = LP[(tau * 64 + pp) * 2 + 1], Cr = CC[(o * 64 + pp) * 2], Ci = CC[(o * 64 + pp) * 2 + 1];
                const float Gr = Cr * Lr - Ci * Li, Gi = Cr * Li + Ci * Lr;
                const LAS f32x4* bp = (const LAS f32x4*)(BB + (pp * 16 + i0) * 2);
#pragma unroll
                for (int v4 = 0; v4 < 4; ++v4) { const f32x4 bb = bp[v4]; acc8[2 * v4] += Gr * bb[0] - Gi * bb[1]; acc8[2 * v4 + 1] += Gr * bb[2] - Gi * bb[3]; }
            }
#pragma unroll
            for (int jj = 0; jj < 8; ++jj) KT[(tau * 16 + o) * 16 + i0 + jj] = acc8[jj];
        }
        __syncthreads();
        bf16_t* Mg = MG + (size_t)g * 256 * 384;
        for (int it = 0; it < 24; ++it) {
            const int v = tid + NT * it, row = v / 48, kc = (v % 48) * 8, t = row >> 4, o = row & 15;
            float val[8];
            if (kc < 256) { const int s = kc >> 4, i0 = kc & 15;
#pragma unroll
                for (int jj = 0; jj < 8; ++jj) val[jj] = (t >= s) ? KT[((t - s) * 16 + o) * 16 + i0 + jj] : 0.f;
            } else { const int n0 = kc - 256;
#pragma unroll
                for (int jj = 0; jj < 8; ++jj) { const int pp = (n0 + jj) & 63;
                    const float Lr = LP[((t + 1) * 64 + pp) * 2], Li = LP[((t + 1) * 64 + pp) * 2 + 1], Cr = CC[(o * 64 + pp) * 2], Ci = CC[(o * 64 + pp) * 2 + 1];
                    val[jj] = (n0 < 64) ? (Cr * Lr - Ci * Li) : -(Cr * Li + Ci * Lr); } }
            u32x4 w; w.x = pk2(val[0], val[1]); w.y = pk2(val[2], val[3]); w.z = pk2(val[4], val[5]); w.w = pk2(val[6], val[7]);
            *(u32x4*)(Mg + (size_t)row * 384 + kc) = w;
        }
        bf16_t* We = WE + (size_t)g * 128 * 256;
        for (int it = 0; it < 8; ++it) {
            const int v = tid + NT * it, n = v >> 5, kc = (v & 31) * 8, s = kc >> 4, i0 = kc & 15, pp = n & 63;
            const float Lr = LP[((15 - s) * 64 + pp) * 2], Li = LP[((15 - s) * 64 + pp) * 2 + 1];
            float val[8];
#pragma unroll
            for (int jj = 0; jj < 8; ++jj) { const float Br = BB[(pp * 16 + i0 + jj) * 2], Bi = BB[(pp * 16 + i0 + jj) * 2 + 1]; val[jj] = (n < 64) ? (Lr * Br - Li * Bi) : (Lr * Bi + Li * Br); }
            u32x4 w; w.x = pk2(val[0], val[1]); w.y = pk2(val[2], val[3]); w.z = pk2(val[4], val[5]); w.w = pk2(val[6], val[7]);
            *(u32x4*)(We + (size_t)n * 256 + kc) = w;
        }
        if (tid < 128) LT[g * 128 + tid] = LP[(16 * 64 + (tid & 63)) * 2 + (tid >> 6)];
    }
    __syncthreads();
}

__device__ __forceinline__ void phase_prep(const Ctx cx, KP p, LAS unsigned char* lds) {
    const int tid = cx.tid, G = cx.G;
    float* modp = (float*)(p->ws + WS_MODP);
    for (int it = cx.bid; it < 256; it += G) {
        const int l = it >> 6, dc = it & 63;
        f32x4 a0 = {0.f, 0.f, 0.f, 0.f}, a1 = a0, a2 = a0;
        const float* wp = p->ada_w + ((size_t)l * DM + dc * 32) * 6144 + 4 * tid;
#pragma unroll 8
        for (int r = 0; r < 32; ++r) {
            const float s = siluf_(p->c[dc * 32 + r]);
            a0 += s * __builtin_nontemporal_load((const f32x4*)(wp + (size_t)r * 6144)); a1 += s * __builtin_nontemporal_load((const f32x4*)(wp + (size_t)r * 6144 + 2048)); a2 += s * __builtin_nontemporal_load((const f32x4*)(wp + (size_t)r * 6144 + 4096));
        }
        float* o = modp + ((size_t)dc * 4 + l) * 6144 + 4 * tid;
        *(f32x4*)o = a0; *(f32x4*)(o + 2048) = a1; *(f32x4*)(o + 4096) = a2;
    }
    { bf16_t* wgt = (bf16_t*)(p->ws + WS_WGT);
      for (int idx = cx.bid * NT + tid; idx < 65536; idx += G * NT) { const int j = idx >> 15, r = (idx >> 11) & 15, d = idx & 2047; wgt[idx] = (bf16_t)(pk2(p->gla_w_in[((size_t)j * DM + d) * GLA_W + 10240 + r], 0.f) & 0xffffu); } }
    for (int j = 0; j < 2; ++j) {
        bf16_t* wg = (bf16_t*)(p->ws + WS_WG) + (size_t)j * 10240 * DM;
        const float* src = p->gla_w_in + (size_t)j * DM * GLA_W;
        conv_job(cx, lds, src, DM, GLA_W, 0, 1024, wg, DM);
        conv_job(cx, lds, src, DM, GLA_W, 6144, 4096, wg + (size_t)1024 * DM, DM);
        conv_job(cx, lds, src, DM, GLA_W, 1024, 1024, wg + (size_t)5120 * DM, DM);
        conv_job(cx, lds, src, DM, GLA_W, 2048, 4096, wg + (size_t)6144 * DM, DM);
        conv_job(cx, lds, p->gla_w_out + (size_t)j * DI * DM, DI, DM, 0, DM, (bf16_t*)(p->ws + WS_WGO) + (size_t)j * DM * DI, DI);
        conv_job(cx, lds, p->s5_w_in + (size_t)j * DM * 8192, DM, 8192, 0, 8192, (bf16_t*)(p->ws + WS_WSI) + (size_t)j * 8192 * DM, DM);
        conv_job(cx, lds, p->s5_w_glu + (size_t)j * DI * DI, DI, DI, 0, DI, (bf16_t*)(p->ws + WS_WGLU) + (size_t)j * DI * DI, DI);
        conv_job(cx, lds, p->s5_w_out + (size_t)j * DI * DM, DI, DM, 0, DM, (bf16_t*)(p->ws + WS_WSO) + (size_t)j * DM * DI, DI);
    }
    s5_tables(cx, p, lds, 0);
}

__device__ __forceinline__ void phase_mod_u0(const Ctx cx, KP p) {
    const int tid = cx.tid, G = cx.G;
    const float* modp = (const float*)(p->ws + WS_MODP); float* mod = (float*)(p->ws + WS_MOD);
    for (int idx = cx.bid * NT + tid; idx < 24576; idx += G * NT) {
        const int l = idx / 6144, e = idx % 6144; float s = p->ada_b[idx];
        for (int dc = 0; dc < 64; ++dc) s += modp[((size_t)dc * 4 + l) * 6144 + e];
        mod[idx] = s;
    }
    f32x4 sh = *(const f32x4*)(p->ada_b + 4 * tid), sc = *(const f32x4*)(p->ada_b + 2048 + 4 * tid);
    for (int dc = 0; dc < 64; ++dc) { sh += *(const f32x4*)(modp + (size_t)dc * 4 * 6144 + 4 * tid); sc += *(const f32x4*)(modp + (size_t)dc * 4 * 6144 + 2048 + 4 * tid); }
    sc += 1.0f;
    bf16_t* U = (bf16_t*)(p->ws + WS_U);
    for (int row0 = cx.bid; row0 < SEQ; row0 += 8 * G) {
        f32x4 xv[8];
#pragma unroll
        for (int i = 0; i < 8; ++i) { const int row = row0 + i * G; if (row < SEQ) xv[i] = *(const f32x4*)(p->x + (size_t)row * DM + 4 * tid); }
#pragma unroll
        for (int i = 0; i < 8; ++i) { const int row = row0 + i * G; if (row < SEQ) { const f32x4 uv = xv[i] * sc + sh; u32x2 w; w.x = pk2(uv[0], uv[1]); w.y = pk2(uv[2], uv[3]); *(u32x2*)(U + (size_t)row * DM + 4 * tid) = w; } }
    }
}

__device__ __forceinline__ void gla_glr(const Ctx cx, KP p, const int j) {
    const int tid = cx.tid, w = __builtin_amdgcn_readfirstlane(tid >> 6), lane = tid & 63, fr = lane & 15, fq = lane >> 4;
    const bf16_t* U = (const bf16_t*)(p->ws + WS_U); const bf16_t* wgt = (const bf16_t*)(p->ws + WS_WGT) + (size_t)j * 16 * DM;
    float* glr = (float*)(p->ws + WS_ACT + ACT_GLR);
    for (int tile = cx.bid + cx.G * w; tile < 512; tile += cx.G * 8) {
        const bf16_t* up = U + (size_t)(tile * 16 + fr) * DM + 8 * fq; const bf16_t* wp = wgt + (size_t)fr * DM + 8 * fq;
        f32x4 acc = {0.f, 0.f, 0.f, 0.f};
#pragma unroll 16
        for (int sx = 0; sx < 64; ++sx) { const bf16x8 a = *(const bf16x8*)(up + 32 * sx), b = *(const bf16x8*)(wp + 32 * sx); acc = __builtin_amdgcn_mfma_f32_16x16x32_bf16(a, b, acc, 0, 0, 0); }
#pragma unroll
        for (int jj = 0; jj < 4; ++jj) glr[(tile * 16 + 4 * fq + jj) * 16 + fr] = acc[jj];
    }
}

__device__ __forceinline__ void gla_decay(const Ctx cx, KP p, LAS unsigned char* lds, const int j) {
    const int tid = cx.tid, G = cx.G;
    const float* glr = (const float*)(p->ws + WS_ACT + ACT_GLR); float* etot = (float*)(p->ws + WS_ACT + ACT_ETOT);
    const bf16_t* KT = (const bf16_t*)(p->ws + WS_ACT + ACT_KT); bf16_t* KD = (bf16_t*)(p->ws + WS_ACT + ACT_KD);
    LAS float* gl = (LAS float*)lds;
    for (int it = cx.bid; it < 256; it += G) {
        const int c = it >> 1, kk = (it & 1) * 512 + tid;
        __syncthreads();
        gl[tid] = glr[c * 1024 + tid]; gl[tid + 512] = glr[c * 1024 + 512 + tid];
        __syncthreads();
        float w2[16];
#pragma unroll
        for (int r = 0; r < 16; ++r) w2[r] = p->gla_gate_w2[((size_t)j * 16 + r) * NQK + kk];
        const float gb = p->gla_gate_b[j * NQK + kk];
        float cum[64]; float run = 0.f;
#pragma unroll
        for (int t = 0; t < 64; ++t) {
            float xx = gb;
#pragma unroll
            for (int r4 = 0; r4 < 4; ++r4) { const f32x4 gv = *(const LAS f32x4*)(gl + t * 16 + r4 * 4); xx += gv[0] * w2[r4 * 4] + gv[1] * w2[r4 * 4 + 1] + gv[2] * w2[r4 * 4 + 2] + gv[3] * w2[r4 * 4 + 3]; }
            const float la = -(fmaxf(-xx, 0.f) + __logf(1.0f + __expf(-fabsf(xx)))) * 0.0625f;
            run += la; cum[t] = run;
        }
        etot[c * 1024 + kk] = __expf(run);
        const bf16_t* kp = KT + (size_t)kk * SEQ + c * 64; bf16_t* ko = KD + (size_t)kk * SEQ + c * 64;
        u32x4 kin[8];
#pragma unroll
        for (int q = 0; q < 8; ++q) kin[q] = *(const u32x4*)(kp + q * 8);
#pragma unroll
        for (int q = 0; q < 8; ++q) {
            u32x4 kv = kin[q];
            kv.x = pk2(bflo(kv.x) * __expf(run - cum[q * 8 + 0]), bfhi(kv.x) * __expf(run - cum[q * 8 + 1]));
            kv.y = pk2(bflo(kv.y) * __expf(run - cum[q * 8 + 2]), bfhi(kv.y) * __expf(run - cum[q * 8 + 3]));
            kv.z = pk2(bflo(kv.z) * __expf(run - cum[q * 8 + 4]), bfhi(kv.z) * __expf(run - cum[q * 8 + 5]));
            kv.w = pk2(bflo(kv.w) * __expf(run - cum[q * 8 + 6]), bfhi(kv.w) * __expf(run - cum[q * 8 + 7]));
            *(u32x4*)(ko + q * 8) = kv;
        }
    }
}

template <bool P2>
__device__ __forceinline__ void gla_scan2(const Ctx cx, KP p, LAS unsigned char* lds, const int j) {
    const int tid = cx.tid, w = __builtin_amdgcn_readfirstlane(tid >> 6), lane = tid & 63, fr = lane & 15, fq = lane >> 4;
    const bf16_t* QS = (const bf16_t*)(p->ws + WS_ACT + ACT_QS); const bf16_t* KT = (const bf16_t*)(p->ws + WS_ACT + ACT_KD);
    const bf16_t* VT = (const bf16_t*)(p->ws + WS_ACT + ACT_Y2); const bf16_t* ZS = (const bf16_t*)(p->ws + WS_ACT + ACT_ZS);
    bf16_t* Y = (bf16_t*)(p->ws + WS_ACT + ACT_YB); const float* etot = (const float*)(p->ws + WS_ACT + ACT_ETOT); float* part = (float*)(p->ws + WS_ACT + ACT_SSQ);
    float* SEND = (float*)(p->ws + WS_ACT + ACT_E); float* DSEG = (float*)(p->ws + WS_ACT + ACT_DSEG);
    const float* ng = p->gla_norm_g + (size_t)j * DI;
    LAS unsigned char* KD = lds;
    LAS unsigned char* QP = lds + 36864;
    LAS float* ET = (LAS float*)(lds + 36864 + 33792);
    LAS float* SQ = ET + 256;
    LAS unsigned char* ZT = lds + 73728;
    LAS unsigned char* YT = lds + 91136;
    for (int it = cx.bid; it < 256; it += cx.G) {
        const int xcd = it & 7, idx = it >> 3, P = xcd * 4 + (idx >> 3), h = P >> 3, seg = P & 7, slice = idx & 7;
        if (!P2 && seg == 7) continue;
        const int dv0 = h * 1024 + slice * 128 + 16 * w, c0 = seg * 16;
        const unsigned kgo = (unsigned)((h * 256 + (tid >> 3)) * SEQ + (tid & 7) * 8) * 2u;
        const unsigned qgo = (unsigned)((tid >> 5) * NQK + h * 256 + (tid & 31) * 8) * 2u;
        const unsigned ego = (unsigned)(h * 256 + 4 * (tid & 63)) * 4u;
        const unsigned vgo = (unsigned)((dv0 + fr) * SEQ + 8 * fq) * 2u;
        const unsigned zto = (unsigned)((tid >> 4) * DI + h * 1024 + slice * 128) * 2u + (unsigned)(tid & 15) * 16u;
        const unsigned ztl = (unsigned)(tid >> 4) * 272u + (unsigned)(tid & 15) * 16u, zfl = (unsigned)fr * 272u + (unsigned)(16 * w + 4 * fq) * 2u;
        const unsigned kl = (tid >> 3) * 144 + (tid & 7) * 16, ql = (tid >> 5) * 528 + (tid & 31) * 16;
        f32x4 S[16];
#pragma unroll
        for (int kt = 0; kt < 16; ++kt) S[kt] = (f32x4){0.f, 0.f, 0.f, 0.f};
        if (P2) {
            for (int sp = 0; sp < seg; ++sp) {
                const float* dp = DSEG + sp * 1024 + h * 256 + 4 * fq;
                const float* se = SEND + ((size_t)(((h * 8 + slice) * 8 + sp) * 8 + w) * 16) * 256 + lane * 4;
                f32x4 dd[16], ee[16];
#pragma unroll
                for (int kt = 0; kt < 16; ++kt) { dd[kt] = *(const f32x4*)(dp + 16 * kt); ee[kt] = *(const f32x4*)(se + kt * 256); }
#pragma unroll
                for (int kt = 0; kt < 16; ++kt) S[kt] = S[kt] * dd[kt] + ee[kt];
            }
        } else if (slice == 0 && tid < 256) {
            float pr = 1.0f;
            for (int c = 0; c < 16; ++c) pr *= etot[(c0 + c) * 1024 + h * 256 + tid];
            DSEG[seg * 1024 + h * 256 + tid] = pr;
        }
        f32x4 g4 = {0.f, 0.f, 0.f, 0.f};
        if (P2) g4 = *(const f32x4*)(ng + dv0 + 4 * fq);
        u32x4 rk[4], rq[4]; f32x4 re = {0.f, 0.f, 0.f, 0.f}; bf16x8 rv0, rv1; u32x4 rz2[2] = {};
#define SC_LOAD(c) do { const int c_ = (c); \
        _Pragma("unroll") for (int i = 0; i < 4; ++i) rk[i] = *(const u32x4*)((const char*)KT + (kgo + (unsigned)(i * 64 * SEQ + c_ * 64) * 2u)); \
        if (P2) { _Pragma("unroll") for (int i = 0; i < 4; ++i) rq[i] = *(const u32x4*)((const char*)QS + (qgo + (unsigned)((c_ * 64 + 16 * i) * NQK) * 2u)); } \
        if (tid < 64) re = *(const f32x4*)((const char*)etot + (ego + (unsigned)c_ * 4096u)); \
        if (P2) { rz2[0] = *(const u32x4*)((const char*)ZS + (zto + (unsigned)(c_ * 64 * DI) * 2u)); rz2[1] = *(const u32x4*)((const char*)ZS + (zto + (unsigned)((c_ * 64 + 32) * DI) * 2u)); } \
        } while (0)
#define SC_LOADV(c) do { const int cv_ = (c); rv0 = *(const bf16x8*)((const char*)VT + (vgo + (unsigned)cv_ * 128u)); rv1 = *(const bf16x8*)((const char*)VT + (vgo + (unsigned)cv_ * 128u + 64u)); } while (0)
        SC_LOAD(c0); SC_LOADV(c0);
#pragma nounroll
        for (int cc = 0; cc < 16; ++cc) {
            const int c = c0 + cc;
            __syncthreads();
            if (P2 && cc > 0) {
#pragma unroll
                for (int i = 0; i < 2; ++i) { const u32x4 yv4 = *(const LAS u32x4*)(YT + ztl + i * 32 * 272); *(u32x4*)((char*)Y + (zto + (unsigned)(((c - 1) * 64 + 32 * i) * DI) * 2u)) = yv4; } }
            if (P2 && cc > 0 && tid < 64) { float sm = 0.f;
#pragma unroll
                for (int ww = 0; ww < 8; ++ww) sm += SQ[ww * 64 + tid];
                part[(((size_t)(c - 1) * 4 + h) * 8 + slice) * 64 + tid] = sm; }
#pragma unroll
            for (int i = 0; i < 4; ++i) *(LAS u32x4*)(KD + kl + i * 9216) = rk[i];
            if (P2) {
#pragma unroll
                for (int i = 0; i < 4; ++i) *(LAS u32x4*)(QP + ql + i * 8448) = rq[i]; }
            if (tid < 64) *(LAS f32x4*)(ET + 4 * tid) = re;
            if (P2) { *(LAS u32x4*)(ZT + ztl) = rz2[0]; *(LAS u32x4*)(ZT + ztl + 32 * 272) = rz2[1]; }
            __syncthreads();
            if (cc + 1 < 16) SC_LOAD(c + 1);
#pragma unroll
            for (int kb = 0; kb < 4; ++kb) {
                f32x4 e[4]; bf16x8 a0[4], a1[4];
#pragma unroll
                for (int i = 0; i < 4; ++i) { const int kt = 4 * kb + i;
                    e[i] = *(const LAS f32x4*)(ET + 16 * kt + 4 * fq);
                    a0[i] = *(const LAS bf16x8*)(KD + (16 * kt + fr) * 144 + fq * 16); a1[i] = *(const LAS bf16x8*)(KD + (16 * kt + fr) * 144 + 64 + fq * 16); }
                __builtin_amdgcn_sched_barrier(0);
#pragma unroll
                for (int i = 0; i < 4; ++i) { const int kt = 4 * kb + i;
                    S[kt] *= e[i];
                    S[kt] = __builtin_amdgcn_mfma_f32_16x16x32_bf16(a0[i], rv0, S[kt], 0, 0, 0);
                    S[kt] = __builtin_amdgcn_mfma_f32_16x16x32_bf16(a1[i], rv1, S[kt], 0, 0, 0); }
                __builtin_amdgcn_sched_barrier(0);
            }
            if (cc + 1 < 16) SC_LOADV(c + 1);
            if (P2) {
                bf16x8 sb[8];
#pragma unroll
                for (int q = 0; q < 8; ++q) { u32x4 t4; t4.x = pk2(S[2 * q][0], S[2 * q][1]); t4.y = pk2(S[2 * q][2], S[2 * q][3]); t4.z = pk2(S[2 * q + 1][0], S[2 * q + 1][1]); t4.w = pk2(S[2 * q + 1][2], S[2 * q + 1][3]); sb[q] = __builtin_bit_cast(bf16x8, t4); }
#pragma unroll
                for (int tt = 0; tt < 4; ++tt) {
                    f32x4 o = {0.f, 0.f, 0.f, 0.f}, o2 = o;
#pragma unroll
                    for (int qh = 0; qh < 2; ++qh) {
                        bf16x8 qf[4];
#pragma unroll
                        for (int q = 0; q < 4; ++q) qf[q] = *(const LAS bf16x8*)(QP + (16 * tt + fr) * 528 + (4 * qh + q) * 64 + fq * 16);
                        __builtin_amdgcn_sched_barrier(0);
#pragma unroll
                        for (int q = 0; q < 4; q += 2) { o = __builtin_amdgcn_mfma_f32_16x16x32_bf16(sb[4 * qh + q], qf[q], o, 0, 0, 0); o2 = __builtin_amdgcn_mfma_f32_16x16x32_bf16(sb[4 * qh + q + 1], qf[q + 1], o2, 0, 0, 0); }
                        __builtin_amdgcn_sched_barrier(0);
                    }
                    o += o2;
                    float sq = (o[0] * o[0] + o[1] * o[1]) + (o[2] * o[2] + o[3] * o[3]);
                    sq += __shfl_xor(sq, 16); sq += __shfl_xor(sq, 32);
                    if (fq == 0) SQ[w * 64 + 16 * tt + fr] = sq;
                    const u32x2 zt = *(const LAS u32x2*)(ZT + zfl + tt * 16 * 272);
                    u32x2 yv; yv.x = pk2(o[0] * g4[0] * bflo(zt.x), o[1] * g4[1] * bfhi(zt.x)); yv.y = pk2(o[2] * g4[2] * bflo(zt.y), o[3] * g4[3] * bfhi(zt.y));
                    *(LAS u32x2*)(YT + zfl + tt * 16 * 272) = yv;
                }
            }
        }
#undef SC_LOAD
#undef SC_LOADV
        if (P2) { __syncthreads();
#pragma unroll
            for (int i = 0; i < 2; ++i) { const u32x4 yv4 = *(const LAS u32x4*)(YT + ztl + i * 32 * 272); *(u32x4*)((char*)Y + (zto + (unsigned)(((c0 + 15) * 64 + 32 * i) * DI) * 2u)) = yv4; }
            if (tid < 64) { float sm = 0.f;
#pragma unroll
                for (int ww = 0; ww < 8; ++ww) sm += SQ[ww * 64 + tid];
                part[(((size_t)(c0 + 15) * 4 + h) * 8 + slice) * 64 + tid] = sm; } }
        if (!P2) {
            float* se = SEND + ((size_t)(((h * 8 + slice) * 8 + seg) * 8 + w) * 16) * 256 + lane * 4;
#pragma unroll
            for (int kt = 0; kt < 16; ++kt) *(f32x4*)(se + kt * 256) = S[kt];
        }
        __syncthreads();
    }
}

__device__ __forceinline__ void gla_rms(const Ctx cx, KP p, LAS unsigned char* lds) {
    const int tid = cx.tid, G = cx.G;
    bf16_t* Y = (bf16_t*)(p->ws + WS_ACT + ACT_YB); const float* part = (const float*)(p->ws + WS_ACT + ACT_SSQ);
    LAS float* ps = (LAS float*)lds;
    LAS float* rsd = ps + 512;
    for (int it = cx.bid; it < 256; it += G) {
        const int c = it >> 1, half = it & 1;
        { const int h = tid >> 7, sg = (tid >> 5) & 3, tl = tid & 31;
          const float* pp = part + (((size_t)c * 4 + h) * 8 + sg * 2) * 64 + half * 32 + tl;
          float s = pp[0] + pp[64];
          __syncthreads();
          ps[tid] = s;
          __syncthreads();
          if (tid < 128) { const int hh = tid >> 5, t2 = tid & 31; const float tot = ps[hh * 128 + t2] + ps[hh * 128 + 32 + t2] + ps[hh * 128 + 64 + t2] + ps[hh * 128 + 96 + t2];
              rsd[tid] = rsqrtf(tot * (1.0f / 1024.0f) + 1e-6f); }
          __syncthreads(); }
        const int t0 = c * 64 + half * 32;
        for (int b = 0; b < 4; ++b) {
            u32x4 y[8];
#pragma unroll
            for (int i = 0; i < 8; ++i) { const int v = tid + (b * 8 + i) * NT; y[i] = *(const u32x4*)(Y + (size_t)(t0 + (v >> 9)) * DI + (v & 511) * 8); }
#pragma unroll
            for (int i = 0; i < 8; ++i) {
                const int v = tid + (b * 8 + i) * NT, tl = v >> 9, col = (v & 511) * 8; const float rs = rsd[(col >> 10) * 32 + tl];
                u32x4 o; o.x = pk2(bflo(y[i].x) * rs, bfhi(y[i].x) * rs); o.y = pk2(bflo(y[i].y) * rs, bfhi(y[i].y) * rs); o.z = pk2(bflo(y[i].z) * rs, bfhi(y[i].z) * rs); o.w = pk2(bflo(y[i].w) * rs, bfhi(y[i].w) * rs);
                *(u32x4*)(Y + (size_t)(t0 + tl) * DI + col) = o; }
        }
    }
}

__device__ __forceinline__ void ln_phase(const Ctx cx, KP p, const int layer) {
    const int tid = cx.tid, w = tid >> 6, lane = tid & 63;
    const float* R = (const float*)(p->ws + WS_ACT + ACT_E); float* Xo = (layer == 3) ? p->out : (float*)(p->ws + WS_X);
    bf16_t* U = (bf16_t*)(p->ws + WS_U);
    const float* g = p->ln_g + layer * DM; const float* b = p->ln_b + layer * DM;
    const float* mod = (const float*)(p->ws + WS_MOD) + (layer < 3 ? (layer + 1) * 6144 : 0);
    for (int row = cx.bid * 8 + w; row < SEQ; row += cx.G * 8) {
        f32x4 v[8]; float s = 0.f;
#pragma unroll
        for (int i = 0; i < 8; ++i) { v[i] = *(const f32x4*)(R + (size_t)row * DM + 256 * i + 4 * lane); s += (v[i][0] + v[i][1]) + (v[i][2] + v[i][3]); }
        s = wave_sum(s); const float mu = s * (1.0f / 2048.0f);
        float q = 0.f;
#pragma unroll
        for (int i = 0; i < 8; ++i) { const f32x4 d = v[i] - mu; q += (d[0] * d[0] + d[1] * d[1]) + (d[2] * d[2] + d[3] * d[3]); }
        q = wave_sum(q); const float rs = rsqrtf(q * (1.0f / 2048.0f) + 1e-5f);
#pragma unroll
        for (int i = 0; i < 8; ++i) {
            const int col = 256 * i + 4 * lane;
            const f32x4 y = (v[i] - mu) * rs * *(const f32x4*)(g + col) + *(const f32x4*)(b + col);
            *(f32x4*)(Xo + (size_t)row * DM + col) = y;
            if (layer < 3) { const f32x4 uv = y * (*(const f32x4*)(mod + 2048 + col) + 1.0f) + *(const f32x4*)(mod + col);
                u32x2 wv; wv.x = pk2(uv[0], uv[1]); wv.y = pk2(uv[2], uv[3]); *(u32x2*)(U + (size_t)row * DM + col) = wv; }
        }
    }
}

__device__ __forceinline__ void s5_carry(const Ctx cx, KP p, LAS unsigned char* lds) {
    const int tid = cx.tid, w = __builtin_amdgcn_readfirstlane(tid >> 6), lane = tid & 63;
    const float* E = (const float*)(p->ws + WS_ACT + ACT_E); bf16_t* UC = (bf16_t*)(p->ws + WS_ACT + ACT_UCAT); const float* LT = (const float*)(p->ws + WS_LAMT);
    LAS float* endst = (LAS float*)lds;
    for (int g = cx.bid; g < 256; g += cx.G) {
        const float lr = LT[g * 128 + lane], li = LT[g * 128 + 64 + lane];
        const float* Eg = E + ((size_t)g * 512 + 64 * w) * 128 + lane;
        float xr = 0.f, xi = 0.f;
        for (int b = 0; b < 2; ++b) {
            float er[32], ei[32];
#pragma unroll
            for (int s = 0; s < 32; ++s) { er[s] = Eg[(32 * b + s) * 128]; ei[s] = Eg[(32 * b + s) * 128 + 64]; }
#pragma unroll
            for (int s = 0; s < 32; ++s) { const float nr = lr * xr - li * xi + er[s], ni = lr * xi + li * xr + ei[s]; xr = nr; xi = ni; }
        }
        __syncthreads();
        endst[w * 128 + lane] = xr; endst[w * 128 + 64 + lane] = xi;
        float pr = lr, pi = li;
#pragma unroll
        for (int q = 0; q < 6; ++q) { const float nr = pr * pr - pi * pi, ni = 2.0f * pr * pi; pr = nr; pi = ni; }
        __syncthreads();
        float cr = 0.f, ci = 0.f;
        for (int ww = 0; ww < w; ++ww) { const float tr = pr * cr - pi * ci + endst[ww * 128 + lane], ti = pr * ci + pi * cr + endst[ww * 128 + 64 + lane]; cr = tr; ci = ti; }
        xr = cr; xi = ci;
        bf16_t* Ug = UC + ((size_t)g * 512 + 64 * w) * 384 + 256 + lane;
        for (int b = 0; b < 2; ++b) {
            float er[32], ei[32];
#pragma unroll
            for (int s = 0; s < 32; ++s) { er[s] = Eg[(32 * b + s) * 128]; ei[s] = Eg[(32 * b + s) * 128 + 64]; }
#pragma unroll
            for (int s = 0; s < 32; ++s) {
                Ug[(size_t)(32 * b + s) * 384] = (bf16_t)(pk2(xr, 0.f) & 0xffffu); Ug[(size_t)(32 * b + s) * 384 + 64] = (bf16_t)(pk2(xi, 0.f) & 0xffffu);
                const float nr = lr * xr - li * xi + er[s], ni = lr * xi + li * xr + ei[s]; xr = nr; xi = ni; }
        }
    }
}

#define XB_TMO      128
#define XB_XCNT(j)  (256  + 64 * (j))
#define XB_XSUB(j)  (1280 + 64 * (j))
#define XB_XGEN(j)  (2304 + 64 * (j))
#define XB_TOP      3328
#define XB_TOPGEN   3392
#define XCD_BAR_WORDS 3456
#define XB_SPIN_CAP (1u << 18)
__device__ __forceinline__ unsigned xb_ld(unsigned* p)              { return __hip_atomic_load(p, __ATOMIC_RELAXED, __HIP_MEMORY_SCOPE_AGENT); }
__device__ __forceinline__ unsigned xb_add(unsigned* p, unsigned v) { return __hip_atomic_fetch_add(p, v, __ATOMIC_RELAXED, __HIP_MEMORY_SCOPE_AGENT); }
__device__ __forceinline__ unsigned xb_xcc_id() { return (unsigned)__builtin_amdgcn_s_getreg((3 << 11) | 20) & 0xFu; }
#define XB_SPIN(cond, bar) do { unsigned _sp = 0; while (cond) { __builtin_amdgcn_s_sleep(1); \
    if ((++_sp & 255u) == 0u) { if (xb_ld(&(bar)[XB_TMO])) break; if (_sp > XB_SPIN_CAP) { atomicAdd(&(bar)[XB_TMO], 1u); break; } } } } while (0)
struct XcdBarrier { unsigned* bar; unsigned x; volatile LAS unsigned* st; };
__device__ __forceinline__ XcdBarrier xcd_barrier_post(unsigned* bar, volatile LAS unsigned* st) {
    XcdBarrier b; b.bar = bar; b.x = xb_xcc_id(); b.st = st;
    if (threadIdx.x == 0) (void)xb_add(&bar[XB_XCNT(b.x)], 1u);
    return b;
}
__device__ __forceinline__ void xcd_barrier_complete(unsigned* bar, unsigned x, unsigned& nloc, unsigned& nx) {
    const unsigned G = gridDim.x * gridDim.y * gridDim.z;
    unsigned sum, cnt, mine, sp = 0u;
    for (;;) {
        sum = 0u; cnt = 0u; mine = 0u;
#pragma unroll
        for (unsigned j = 0; j < 16; ++j) { const unsigned c = xb_ld(&bar[XB_XCNT(j)]); sum += c; cnt += (c > 0u) ? 1u : 0u; mine = (j == x) ? c : mine; }
        if (sum == G) break;
        __builtin_amdgcn_s_sleep(1);
        if ((++sp & 255u) == 0u) { if (xb_ld(&bar[XB_TMO])) break; if (sp > XB_SPIN_CAP) { atomicAdd(&bar[XB_TMO], 1u); break; } }
    }
    nloc = mine > 0u ? mine : 1u; nx = cnt > 0u ? cnt : 1u;
}
__device__ __forceinline__ void xcd_barrier(const XcdBarrier& b) {
    asm volatile("s_waitcnt vmcnt(0)" ::: "memory");
    __syncthreads();
    if (threadIdx.x == 0) {
        unsigned* bar = b.bar;
        __builtin_amdgcn_s_waitcnt(0);
        unsigned nloc = b.st[0], nx = b.st[1];
        if (nloc == 0u) { xcd_barrier_complete(bar, b.x, nloc, nx); b.st[0] = nloc; b.st[1] = nx; }
        const unsigned old = xb_add(&bar[XB_XSUB(b.x)], 1u);
        const unsigned gen = old / nloc;
        if (old + 1u == (gen + 1u) * nloc) {
            __builtin_amdgcn_fence(__ATOMIC_RELEASE, "agent");
            asm volatile("s_waitcnt vmcnt(0)" ::: "memory");
            const unsigned og = xb_add(&bar[XB_TOP], 1u);
            const unsigned tg = og / nx;
            if (og + 1u == (tg + 1u) * nx) xb_add(&bar[XB_TOPGEN], 1u);
            else XB_SPIN(xb_ld(&bar[XB_TOPGEN]) == tg, bar);
            __builtin_amdgcn_fence(__ATOMIC_ACQUIRE, "agent");
            xb_add(&bar[XB_XGEN(b.x)], 1u);
            asm volatile("s_waitcnt vmcnt(0)" ::: "memory");
        } else {
            XB_SPIN(xb_ld(&bar[XB_XGEN(b.x)]) == gen, bar);
            __builtin_amdgcn_fence(__ATOMIC_ACQUIRE, "agent");
            asm volatile("s_waitcnt vmcnt(0)" ::: "memory");
        }
    }
    __syncthreads();
}

__device__ __forceinline__ void run_phase(const Ctx cx, KP p, LAS unsigned char* lds, const int ph) {
    const int G = cx.G, c = cx.bid;
    if (ph == 0) { phase_prep(cx, p, lds); return; }
    if (ph == 1) { phase_mod_u0(cx, p); return; }
    const int layer = (ph - 2) / 7, q = (ph - 2) % 7;
    const int j = layer >> 1;
    const float* Xcur = (layer == 0) ? p->x : (const float*)(p->ws + WS_X);
    const float* gate = (const float*)(p->ws + WS_MOD) + layer * 6144 + 4096;
    unsigned char* act = p->ws + WS_ACT;
    if ((layer & 1) == 0) {
        if (q == 0) {
            gla_glr(cx, p, j);
            SchedGlaIn S{(const char*)(p->ws + WS_U), (const char*)(p->ws + WS_WG + (size_t)j * 10240 * DM * 2), G, c};
            EpiGlaIn E{(bf16_t*)(act + ACT_QS), (bf16_t*)(act + ACT_ZS), (bf16_t*)(act + ACT_KT), (bf16_t*)(act + ACT_Y2)};
            pg8::gemm_phase(cx, lds, DM, DM, DM, 1, S, E);
        } else if (q == 1) { gla_decay(cx, p, lds, j); if (MK_PROBE_DECAY && layer == 0) { asm volatile("" ::: "memory"); gla_decay(cx, p, lds, j); } if (layer == 2) s5_tables(cx, p, lds, 1); }
        else if (q == 2) gla_scan2<false>(cx, p, lds, j);
        else if (q == 3) gla_scan2<true>(cx, p, lds, j);
        else if (q == 4) { if (cx.G != 256) gla_rms(cx, p, lds); }
        else if (q == 5) {
            SchedPlain S{(const char*)(act + ACT_YB), (const char*)(p->ws + WS_WGO + (size_t)j * DM * DI * 2), 32, 8, G, c, (size_t)256 * DI * 2, (size_t)256 * DI * 2, 0};
            if (cx.G == 256) {
                EpiOutLn<true> E{(const float*)(act + ACT_SSQ), Xcur, (layer == 3) ? p->out : (float*)(p->ws + WS_X), (bf16_t*)(p->ws + WS_U), gate, p->ln_g + layer * DM, p->ln_b + layer * DM,
                           (layer < 3) ? (const float*)(p->ws + WS_MOD) + (layer + 1) * 6144 : (const float*)nullptr, (unsigned long long*)(p->ws + WS_XBUF), (unsigned*)(p->ws + WS_CNT) + layer * 2048};
                pg8::gemm_phase(cx, lds, DI, DI, DI, 1, S, E);
            } else { EpiOut E{Xcur, (float*)(act + ACT_E), gate}; pg8::gemm_phase(cx, lds, DI, DI, DI, 1, S, E); }
        } else if (cx.G != 256) ln_phase(cx, p, layer);
    } else {
        if (q == 0) {
            SchedPlain S{(const char*)(p->ws + WS_U), (const char*)(p->ws + WS_WSI + (size_t)j * 8192 * DM * 2), 32, 32, G, c, (size_t)256 * DM * 2, (size_t)256 * DM * 2, 1};
            EpiS5In E{(bf16_t*)(act + ACT_UCAT), (bf16_t*)(act + ACT_ZS)};
            pg8::gemm_phase(cx, lds, DM, DM, DM, 1, S, E);
        } else if (q == 1) {
            if (cx.G == 256) {
                { SchedGroupLocal S{(const char*)(act + ACT_UCAT), (const char*)(p->ws + WS_WE), (size_t)512 * 384 * 2, (size_t)128 * 256 * 2, (size_t)256 * 384 * 2, cx.bid};
                  EpiS5E E{(float*)(act + ACT_E)};
                  pg8::gemm_phase(cx, lds, 256, 384, 256, 0, S, E); }
                asm volatile("s_waitcnt vmcnt(0)" ::: "memory"); __syncthreads();
                s5_carry(cx, p, lds);
                asm volatile("s_waitcnt vmcnt(0)" ::: "memory"); __syncthreads();
                { SchedGroupLocal S{(const char*)(act + ACT_UCAT), (const char*)(p->ws + WS_MG), (size_t)512 * 384 * 2, (size_t)256 * 384 * 2, (size_t)256 * 384 * 2, cx.bid};
                  EpiS5Y E{(const bf16_t*)(act + ACT_UCAT), (bf16_t*)(act + ACT_YB), p->s5_d + (size_t)j * DI};
                  pg8::gemm_phase(cx, lds, 384, 384, 384, 1, S, E); }
            } else {
                SchedGroup S{(const char*)(act + ACT_UCAT), (const char*)(p->ws + WS_WE), (size_t)512 * 384 * 2, (size_t)128 * 256 * 2, (size_t)256 * 384 * 2, G, c};
                EpiS5E E{(float*)(act + ACT_E)};
                pg8::gemm_phase(cx, lds, 256, 384, 256, 0, S, E);
            }
        } else if (q == 2) { if (cx.G != 256) s5_carry(cx, p, lds); }
        else if (q == 3) {
            if (cx.G != 256) {
                SchedGroup S{(const char*)(act + ACT_UCAT), (const char*)(p->ws + WS_MG), (size_t)512 * 384 * 2, (size_t)256 * 384 * 2, (size_t)256 * 384 * 2, G, c};
                EpiS5Y E{(const bf16_t*)(act + ACT_UCAT), (bf16_t*)(act + ACT_YB), p->s5_d + (size_t)j * DI};
                pg8::gemm_phase(cx, lds, 384, 384, 384, 1, S, E);
            }
        } else if (q == 4) {
            SchedPlain S{(const char*)(act + ACT_YB), (const char*)(p->ws + WS_WGLU + (size_t)j * DI * DI * 2), 32, 16, G, c, (size_t)256 * DI * 2, (size_t)256 * DI * 2, 0};
            EpiGlu E{(const bf16_t*)(act + ACT_YB), (const bf16_t*)(act + ACT_ZS), (bf16_t*)(act + ACT_Y2), p->s5_b_glu + (size_t)j * DI};
            pg8::gemm_phase<EpiGlu, SchedPlain, MK_KREP_GLU>(cx, lds, DI, DI, DI, 1, S, E);
        } else if (q == 5) {
            SchedPlain S{(const char*)(act + ACT_Y2), (const char*)(p->ws + WS_WSO + (size_t)j * DM * DI * 2), 32, 8, G, c, (size_t)256 * DI * 2, (size_t)256 * DI * 2, 0};
            if (cx.G == 256) {
                EpiOutLn<false> E{(const float*)nullptr, Xcur, (layer == 3) ? p->out : (float*)(p->ws + WS_X), (bf16_t*)(p->ws + WS_U), gate, p->ln_g + layer * DM, p->ln_b + layer * DM,
                           (layer < 3) ? (const float*)(p->ws + WS_MOD) + (layer + 1) * 6144 : (const float*)nullptr, (unsigned long long*)(p->ws + WS_XBUF), (unsigned*)(p->ws + WS_CNT) + layer * 2048};
                pg8::gemm_phase(cx, lds, DI, DI, DI, 1, S, E);
            } else { EpiOut E{Xcur, (float*)(act + ACT_E), gate}; pg8::gemm_phase(cx, lds, DI, DI, DI, 1, S, E); }
        } else if (cx.G != 256) ln_phase(cx, p, layer);
    }
}

__global__ void __launch_bounds__(NT, 2) fwd_megakernel(Params p_unused) {
    extern __shared__ __attribute__((aligned(16))) unsigned char lds_raw[];
    LAS unsigned char* lds = (LAS unsigned char*)lds_raw;
    KP kp0 = (KP)__builtin_amdgcn_kernarg_segment_ptr();
    const int ph_lo = kp0->ph_lo, ph_hi = kp0->ph_hi, coop = kp0->coop;
    XcdBarrier bar; bar.bar = (unsigned*)(kp0->ws + WS_BAR); bar.x = 0; bar.st = (volatile LAS unsigned*)(lds + LDS_STAGE);
    if (coop) { if (threadIdx.x < 4) ((LAS unsigned*)(lds + LDS_STAGE))[threadIdx.x] = 0u; __syncthreads(); bar = xcd_barrier_post((unsigned*)(kp0->ws + WS_BAR), (volatile LAS unsigned*)(lds + LDS_STAGE)); }
    for (int ph = ph_lo; ph < ph_hi; ++ph) {
        if (gridDim.x == 256 && ph >= 2 && ((ph - 2) % 7 == 6 || ((ph - 2) % 7 == 4 && (((ph - 2) / 7) & 1) == 0) || (((ph - 2) % 7 == 2 || (ph - 2) % 7 == 3) && (((ph - 2) / 7) & 1) == 1))) continue;
#if MK_REPEAT_MASK
        for (int rep = 0; rep < ((MK_REPEAT_MASK >> ph) & 1) + 1; ++rep)
#endif
        {
            KP kp = kp0; asm volatile("" : "+s"(kp));
            Ctx cx; cx.tid = threadIdx.x; cx.bid = blockIdx.x; cx.G = gridDim.x;
            asm volatile("" : "+v"(cx.tid)); asm volatile("" : "+s"(cx.bid)); asm volatile("" : "+s"(cx.G));
            run_phase(cx, kp, lds, ph);
        }
        if (coop && ph + 1 < ph_hi) { if (coop == 2) cg::this_grid().sync(); else xcd_barrier(bar); }
    }
}

#ifndef MK_ONE_LAUNCH
#define MK_ONE_LAUNCH 1
#endif

extern "C" void kernel_launch(void* const* d_in, const int* in_sizes, int n_in, void* d_out, int out_size, void* d_ws, size_t ws_size, hipStream_t stream) {
    static int grid = 0;
    if (grid == 0) {
        if (n_in != 23 || ws_size < WS_END) { fprintf(stderr, "kernel_launch: need 23 inputs and %zu bytes of workspace, got %d / %zu\n", (size_t)WS_END, n_in, ws_size); grid = -1; return; }
        int dev = 0, cus = 0, per_cu = 0;
        hipGetDevice(&dev); hipDeviceGetAttribute(&cus, hipDeviceAttributeMultiprocessorCount, dev);
        if (hipFuncSetAttribute((const void*)fwd_megakernel, hipFuncAttributeMaxDynamicSharedMemorySize, LDS_BYTES) != hipSuccess) { fprintf(stderr, "kernel_launch: hipFuncSetAttribute failed\n"); grid = -1; return; }
        if (hipOccupancyMaxActiveBlocksPerMultiprocessor(&per_cu, (const void*)fwd_megakernel, NT, LDS_BYTES) != hipSuccess || per_cu < 1) { fprintf(stderr, "kernel_launch: occupancy query gave %d\n", per_cu); per_cu = 1; }
        (void)hipGetLastError();
        grid = cus;
    }
    if (grid < 0) return;
    Params hp{};
    const float** pp = (const float**)&hp;
    for (int i = 0; i < 23; ++i) pp[i] = (const float*)d_in[i];
    hp.out = (float*)d_out; hp.ws = (unsigned char*)d_ws; hp.pad = 0;
#if MK_ONE_LAUNCH
    if (hipMemsetAsync((char*)d_ws + WS_BAR, 0, 16384 + 32768, stream) != hipSuccess) { fprintf(stderr, "kernel_launch: memset of the barrier words failed\n"); return; }
    hp.ph_lo = 0; hp.ph_hi = NPH; hp.coop = 1;
    void* args[] = {&hp};
    hipError_t e = hipLaunchCooperativeKernel((const void*)fwd_megakernel, dim3(grid), dim3(NT), args, LDS_BYTES, stream);
    if (e != hipSuccess) fprintf(stderr, "cooperative launch failed: %s (grid %d)\n", hipGetErrorString(e), grid);
#else
    hp.coop = 0;
    for (int ph = 0; ph < NPH; ++ph) { hp.ph_lo = ph; hp.ph_hi = ph + 1; hipLaunchKernelGGL(fwd_megakernel, dim3(grid), dim3(NT), LDS_BYTES, stream, hp); }
#endif
}
```

```cpp
#include <hip/hip_runtime.h>
#include <hip/hip_cooperative_groups.h>
#include <cstdio>
namespace cg = cooperative_groups;

#define LAS __attribute__((address_space(3)))
typedef unsigned short bf16_t;
typedef short bf16x8 __attribute__((ext_vector_type(8)));
typedef short s16x4 __attribute__((ext_vector_type(4)));
typedef float f32x4 __attribute__((ext_vector_type(4)));
typedef float f32x2 __attribute__((ext_vector_type(2)));
typedef unsigned u32x4 __attribute__((ext_vector_type(4)));
typedef unsigned u32x2 __attribute__((ext_vector_type(2)));
typedef _Float16 f16x4 __attribute__((ext_vector_type(4)));

constexpr int SEQ = 8192, DM = 2048, DI = 4096, NQK = 1024;
constexpr int GLA_W = 10256;
constexpr float DN_ALPHA = 1.6817928305074290f;
#ifndef MK_REPEAT_MASK
#define MK_REPEAT_MASK 0
#endif
#ifndef MK_KREP_GLU
#define MK_KREP_GLU 1
#endif
#ifndef MK_PROBE_DECAY
#define MK_PROBE_DECAY 0
#endif
constexpr int NPH = 30;
constexpr int NT = 512;
constexpr int LDS_STAGE = 131072;
constexpr int LDS_RT = LDS_STAGE + 16;
constexpr int LDS_BYTES = LDS_RT + 4096;

constexpr size_t WS_WG   = 0;
constexpr size_t WS_WGO  = WS_WG   + 83886080;
constexpr size_t WS_WSI  = WS_WGO  + 33554432;
constexpr size_t WS_WGLU = WS_WSI  + 67108864;
constexpr size_t WS_WSO  = WS_WGLU + 67108864;
constexpr size_t WS_MG   = WS_WSO  + 33554432;
constexpr size_t WS_WE   = WS_MG   + 50331648;
constexpr size_t WS_LAMT = WS_WE   + 16777216;
constexpr size_t WS_WGT  = WS_LAMT + 131072;
constexpr size_t WS_MODP = WS_WGT  + 262144;
constexpr size_t WS_MOD  = WS_MODP + 6291456;
constexpr size_t WS_X    = WS_MOD  + 98304;
constexpr size_t WS_U    = WS_X    + 67108864;
constexpr size_t WS_ACT  = WS_U    + 33554432;
constexpr size_t ACT_UCAT = 0;
constexpr size_t ACT_QS   = 0;
constexpr size_t ACT_KT   = 16777216;
constexpr size_t ACT_GLR  = 33554432;
constexpr size_t ACT_ETOT = 34078720;
constexpr size_t ACT_SSQ  = 34603008;
constexpr size_t ACT_DSEG = 42991616;
constexpr size_t ACT_KD   = 50331648;
constexpr size_t ACT_ZS   = 100663296;
constexpr size_t ACT_E    = 167772160;
constexpr size_t ACT_YB   = 234881024;
constexpr size_t ACT_Y2   = 301989888;
constexpr size_t ACT_END  = 369098752;
constexpr size_t WS_BAR   = WS_ACT + ACT_END;
constexpr size_t WS_CNT   = WS_BAR + 16384;
constexpr size_t WS_XBUF  = WS_CNT + 32768;
constexpr size_t WS_END   = WS_XBUF + 524288;

struct Params {
    const float *x, *c, *ln_g, *ln_b, *ada_w, *ada_b, *gla_w_in, *gla_gate_w2, *gla_gate_b, *gla_norm_g, *gla_w_out,
        *s5_w_in, *s5_a_re, *s5_a_im, *s5_log_dt, *s5_b_re, *s5_b_im, *s5_c_re, *s5_c_im, *s5_d, *s5_w_glu, *s5_b_glu, *s5_w_out;
    float* out; unsigned char* ws; int ph_lo, ph_hi, coop, pad;
};

typedef const __attribute__((address_space(4))) Params* KP;
struct Ctx { int tid, bid, G; };

typedef __bf16 bf16v2_t __attribute__((ext_vector_type(2)));
__device__ __forceinline__ unsigned pk2(float lo, float hi) { const f32x2 v = {lo, hi}; return __builtin_bit_cast(unsigned, __builtin_convertvector(v, bf16v2_t)); }
__device__ __forceinline__ float bflo(unsigned u) { return __uint_as_float(u << 16); }
__device__ __forceinline__ float bfhi(unsigned u) { return __uint_as_float(u & 0xffff0000u); }
__device__ __forceinline__ float sigmoidf_(float x) { return __builtin_amdgcn_rcpf(1.0f + __expf(-x)); }
__device__ __forceinline__ float siluf_(float x) { return x * __builtin_amdgcn_rcpf(1.0f + __expf(-x)); }
__device__ __forceinline__ float gelu_tanh(float y) { const float a = 1.5957691216057308f * (y + 0.044715f * y * y * y); return y * __builtin_amdgcn_rcpf(1.0f + __expf(-a)); }
__device__ __forceinline__ float wave_sum(float v) {
    v += __shfl_xor(v, 32); v += __shfl_xor(v, 16); v += __shfl_xor(v, 8); v += __shfl_xor(v, 4); v += __shfl_xor(v, 2); v += __shfl_xor(v, 1); return v;
}

namespace pg8 {
constexpr int BM = 256, BK = 64, HALF = 128, HTB = HALF * BK * 2, STAGE_BYTES = 8 * HTB, NXCD = 8, WGM = 8;
__device__ __forceinline__ int lds_byte(int r, int c) { const int st = (r >> 4) * 2 + (c >> 5), rr = r & 15, cc = c & 31, ob = rr * 64 + cc * 2; return st * 1024 + (ob ^ (((ob >> 9) & 1) << 5)); }
__device__ __forceinline__ void stage_rc(int b, int& R, int& C) { const int st = b / 1024, sb = b % 1024, swz = sb ^ (((sb >> 9) & 1) << 5); R = (st >> 1) * 16 + swz / 64; C = (st & 1) * 32 + (swz % 64) / 2; }
__device__ __forceinline__ int perm32(int rho) { const int n = rho >> 4, i = rho & 15; return 8 * (i >> 2) + 4 * n + (i & 3); }

struct Unit { const char* a; const char* b; int pm, pn, kind, aux; };

__device__ __forceinline__ void tile_map(int wgid, int nM, int nN, int& pm, int& pn) {
    const int nwg = nM * nN;
    { const int q = nwg / NXCD, r = nwg % NXCD, xcd = wgid % NXCD, off = wgid / NXCD; wgid = (xcd < r ? xcd * (q + 1) : r * (q + 1) + (xcd - r) * q) + off; }
    const int nig = WGM * nN, gid = wgid / nig, fm = gid * WGM, gsz = (nM - fm) < WGM ? (nM - fm) : WGM;
    pm = fm + ((wgid % nig) % gsz); pn = (wgid % nig) / gsz;
}

template <class Epi, class Sched, int KREP = 1>
__device__ __forceinline__ void gemm_phase(const Ctx cx, LAS unsigned char* lds, const int K, const int lda, const int ldb, const int hsB, const Sched& S, const Epi& E) {
    const int tid = cx.tid, wid = __builtin_amdgcn_readfirstlane(tid >> 6), lane = tid & 63, wr = wid >> 2, wc = wid & 3, fr = lane & 15, fq = lane >> 4;
    const int nt = K / BK;
    unsigned voffA[2], voffB[2];
#pragma unroll
    for (int i = 0; i < 2; ++i) { int R, C; stage_rc(tid * 16 + i * 8192, R, C); const int Rb = Epi::PERM ? ((R & ~31) + perm32(R & 31)) : R;
        voffA[i] = (unsigned)(R * lda + C) * 2u; voffB[i] = (unsigned)(Rb * ldb + C) * 2u; }
    const size_t kstep = (size_t)(BK * 2);
    const size_t hstepA = (size_t)HALF * lda * 2;
    const size_t hstepB = hsB ? (size_t)HALF * ldb * 2 : 0;
    const unsigned ldsw = (unsigned)wid * 1024u;
    const int aoff = lds_byte(wr * 64 + fr, fq * 8), boff = lds_byte(wc * 32 + fr, fq * 8);
#define PG8_SA(b, h) (((b) * 2 + (h)) * HTB)
#define PG8_SB(b, h) ((4 + (b) * 2 + (h)) * HTB)
#define PG8_STAGE(bufoff, gbase, voff) do { _Pragma("unroll") for (int _i = 0; _i < 2; ++_i) \
        __builtin_amdgcn_global_load_lds((const unsigned*)((const char*)(gbase) + (voff)[_i]), (LAS unsigned*)(lds + (bufoff) + ldsw + _i * 8192), 16, 0, 0); } while (0)
#define PG8_LDA(dst, b, h) do { _Pragma("unroll") for (int m = 0; m < 4; ++m) _Pragma("unroll") for (int k = 0; k < 2; ++k) dst[m][k] = *(const LAS bf16x8*)(lds + PG8_SA(b, h) + aoff + m * 2048 + k * 1024); } while (0)
#define PG8_LDB(dst, b, h) do { _Pragma("unroll") for (int n = 0; n < 2; ++n) _Pragma("unroll") for (int k = 0; k < 2; ++k) dst[n][k] = *(const LAS bf16x8*)(lds + PG8_SB(b, h) + boff + n * 2048 + k * 1024); } while (0)
#define PG8_MMA(ai, bj, At, Bt) do { __builtin_amdgcn_s_setprio(1); _Pragma("unroll") for (int m = 0; m < 4; ++m) _Pragma("unroll") for (int n = 0; n < 2; ++n) _Pragma("unroll") for (int k = 0; k < 2; ++k) \
        acc[ai][bj][m][n] = __builtin_amdgcn_mfma_f32_16x16x32_bf16(Bt[n][k], At[m][k], acc[ai][bj][m][n], 0, 0, 0); __builtin_amdgcn_s_setprio(0); } while (0)
#define PG8_WAIT_V(n) asm volatile("s_waitcnt vmcnt(" #n ")" ::: "memory")
#define PG8_WAIT_L(n) asm volatile("s_waitcnt lgkmcnt(" #n ")" ::: "memory")
#define PG8_BAR __builtin_amdgcn_s_barrier()
#define PG8_SCHED __builtin_amdgcn_sched_barrier(0)
    Unit cur, nxt; int ui = 0;
    if (!S.next(0, cur)) return;
    if constexpr (Epi::KSCALE) E.prologue(cur, lds, tid);
    f32x4 acc[2][2][4][2];
#pragma unroll
    for (int a = 0; a < 2; ++a)
#pragma unroll
        for (int b = 0; b < 2; ++b)
#pragma unroll
            for (int m = 0; m < 4; ++m)
#pragma unroll
                for (int n = 0; n < 2; ++n) acc[a][b][m][n] = (f32x4){0.f, 0.f, 0.f, 0.f};
    bf16x8 At[4][2], B0[2][2], B1[2][2];
    const char* cA = cur.a; const char* cB = cur.b;
    PG8_STAGE(PG8_SB(0, 0), cB, voffB); PG8_STAGE(PG8_SA(0, 0), cA, voffA); PG8_STAGE(PG8_SB(0, 1), cB + hstepB, voffB); PG8_STAGE(PG8_SA(0, 1), cA + hstepA, voffA);
    if (wr == 1) PG8_BAR;
    PG8_WAIT_V(4); PG8_BAR;
    PG8_STAGE(PG8_SB(1, 0), cB + kstep, voffB); PG8_STAGE(PG8_SA(1, 0), cA + kstep, voffA); PG8_STAGE(PG8_SB(1, 1), cB + hstepB + kstep, voffB);
    PG8_WAIT_V(6); PG8_BAR;
    for (;;) {
        const bool has_next = S.next(ui + 1, nxt);
        const char* nA = has_next ? nxt.a : cA; const char* nB = has_next ? nxt.b : cB;
        for (int krep = 0; krep < KREP; ++krep) {
        const char* nAr = (krep == KREP - 1) ? nA : cA; const char* nBr = (krep == KREP - 1) ? nB : cB;
#pragma nounroll
        for (int t = 0; t < nt; t += 2) {
            const bool last = (t == nt - 2);
            const char* a1 = cA + (size_t)(t + 1) * kstep;
            const char* a2 = last ? nAr : cA + (size_t)(t + 2) * kstep; const char* b2 = last ? nBr : cB + (size_t)(t + 2) * kstep;
            const char* a3 = a2 + kstep; const char* b3 = b2 + kstep;
            if constexpr (Epi::KSCALE) { if (t != 0 && (t & 15) == 0) E.kscale(acc, (t >> 4) - 1, lds, wr, fr); }
            PG8_LDB(B0, 0, 0); PG8_SCHED; PG8_LDA(At, 0, 0); PG8_STAGE(PG8_SA(1, 1), a1 + hstepA, voffA);
            PG8_WAIT_L(8); PG8_BAR; PG8_WAIT_L(0); PG8_MMA(0, 0, At, B0); PG8_BAR; PG8_SCHED;
            PG8_LDB(B1, 0, 1); PG8_STAGE(PG8_SB(0, 0), b2, voffB);
            PG8_BAR; PG8_WAIT_L(0); PG8_MMA(0, 1, At, B1); PG8_BAR;
            PG8_LDA(At, 0, 1); PG8_STAGE(PG8_SA(0, 0), a2, voffA);
            PG8_BAR; PG8_WAIT_L(0); PG8_MMA(1, 0, At, B0); PG8_BAR; PG8_SCHED;
            PG8_STAGE(PG8_SB(0, 1), b2 + hstepB, voffB);
            PG8_WAIT_V(6); PG8_BAR; PG8_MMA(1, 1, At, B1); PG8_BAR;
            PG8_LDB(B0, 1, 0); PG8_SCHED; PG8_LDA(At, 1, 0); PG8_STAGE(PG8_SA(0, 1), a2 + hstepA, voffA);
            PG8_WAIT_L(8); PG8_BAR; PG8_WAIT_L(0); PG8_MMA(0, 0, At, B0); PG8_BAR; PG8_SCHED;
            PG8_LDB(B1, 1, 1); PG8_STAGE(PG8_SB(1, 0), b3, voffB);
            PG8_BAR; PG8_WAIT_L(0); PG8_MMA(0, 1, At, B1); PG8_BAR;
            PG8_LDA(At, 1, 1); PG8_STAGE(PG8_SA(1, 0), a3, voffA);
            PG8_BAR; PG8_WAIT_L(0); PG8_MMA(1, 0, At, B0); PG8_BAR; PG8_SCHED;
            PG8_STAGE(PG8_SB(1, 1), b3 + hstepB, voffB);
            PG8_WAIT_V(6); PG8_BAR; PG8_MMA(1, 1, At, B1); PG8_BAR;
        }
        }
        if constexpr (KREP > 1) {
#pragma unroll
            for (int a = 0; a < 2; ++a)
#pragma unroll
                for (int b = 0; b < 2; ++b)
#pragma unroll
                    for (int m = 0; m < 4; ++m)
#pragma unroll
                        for (int n = 0; n < 2; ++n) acc[a][b][m][n] *= (1.0f / KREP); }
        if constexpr (!Epi::AFTER_DRAIN) E(acc, cur, wr, wc, fr, fq);
        if (!has_next) break;
#pragma unroll
        for (int a = 0; a < 2; ++a)
#pragma unroll
            for (int b = 0; b < 2; ++b)
#pragma unroll
                for (int m = 0; m < 4; ++m)
#pragma unroll
                    for (int n = 0; n < 2; ++n) acc[a][b][m][n] = (f32x4){0.f, 0.f, 0.f, 0.f};
        cur = nxt; cA = nA; cB = nB; ++ui;
    }
    PG8_WAIT_V(0);
    if (wr == 0) PG8_BAR;
    PG8_BAR;
    if constexpr (Epi::AFTER_DRAIN) E.fused(acc, cur, wr, wc, fr, fq, lds, wid, lane);
#undef PG8_SA
#undef PG8_SB
#undef PG8_STAGE
#undef PG8_LDA
#undef PG8_LDB
#undef PG8_MMA
#undef PG8_WAIT_V
#undef PG8_WAIT_L
#undef PG8_BAR
#undef PG8_SCHED
}
}
using pg8::Unit;
typedef f32x4 Acc[2][2][4][2];

struct SchedPlain {
    const char* A; const char* B; int nM, nN, G, c; size_t ta, tb; int mix;
    __device__ __forceinline__ bool next(int i, Unit& u) const {
        const int L = i * G + c; if (L >= nM * nN) return false;
        int pm, pn; pg8::tile_map(L, nM, nN, pm, pn);
        if (mix) pn = (pn & 1) ? (nN >> 1) + (pn >> 1) : (pn >> 1);
        u.pm = pm; u.pn = pn; u.kind = 0; u.aux = 0; u.a = A + (size_t)pm * ta; u.b = B + (size_t)pn * tb; return true;
    }
};
struct SchedGlaIn {
    const char* U; const char* W; int G, c;
    __device__ __forceinline__ bool next(int i, Unit& u) const {
        int L = i * G + c; if (L >= 1280) return false;
        const size_t tstep = (size_t)256 * DM * 2;
        int pm, pn;
        if (L < 640) { pg8::tile_map(L, 32, 20, pm, pn); u.kind = 0; u.a = U + (size_t)pm * tstep; u.b = W + (size_t)pn * tstep; }
        else { pg8::tile_map(L - 640, 20, 32, pm, pn); u.kind = 1; u.a = W + (size_t)(20 + pm) * tstep; u.b = U + (size_t)pn * tstep; }
        u.pm = pm; u.pn = pn; u.aux = 0; return true;
    }
};
struct SchedGroup {
    const char* A; const char* B; size_t ga, gb, ta; int G, c;
    __device__ __forceinline__ bool next(int i, Unit& u) const {
        const int L = i * G + c; if (L >= 512) return false;
        const int g = L >> 1, pm = L & 1;
        u.pm = pm; u.pn = 0; u.kind = 0; u.aux = g; u.a = A + (size_t)g * ga + (size_t)pm * ta; u.b = B + (size_t)g * gb; return true;
    }
};

struct SchedGroupLocal {
    const char* A; const char* B; size_t ga, gb, ta; int g;
    __device__ __forceinline__ bool next(int i, Unit& u) const {
        if (i >= 2) return false;
        u.pm = i; u.pn = 0; u.kind = 0; u.aux = g; u.a = A + (size_t)g * ga + (size_t)i * ta; u.b = B + (size_t)g * gb; return true;
    }
};

struct EpiGlaIn {
    static constexpr bool PERM = true, AFTER_DRAIN = false, KSCALE = false;
    bf16_t *QS, *ZS, *KT, *VT;
    __device__ __forceinline__ void operator()(const Acc& acc, const Unit& u, int wr, int wc, int fr, int fq) const {
        const int row0 = u.pm * 256 + wr * 64 + fr, col0 = u.pn * 256 + wc * 32 + 8 * fq;
        bf16_t* base; int ld, rofs = 0, cofs = 0, mode;
        if (u.kind == 0) { if (u.pn < 4) { base = QS; ld = NQK; mode = 1; } else { base = ZS; ld = DI; cofs = -NQK; mode = 2; } }
        else { mode = 0; ld = SEQ; if (u.pm < 4) { base = KT; } else { base = VT; rofs = -NQK; } }
#pragma unroll
        for (int ai = 0; ai < 2; ++ai)
#pragma unroll
            for (int m = 0; m < 4; ++m) {
                bf16_t* rowp = base + (size_t)(row0 + rofs + ai * 128 + m * 16) * ld + col0 + cofs;
#pragma unroll
                for (int bj = 0; bj < 2; ++bj) {
                    f32x4 v0 = acc[ai][bj][m][0], v1 = acc[ai][bj][m][1];
                    if (mode == 1) { v0 *= 0.0625f; v1 *= 0.0625f; }
                    if (mode == 2) {
#pragma unroll
                        for (int j = 0; j < 4; ++j) { v0[j] = siluf_(v0[j]); v1[j] = siluf_(v1[j]); } }
                    u32x4 w; w.x = pk2(v0[0], v0[1]); w.y = pk2(v0[2], v0[3]); w.z = pk2(v1[0], v1[1]); w.w = pk2(v1[2], v1[3]);
                    if (mode == 1) {
                        const int m0 = 2 * fq; bf16_t* gp = rowp + bj * 128 - 8 * fq;
                        u32x2 lo; lo.x = w.x; lo.y = w.y; u32x2 hi; hi.x = w.z; hi.y = w.w;
                        *(u32x2*)(gp + (m0 & 3) * 8 + (m0 >> 2) * 4) = lo; *(u32x2*)(gp + ((m0 + 1) & 3) * 8 + ((m0 + 1) >> 2) * 4) = hi;
                    } else *(u32x4*)(rowp + bj * 128) = w; } }
    }
};
struct EpiS5In {
    static constexpr bool PERM = true, AFTER_DRAIN = false, KSCALE = false;
    bf16_t *UC, *ZS;
    __device__ __forceinline__ void operator()(const Acc& acc, const Unit& u, int wr, int wc, int fr, int fq) const {
        const int row0 = u.pm * 256 + wr * 64 + fr, col0 = u.pn * 256 + wc * 32 + 8 * fq;
        const bool isz = u.pn >= 16;
#pragma unroll
        for (int ai = 0; ai < 2; ++ai)
#pragma unroll
            for (int m = 0; m < 4; ++m) {
                const int t = row0 + ai * 128 + m * 16;
#pragma unroll
                for (int bj = 0; bj < 2; ++bj) {
                    f32x4 v0 = acc[ai][bj][m][0], v1 = acc[ai][bj][m][1];
                    const int c = col0 + bj * 128;
                    bf16_t* dst;
                    if (isz) {
#pragma unroll
                        for (int j = 0; j < 4; ++j) { v0[j] = siluf_(v0[j]); v1[j] = siluf_(v1[j]); }
                        dst = ZS + (size_t)t * DI + (c - DI);
                    } else { const int g = c >> 4, i0 = c & 15; dst = UC + ((size_t)g * 512 + (t >> 4)) * 384 + (t & 15) * 16 + i0; }
                    u32x4 w; w.x = pk2(v0[0], v0[1]); w.y = pk2(v0[2], v0[3]); w.z = pk2(v1[0], v1[1]); w.w = pk2(v1[2], v1[3]);
                    *(u32x4*)dst = w; } }
    }
};
struct EpiS5E {
    static constexpr bool PERM = false, AFTER_DRAIN = false, KSCALE = false;
    float* E;
    __device__ __forceinline__ void operator()(const Acc& acc, const Unit& u, int wr, int wc, int fr, int fq) const {
        const int row0 = u.pm * 256 + wr * 64 + fr, col0 = wc * 32 + 4 * fq;
#pragma unroll
        for (int ai = 0; ai < 2; ++ai)
#pragma unroll
            for (int m = 0; m < 4; ++m) {
                float* rowp = E + ((size_t)u.aux * 512 + row0 + ai * 128 + m * 16) * 128 + col0;
#pragma unroll
                for (int n = 0; n < 2; ++n) *(f32x4*)(rowp + n * 16) = acc[ai][0][m][n]; }
    }
};
struct EpiS5Y {
    static constexpr bool PERM = true, AFTER_DRAIN = false, KSCALE = false;
    const bf16_t* UC; bf16_t* YB; const float* dsk;
    __device__ __forceinline__ void operator()(const Acc& acc, const Unit& u, int wr, int wc, int fr, int fq) const {
        const int g = u.aux; const int row0 = u.pm * 256 + wr * 64 + fr, col0 = wc * 32 + 8 * fq;
#pragma unroll
        for (int bj = 0; bj < 2; ++bj) {
            const int n = col0 + bj * 128; const int tt = n >> 4, o0 = n & 15; const int ch = g * 16 + o0;
            const f32x4 d0 = *(const f32x4*)(dsk + ch), d1 = *(const f32x4*)(dsk + ch + 4);
#pragma unroll
            for (int ai = 0; ai < 2; ++ai) {
                u32x4 uq[4];
#pragma unroll
                for (int m = 0; m < 4; ++m) uq[m] = *(const u32x4*)(UC + ((size_t)g * 512 + row0 + ai * 128 + m * 16) * 384 + n);
                __builtin_amdgcn_sched_barrier(0);
#pragma unroll
                for (int m = 0; m < 4; ++m) {
                    const int c = row0 + ai * 128 + m * 16; const u32x4 uu = uq[m];
                    f32x4 v0 = acc[ai][bj][m][0], v1 = acc[ai][bj][m][1];
                    v0[0] += d0[0] * bflo(uu.x); v0[1] += d0[1] * bfhi(uu.x); v0[2] += d0[2] * bflo(uu.y); v0[3] += d0[3] * bfhi(uu.y);
                    v1[0] += d1[0] * bflo(uu.z); v1[1] += d1[1] * bfhi(uu.z); v1[2] += d1[2] * bflo(uu.w); v1[3] += d1[3] * bfhi(uu.w);
#pragma unroll
                    for (int j = 0; j < 4; ++j) { v0[j] = gelu_tanh(v0[j]); v1[j] = gelu_tanh(v1[j]); }
                    u32x4 w; w.x = pk2(v0[0], v0[1]); w.y = pk2(v0[2], v0[3]); w.z = pk2(v1[0], v1[1]); w.w = pk2(v1[2], v1[3]);
                    *(u32x4*)(YB + (size_t)(c * 16 + tt) * DI + ch) = w; }
                __builtin_amdgcn_sched_barrier(0);
            } }
    }
};
struct EpiGlu {
    static constexpr bool PERM = true, AFTER_DRAIN = false, KSCALE = false;
    const bf16_t *YB, *ZS; bf16_t* Y2; const float* bg;
    __device__ __forceinline__ void operator()(const Acc& acc, const Unit& u, int wr, int wc, int fr, int fq) const {
        const int row0 = u.pm * 256 + wr * 64 + fr, col0 = u.pn * 256 + wc * 32 + 8 * fq;
#pragma unroll
        for (int bj = 0; bj < 2; ++bj) {
            const int c = col0 + bj * 128;
            const f32x4 b0 = *(const f32x4*)(bg + c), b1 = *(const f32x4*)(bg + c + 4);
#pragma unroll
            for (int ai = 0; ai < 2; ++ai) {
                u32x4 yy[4], zz[4];
#pragma unroll
                for (int m = 0; m < 4; ++m) { const size_t off = (size_t)(row0 + ai * 128 + m * 16) * DI + c; yy[m] = *(const u32x4*)(YB + off); zz[m] = *(const u32x4*)(ZS + off); }
                __builtin_amdgcn_sched_barrier(0);
#pragma unroll
                for (int m = 0; m < 4; ++m) {
                    const size_t off = (size_t)(row0 + ai * 128 + m * 16) * DI + c;
                    f32x4 v0 = acc[ai][bj][m][0] + b0, v1 = acc[ai][bj][m][1] + b1;
                    v0[0] = bflo(yy[m].x) * bflo(zz[m].x) * sigmoidf_(v0[0]); v0[1] = bfhi(yy[m].x) * bfhi(zz[m].x) * sigmoidf_(v0[1]);
                    v0[2] = bflo(yy[m].y) * bflo(zz[m].y) * sigmoidf_(v0[2]); v0[3] = bfhi(yy[m].y) * bfhi(zz[m].y) * sigmoidf_(v0[3]);
                    v1[0] = bflo(yy[m].z) * bflo(zz[m].z) * sigmoidf_(v1[0]); v1[1] = bfhi(yy[m].z) * bfhi(zz[m].z) * sigmoidf_(v1[1]);
                    v1[2] = bflo(yy[m].w) * bflo(zz[m].w) * sigmoidf_(v1[2]); v1[3] = bfhi(yy[m].w) * bfhi(zz[m].w) * sigmoidf_(v1[3]);
                    u32x4 w; w.x = pk2(v0[0], v0[1]); w.y = pk2(v0[2], v0[3]); w.z = pk2(v1[0], v1[1]); w.w = pk2(v1[2], v1[3]);
                    *(u32x4*)(Y2 + off) = w; }
                __builtin_amdgcn_sched_barrier(0);
            } }
    }
};
struct EpiOut {
    static constexpr bool PERM = false, AFTER_DRAIN = false, KSCALE = false;
    const float* X; float* R; const float* gate;
    __device__ __forceinline__ void operator()(const Acc& acc, const Unit& u, int wr, int wc, int fr, int fq) const {
        const int row0 = u.pm * 256 + wr * 64 + fr, col0 = u.pn * 256 + wc * 32 + 4 * fq;
        f32x4 gv[2][2];
#pragma unroll
        for (int bj = 0; bj < 2; ++bj)
#pragma unroll
            for (int n = 0; n < 2; ++n) gv[bj][n] = *(const f32x4*)(gate + col0 + bj * 128 + n * 16) + 1.0f;
#pragma unroll
        for (int ai = 0; ai < 2; ++ai)
#pragma unroll
            for (int m = 0; m < 4; ++m) {
                const size_t off = (size_t)(row0 + ai * 128 + m * 16) * DM + col0;
#pragma unroll
                for (int bj = 0; bj < 2; ++bj)
#pragma unroll
                    for (int n = 0; n < 2; ++n) {
                        const f32x4 xv = *(const f32x4*)(X + off + bj * 128 + n * 16);
                        *(f32x4*)(R + off + bj * 128 + n * 16) = xv * DN_ALPHA + gv[bj][n] * acc[ai][bj][m][n]; } }
    }
};

template <bool RS> struct EpiOutLn {
    static constexpr bool PERM = true, AFTER_DRAIN = true, KSCALE = RS;
    const float* part;
    __device__ __forceinline__ void prologue(const Unit& u, LAS unsigned char* lds, int tid) const {
        LAS float* RT = (LAS float*)(lds + LDS_RT);
        if (tid < 256) {
            const int t = u.pm * 256 + tid, c = t >> 6, tl = t & 63; float r[4];
#pragma unroll
            for (int h = 0; h < 4; ++h) { const float* pp = part + (((size_t)c * 4 + h) * 8) * 64 + tl; float sm = 0.f;
#pragma unroll
                for (int q = 0; q < 8; ++q) sm += pp[q * 64];
                r[h] = rsqrtf(sm * (1.0f / 1024.0f) + 1e-6f); }
            RT[tid] = r[0] / r[1]; RT[256 + tid] = r[1] / r[2]; RT[512 + tid] = r[2] / r[3]; RT[768 + tid] = r[3];
        }
        asm volatile("s_waitcnt vmcnt(0) lgkmcnt(0)" ::: "memory"); __syncthreads();
    }
    __device__ __forceinline__ void kscale(Acc& acc, int hb, LAS unsigned char* lds, int wr, int fr) const {
        const LAS float* RT = (const LAS float*)(lds + LDS_RT) + hb * 256 + wr * 64 + fr;
#pragma unroll
        for (int ai = 0; ai < 2; ++ai)
#pragma unroll
            for (int m = 0; m < 4; ++m) { const float f = RT[ai * 128 + m * 16];
#pragma unroll
                for (int bj = 0; bj < 2; ++bj)
#pragma unroll
                    for (int n = 0; n < 2; ++n) acc[ai][bj][m][n] *= f; }
    }
    const float* X; float* Xo; bf16_t* U; const float* gate; const float* lng; const float* lnb; const float* modn;
    unsigned long long* xbuf; unsigned* cnt;
    const float* modc;
    __device__ __forceinline__ void operator()(const Acc&, const Unit&, int, int, int, int) const {}
    __device__ __forceinline__ void fused(Acc& acc, const Unit& u, int wr, int wc, int fr, int fq, LAS unsigned char* lds, int wid, int lane) const {
        LAS f32x2* P = (LAS f32x2*)lds;
        LAS f32x2* S = (LAS f32x2*)(lds + 8192);
        const int row0 = u.pm * 256 + wr * 64 + fr, col0 = u.pn * 256 + wc * 32 + 8 * fq;
        if constexpr (RS) kscale(acc, 3, lds, wr, fr);
        {
            f32x4 gv[2][2];
#pragma unroll
            for (int bj = 0; bj < 2; ++bj)
#pragma unroll
                for (int n = 0; n < 2; ++n) gv[bj][n] = *(const f32x4*)(gate + col0 + bj * 128 + n * 4) + 1.0f;
            {
                const _Float16* XH = (const _Float16*)modc;
#pragma unroll
                for (int ai = 0; ai < 2; ++ai)
#pragma unroll
                    for (int m = 0; m < 4; ++m) {
                        const size_t off = (size_t)(row0 + ai * 128 + m * 16) * DM + col0;
#pragma unroll
                        for (int bj = 0; bj < 2; ++bj)
#pragma unroll
                            for (int n = 0; n < 2; ++n) { const f16x4 xh = *(const f16x4*)(XH + off + bj * 128 + n * 4);
                                const f32x4 xv = __builtin_convertvector(xh, f32x4);
                                acc[ai][bj][m][n] = xv * DN_ALPHA + gv[bj][n] * acc[ai][bj][m][n]; }
                        asm volatile("" : "+v"(acc[ai][0][m][0]), "+v"(acc[ai][0][m][1]), "+v"(acc[ai][1][m][0]), "+v"(acc[ai][1][m][1]));
                        if (m & 1) asm volatile("" ::: "memory"); }
            }
        }
#pragma unroll
        for (int ai = 0; ai < 2; ++ai)
#pragma unroll
            for (int m = 0; m < 4; ++m) {
                float sm = 0.f;
#pragma unroll
                for (int bj = 0; bj < 2; ++bj)
#pragma unroll
                    for (int n = 0; n < 2; ++n) { const f32x4 x = acc[ai][bj][m][n]; sm += (x[0] + x[1]) + (x[2] + x[3]); }
                sm += __shfl_xor(sm, 16); sm += __shfl_xor(sm, 32);
                const float mw = sm * (1.0f / 64.0f); float q = 0.f;
#pragma unroll
                for (int bj = 0; bj < 2; ++bj)
#pragma unroll
                    for (int n = 0; n < 2; ++n) { const f32x4 d = acc[ai][bj][m][n] - mw; q += (d[0] * d[0] + d[1] * d[1]) + (d[2] * d[2] + d[3] * d[3]); }
                q += __shfl_xor(q, 16); q += __shfl_xor(q, 32);
                if (fq == 0) P[(ai * 128 + wr * 64 + m * 16 + fr) * 4 + wc] = (f32x2){mw, q};
            }
        asm volatile("s_waitcnt lgkmcnt(0)" ::: "memory"); __builtin_amdgcn_s_barrier(); asm volatile("" ::: "memory");
        const int row = wid * 32 + (lane & 31);
        if (lane < 32) {
            const f32x2 a = P[row * 4 + 0], b = P[row * 4 + 1], c = P[row * 4 + 2], d = P[row * 4 + 3];
            const float mt = (a.x + b.x + c.x + d.x) * 0.25f;
            const float da = a.x - mt, db = b.x - mt, dc = c.x - mt, dd = d.x - mt;
            const float m2 = (a.y + b.y) + (c.y + d.y) + 64.0f * ((da * da + db * db) + (dc * dc + dd * dd));
            unsigned long long* slot = xbuf + ((size_t)(u.pm * 256 + row) * 8 + u.pn);
            __hip_atomic_store(slot, ((unsigned long long)__float_as_uint(m2) << 32) | __float_as_uint(mt), __ATOMIC_RELAXED, __HIP_MEMORY_SCOPE_AGENT);
        }
        asm volatile("s_waitcnt vmcnt(0)" ::: "memory");
        if (lane == 0) __hip_atomic_fetch_add(cnt + 64 * u.pm, 1u, __ATOMIC_RELAXED, __HIP_MEMORY_SCOPE_AGENT);
        if (wid == 0) {
            for (unsigned sp = 0; sp < (1u << 22); ++sp) {
                if ((unsigned)__builtin_amdgcn_readfirstlane(__hip_atomic_load(cnt + 64 * u.pm, __ATOMIC_RELAXED, __HIP_MEMORY_SCOPE_AGENT)) >= 64u) break;
                __builtin_amdgcn_s_sleep(2);
            }
            __builtin_amdgcn_fence(__ATOMIC_ACQUIRE, "agent");
        }
        asm volatile("s_waitcnt vmcnt(0) lgkmcnt(0)" ::: "memory"); __builtin_amdgcn_s_barrier(); asm volatile("" ::: "memory");
        if (lane < 32) {
            const unsigned long long* slot = xbuf + (size_t)(u.pm * 256 + row) * 8; float mt[8], m2[8]; float ms = 0.f;
#pragma unroll
            for (int t = 0; t < 8; ++t) { const unsigned long long wv = __hip_atomic_load(slot + t, __ATOMIC_RELAXED, __HIP_MEMORY_SCOPE_AGENT); mt[t] = __uint_as_float((unsigned)wv); m2[t] = __uint_as_float((unsigned)(wv >> 32)); ms += mt[t]; }
            const float mean = ms * 0.125f; float q = 0.f;
#pragma unroll
            for (int t = 0; t < 8; ++t) { const float dm = mt[t] - mean; q += m2[t] + 256.0f * dm * dm; }
            S[row] = (f32x2){mean, rsqrtf(q * (1.0f / 2048.0f) + 1e-5f)};
        }
        asm volatile("s_waitcnt lgkmcnt(0)" ::: "memory"); __builtin_amdgcn_s_barrier(); asm volatile("" ::: "memory");
        typedef _Float16 f16x8 __attribute__((ext_vector_type(8)));
#pragma unroll
        for (int bj = 0; bj < 2; ++bj) {
            const int col = col0 + bj * 128;
            const f32x4 g0 = *(const f32x4*)(lng + col), g1 = *(const f32x4*)(lng + col + 4), b0 = *(const f32x4*)(lnb + col), b1 = *(const f32x4*)(lnb + col + 4);
            f32x4 sc0 = {0.f, 0.f, 0.f, 0.f}, sc1 = sc0, sh0 = sc0, sh1 = sc0;
            if (modn) { sh0 = *(const f32x4*)(modn + col); sh1 = *(const f32x4*)(modn + col + 4); sc0 = *(const f32x4*)(modn + 2048 + col) + 1.0f; sc1 = *(const f32x4*)(modn + 2048 + col + 4) + 1.0f; }
#pragma unroll
            for (int ai = 0; ai < 2; ++ai)
#pragma unroll
                for (int m = 0; m < 4; ++m) {
                    const int r = ai * 128 + wr * 64 + m * 16 + fr; const f32x2 sr = S[r];
                    const size_t off = (size_t)(u.pm * 256 + r) * DM + col;
                    const f32x4 y0 = (acc[ai][bj][m][0] - sr.x) * sr.y * g0 + b0, y1 = (acc[ai][bj][m][1] - sr.x) * sr.y * g1 + b1;
                    if (Xo) { *(f32x4*)(Xo + off) = y0; *(f32x4*)(Xo + off + 4) = y1; }
                    if (modn) { const f32x4 u0 = y0 * sc0 + sh0, u1 = y1 * sc1 + sh1;
                        u32x4 wv; wv.x = pk2(u0[0], u0[1]); wv.y = pk2(u0[2], u0[3]); wv.z = pk2(u1[0], u1[1]); wv.w = pk2(u1[2], u1[3]); *(u32x4*)(U + off) = wv;
                        const f16x4 h0 = __builtin_convertvector(y0, f16x4), h1 = __builtin_convertvector(y1, f16x4);
                        *(f16x8*)((_Float16*)modc + off) = __builtin_shufflevector(h0, h1, 0, 1, 2, 3, 4, 5, 6, 7); }
                    if (m & 1) asm volatile("" ::: "memory");
                }
            asm volatile("" ::: "memory");
        }
    }
};

__device__ __forceinline__ void conv_job(const Ctx cx, LAS unsigned char* lds, const float* src, const int K, const int sstride, const int col0, const int ncols, bf16_t* dst, const int ldd) {
    const int tid = cx.tid, G = cx.G;
    const int ntn = ncols >> 7, ntiles = ntn * (K >> 6);
    LAS unsigned* T = (LAS unsigned*)lds;
    const int c4 = tid & 31, rp = tid >> 5;
    f32x4 va[4], vb[4];
#define CONV_LOAD(v, tile) do { const int tk_ = (tile) / ntn, tn_ = (tile) % ntn; \
        const float* s_ = src + (size_t)(tk_ * 64 + 2 * rp) * sstride + col0 + tn_ * 128 + 4 * c4; \
        v[0] = __builtin_nontemporal_load((const f32x4*)s_); v[1] = __builtin_nontemporal_load((const f32x4*)(s_ + sstride)); v[2] = __builtin_nontemporal_load((const f32x4*)(s_ + (size_t)32 * sstride)); v[3] = __builtin_nontemporal_load((const f32x4*)(s_ + (size_t)33 * sstride)); } while (0)
#define CONV_OUT(v, tile, nexttile) do { \
        _Pragma("unroll") for (int j = 0; j < 4; ++j) { T[(4 * c4 + j) * 33 + rp] = pk2(v[0][j], v[1][j]); T[(4 * c4 + j) * 33 + rp + 16] = pk2(v[2][j], v[3][j]); } \
        if ((nexttile) < ntiles) CONV_LOAD(v, nexttile); \
        __syncthreads(); \
        { const int tk = (tile) / ntn, tn = (tile) % ntn; const int n = tid >> 2, qq = tid & 3; \
          u32x4 w0, w1; const LAS unsigned* tp = T + n * 33 + 8 * qq; \
          w0.x = tp[0]; w0.y = tp[1]; w0.z = tp[2]; w0.w = tp[3]; w1.x = tp[4]; w1.y = tp[5]; w1.z = tp[6]; w1.w = tp[7]; \
          bf16_t* d = dst + (size_t)(tn * 128 + n) * ldd + tk * 64 + 16 * qq; \
          *(u32x4*)d = w0; *(u32x4*)(d + 8) = w1; } \
        __syncthreads(); } while (0)
    int t = cx.bid;
    if (t < ntiles) CONV_LOAD(va, t);
    if (t + G < ntiles) CONV_LOAD(vb, t + G);
    for (; t < ntiles; t += 2 * G) {
        CONV_OUT(va, t, t + 2 * G);
        if (t + G < ntiles) CONV_OUT(vb, t + G, t + 3 * G);
    }
#undef CONV_LOAD
#undef CONV_OUT
}

__device__ __forceinline__ void s5_tables(const Ctx cx, KP p, LAS unsigned char* lds, const int j) {
    const int tid = cx.tid;
    LAS float* LP = (LAS float*)lds;
    LAS float* BB = LP + 17 * 64 * 2;
    LAS float* CC = BB + 2048;
    LAS float* KT = CC + 2048;
    LAS float* CF = KT + 4096;
    bf16_t* MG = (bf16_t*)(p->ws + WS_MG); bf16_t* WE = (bf16_t*)(p->ws + WS_WE); float* LT = (float*)(p->ws + WS_LAMT);
    for (int g = cx.bid; g < 256; g += cx.G) {
        __syncthreads();
        const int jg = j * 256 + g;
        if (tid < 64) {
            const float are = p->s5_a_re[jg * 64 + tid], aim = p->s5_a_im[jg * 64 + tid], dt = expf(p->s5_log_dt[jg]);
            const float mag = expf(are * dt), ang = aim * dt;
            const float lbr = mag * cosf(ang), lbi = mag * sinf(ang);
            const float nr = lbr - 1.0f, den = are * are + aim * aim;
            CF[2 * tid] = (nr * are + lbi * aim) / den; CF[2 * tid + 1] = (lbi * are - nr * aim) / den;
            for (int n = 0; n <= 16; ++n) { const float mm = expf(are * dt * (float)n), a = ang * (float)n; LP[(n * 64 + tid) * 2] = mm * cosf(a); LP[(n * 64 + tid) * 2 + 1] = mm * sinf(a); }
        }
        __syncthreads();
        for (int idx = tid; idx < 1024; idx += NT) {
            const int pp = idx >> 4;
            const float br = p->s5_b_re[(size_t)jg * 1024 + idx], bi = p->s5_b_im[(size_t)jg * 1024 + idx], cr = CF[2 * pp], ci = CF[2 * pp + 1];
            BB[idx * 2] = cr * br - ci * bi; BB[idx * 2 + 1] = cr * bi + ci * br;
            CC[idx * 2] = p->s5_c_re[(size_t)jg * 1024 + idx]; CC[idx * 2 + 1] = p->s5_c_im[(size_t)jg * 1024 + idx];
        }
        __syncthreads();
        {
            const int tau = tid >> 5, o = (tid >> 1) & 15, i0 = (tid & 1) * 8;
            float acc8[8];
#pragma unroll
            for (int jj = 0; jj < 8; ++jj) acc8[jj] = 0.f;
            for (int pp = 0; pp < 64; ++pp) {
                const float Lr = LP[(tau * 64 + pp) * 2], Li = LP[(tau * 64 + pp) * 2 + 1], Cr = CC[(o * 64 + pp) * 2], Ci = CC[(o * 64 + pp) * 2 + 1];
                const float Gr = Cr * Lr - Ci * Li, Gi = Cr * Li + Ci * Lr;
                const LAS f32x4* bp = (const LAS f32x4*)(BB + (pp * 16 + i0) * 2);
#pragma unroll
                for (int v4 = 0; v4 < 4; ++v4) { const f32x4 bb = bp[v4]; acc8[2 * v4] += Gr * bb[0] - Gi * bb[1]; acc8[2 * v4 + 1] += Gr * bb[2] - Gi * bb[3]; }
            }
#pragma unroll
            for (int jj = 0; jj < 8; ++jj) KT[(tau * 16 + o) * 16 + i0 + jj] = acc8[jj];
        }
        __syncthreads();
        bf16_t* Mg = MG + (size_t)g * 256 * 384;
        for (int it = 0; it < 24; ++it) {
            const int v = tid + NT * it, row = v / 48, kc = (v % 48) * 8, t = row >> 4, o = row & 15;
            float val[8];
            if (kc < 256) { const int s = kc >> 4, i0 = kc & 15;
#pragma unroll
                for (int jj = 0; jj < 8; ++jj) val[jj] = (t >= s) ? KT[((t - s) * 16 + o) * 16 + i0 + jj] : 0.f;
            } else { const int n0 = kc - 256;
#pragma unroll
                for (int jj = 0; jj < 8; ++jj) { const int pp = (n0 + jj) & 63;
                    const float Lr = LP[((t + 1) * 64 + pp) * 2], Li = LP[((t + 1) * 64 + pp) * 2 + 1], Cr = CC[(o * 64 + pp) * 2], Ci = CC[(o * 64 + pp) * 2 + 1];
                    val[jj] = (n0 < 64) ? (Cr * Lr - Ci * Li) : -(Cr * Li + Ci * Lr); } }
            u32x4 w; w.x = pk2(val[0], val[1]); w.y = pk2(val[2], val[3]); w.z = pk2(val[4], val[5]); w.w = pk2(val[6], val[7]);
            *(u32x4*)(Mg + (size_t)row * 384 + kc) = w;
        }
        bf16_t* We = WE + (size_t)g * 128 * 256;
        for (int it = 0; it < 8; ++it) {
            const int v = tid + NT * it, n = v >> 5, kc = (v & 31) * 8, s = kc >> 4, i0 = kc & 15, pp = n & 63;
            const float Lr = LP[((15 - s) * 64 + pp) * 2], Li = LP[((15 - s) * 64 + pp) * 2 + 1];
            float val[8];
#pragma unroll
            for (int jj = 0; jj < 8; ++jj) { const float Br = BB[(pp * 16 + i0 + jj) * 2], Bi = BB[(pp * 16 + i0 + jj) * 2 + 1]; val[jj] = (n < 64) ? (Lr * Br - Li * Bi) : (Lr * Bi + Li * Br); }
            u32x4 w; w.x = pk2(val[0], val[1]); w.y = pk2(val[2], val[3]); w.z = pk2(val[4], val[5]); w.w = pk2(val[6], val[7]);
            *(u32x4*)(We + (size_t)n * 256 + kc) = w;
        }
        if (tid < 128) LT[g * 128 + tid] = LP[(16 * 64 + (tid & 63)) * 2 + (tid >> 6)];
    }
    __syncthreads();
}

__device__ __forceinline__ void phase_prep(const Ctx cx, KP p, LAS unsigned char* lds) {
    const int tid = cx.tid, G = cx.G;
    float* modp = (float*)(p->ws + WS_MODP);
    for (int it = cx.bid; it < 256; it += G) {
        const int l = it >> 6, dc = it & 63;
        f32x4 a0 = {0.f, 0.f, 0.f, 0.f}, a1 = a0, a2 = a0;
        const float* wp = p->ada_w + ((size_t)l * DM + dc * 32) * 6144 + 4 * tid;
#pragma unroll 8
        for (int r = 0; r < 32; ++r) {
            const float s = siluf_(p->c[dc * 32 + r]);
            a0 += s * __builtin_nontemporal_load((const f32x4*)(wp + (size_t)r * 6144)); a1 += s * __builtin_nontemporal_load((const f32x4*)(wp + (size_t)r * 6144 + 2048)); a2 += s * __builtin_nontemporal_load((const f32x4*)(wp + (size_t)r * 6144 + 4096));
        }
        float* o = modp + ((size_t)dc * 4 + l) * 6144 + 4 * tid;
        *(f32x4*)o = a0; *(f32x4*)(o + 2048) = a1; *(f32x4*)(o + 4096) = a2;
    }
    { bf16_t* wgt = (bf16_t*)(p->ws + WS_WGT);
      for (int idx = cx.bid * NT + tid; idx < 65536; idx += G * NT) { const int j = idx >> 15, r = (idx >> 11) & 15, d = idx & 2047; wgt[idx] = (bf16_t)(pk2(p->gla_w_in[((size_t)j * DM + d) * GLA_W + 10240 + r], 0.f) & 0xffffu); } }
    for (int j = 0; j < 2; ++j) {
        bf16_t* wg = (bf16_t*)(p->ws + WS_WG) + (size_t)j * 10240 * DM;
        const float* src = p->gla_w_in + (size_t)j * DM * GLA_W;
        conv_job(cx, lds, src, DM, GLA_W, 0, 1024, wg, DM);
        conv_job(cx, lds, src, DM, GLA_W, 6144, 4096, wg + (size_t)1024 * DM, DM);
        conv_job(cx, lds, src, DM, GLA_W, 1024, 1024, wg + (size_t)5120 * DM, DM);
        conv_job(cx, lds, src, DM, GLA_W, 2048, 4096, wg + (size_t)6144 * DM, DM);
        conv_job(cx, lds, p->gla_w_out + (size_t)j * DI * DM, DI, DM, 0, DM, (bf16_t*)(p->ws + WS_WGO) + (size_t)j * DM * DI, DI);
        conv_job(cx, lds, p->s5_w_in + (size_t)j * DM * 8192, DM, 8192, 0, 8192, (bf16_t*)(p->ws + WS_WSI) + (size_t)j * 8192 * DM, DM);
        conv_job(cx, lds, p->s5_w_glu + (size_t)j * DI * DI, DI, DI, 0, DI, (bf16_t*)(p->ws + WS_WGLU) + (size_t)j * DI * DI, DI);
        conv_job(cx, lds, p->s5_w_out + (size_t)j * DI * DM, DI, DM, 0, DM, (bf16_t*)(p->ws + WS_WSO) + (size_t)j * DM * DI, DI);
    }
    s5_tables(cx, p, lds, 0);
}

__device__ __forceinline__ void phase_mod_u0(const Ctx cx, KP p) {
    const int tid = cx.tid, G = cx.G;
    const float* modp = (const float*)(p->ws + WS_MODP); float* mod = (float*)(p->ws + WS_MOD);
    for (int idx = cx.bid * NT + tid; idx < 24576; idx += G * NT) {
        const int l = idx / 6144, e = idx % 6144; float s = p->ada_b[idx];
        for (int dc = 0; dc < 64; ++dc) s += modp[((size_t)dc * 4 + l) * 6144 + e];
        mod[idx] = s;
    }
    f32x4 sh = *(const f32x4*)(p->ada_b + 4 * tid), sc = *(const f32x4*)(p->ada_b + 2048 + 4 * tid);
    for (int dc = 0; dc < 64; ++dc) { sh += *(const f32x4*)(modp + (size_t)dc * 4 * 6144 + 4 * tid); sc += *(const f32x4*)(modp + (size_t)dc * 4 * 6144 + 2048 + 4 * tid); }
    sc += 1.0f;
    bf16_t* U = (bf16_t*)(p->ws + WS_U);
    for (int row0 = cx.bid; row0 < SEQ; row0 += 8 * G) {
        f32x4 xv[8];
#pragma unroll
        for (int i = 0; i < 8; ++i) { const int row = row0 + i * G; if (row < SEQ) xv[i] = *(const f32x4*)(p->x + (size_t)row * DM + 4 * tid); }
#pragma unroll
        for (int i = 0; i < 8; ++i) { const int row = row0 + i * G; if (row < SEQ) { const f32x4 uv = xv[i] * sc + sh; u32x2 w; w.x = pk2(uv[0], uv[1]); w.y = pk2(uv[2], uv[3]); *(u32x2*)(U + (size_t)row * DM + 4 * tid) = w;
            *(f16x4*)((_Float16*)(p->ws + WS_X) + (size_t)row * DM + 4 * tid) = __builtin_convertvector(xv[i], f16x4); } }
    }
}

__device__ __forceinline__ void gla_glr(const Ctx cx, KP p, const int j) {
    const int tid = cx.tid, w = __builtin_amdgcn_readfirstlane(tid >> 6), lane = tid & 63, fr = lane & 15, fq = lane >> 4;
    const bf16_t* U = (const bf16_t*)(p->ws + WS_U); const bf16_t* wgt = (const bf16_t*)(p->ws + WS_WGT) + (size_t)j * 16 * DM;
    float* glr = (float*)(p->ws + WS_ACT + ACT_GLR);
    for (int tile = cx.bid + cx.G * w; tile < 512; tile += cx.G * 8) {
        const bf16_t* up = U + (size_t)(tile * 16 + fr) * DM + 8 * fq; const bf16_t* wp = wgt + (size_t)fr * DM + 8 * fq;
        f32x4 acc = {0.f, 0.f, 0.f, 0.f};
#pragma unroll 16
        for (int sx = 0; sx < 64; ++sx) { const bf16x8 a = *(const bf16x8*)(up + 32 * sx), b = *(const bf16x8*)(wp + 32 * sx); acc = __builtin_amdgcn_mfma_f32_16x16x32_bf16(a, b, acc, 0, 0, 0); }
#pragma unroll
        for (int jj = 0; jj < 4; ++jj) glr[(tile * 16 + 4 * fq + jj) * 16 + fr] = acc[jj];
    }
}

__device__ __forceinline__ void gla_decay(const Ctx cx, KP p, LAS unsigned char* lds, const int j) {
    const int tid = cx.tid, G = cx.G;
    const float* glr = (const float*)(p->ws + WS_ACT + ACT_GLR); float* etot = (float*)(p->ws + WS_ACT + ACT_ETOT);
    const bf16_t* KT = (const bf16_t*)(p->ws + WS_ACT + ACT_KT); bf16_t* KD = (bf16_t*)(p->ws + WS_ACT + ACT_KD);
    LAS float* gl = (LAS float*)lds;
    for (int it = cx.bid; it < 256; it += G) {
        const int c = it >> 1, kk = (it & 1) * 512 + tid;
        __syncthreads();
        gl[tid] = glr[c * 1024 + tid]; gl[tid + 512] = glr[c * 1024 + 512 + tid];
        __syncthreads();
        float w2[16];
#pragma unroll
        for (int r = 0; r < 16; ++r) w2[r] = p->gla_gate_w2[((size_t)j * 16 + r) * NQK + kk];
        const float gb = p->gla_gate_b[j * NQK + kk];
        float cum[64]; float run = 0.f;
#pragma unroll
        for (int t = 0; t < 64; ++t) {
            float xx = gb;
#pragma unroll
            for (int r4 = 0; r4 < 4; ++r4) { const f32x4 gv = *(const LAS f32x4*)(gl + t * 16 + r4 * 4); xx += gv[0] * w2[r4 * 4] + gv[1] * w2[r4 * 4 + 1] + gv[2] * w2[r4 * 4 + 2] + gv[3] * w2[r4 * 4 + 3]; }
            const float la = -(fmaxf(-xx, 0.f) + __logf(1.0f + __expf(-fabsf(xx)))) * 0.0625f;
            run += la; cum[t] = run;
        }
        etot[c * 1024 + kk] = __expf(run);
        const bf16_t* kp = KT + (size_t)kk * SEQ + c * 64; bf16_t* ko = KD + (size_t)kk * SEQ + c * 64;
        u32x4 kin[8];
#pragma unroll
        for (int q = 0; q < 8; ++q) kin[q] = *(const u32x4*)(kp + q * 8);
#pragma unroll
        for (int q = 0; q < 8; ++q) {
            u32x4 kv = kin[q];
            kv.x = pk2(bflo(kv.x) * __expf(run - cum[q * 8 + 0]), bfhi(kv.x) * __expf(run - cum[q * 8 + 1]));
            kv.y = pk2(bflo(kv.y) * __expf(run - cum[q * 8 + 2]), bfhi(kv.y) * __expf(run - cum[q * 8 + 3]));
            kv.z = pk2(bflo(kv.z) * __expf(run - cum[q * 8 + 4]), bfhi(kv.z) * __expf(run - cum[q * 8 + 5]));
            kv.w = pk2(bflo(kv.w) * __expf(run - cum[q * 8 + 6]), bfhi(kv.w) * __expf(run - cum[q * 8 + 7]));
            *(u32x4*)(ko + q * 8) = kv;
        }
    }
}

template <bool P2>
__device__ __forceinline__ void gla_scan2(const Ctx cx, KP p, LAS unsigned char* lds, const int j) {
    const int tid = cx.tid, w = __builtin_amdgcn_readfirstlane(tid >> 6), lane = tid & 63, fr = lane & 15, fq = lane >> 4;
    const bf16_t* QS = (const bf16_t*)(p->ws + WS_ACT + ACT_QS); const bf16_t* KT = (const bf16_t*)(p->ws + WS_ACT + ACT_KD);
    const bf16_t* VT = (const bf16_t*)(p->ws + WS_ACT + ACT_Y2); const bf16_t* ZS = (const bf16_t*)(p->ws + WS_ACT + ACT_ZS);
    bf16_t* Y = (bf16_t*)(p->ws + WS_ACT + ACT_YB); const float* etot = (const float*)(p->ws + WS_ACT + ACT_ETOT); float* part = (float*)(p->ws + WS_ACT + ACT_SSQ);
    float* SEND = (float*)(p->ws + WS_ACT + ACT_E); float* DSEG = (float*)(p->ws + WS_ACT + ACT_DSEG);
    const float* ng = p->gla_norm_g + (size_t)j * DI;
    LAS unsigned char* KD = lds;
    LAS unsigned char* QP = lds + 36864;
    LAS float* ET = (LAS float*)(lds + 36864 + 33792);
    LAS float* SQ = ET + 256;
    LAS unsigned char* ZT = lds + 73728;
    LAS unsigned char* YT = lds + 91136;
    for (int it = cx.bid; it < 256; it += cx.G) {
        const int xcd = it & 7, idx = it >> 3, P = xcd * 4 + (idx >> 3), h = P >> 3, seg = P & 7, slice = idx & 7;
        if (!P2 && seg == 7) continue;
        const int dv0 = h * 1024 + slice * 128 + 16 * w, c0 = seg * 16;
        const unsigned kgo = (unsigned)((h * 256 + (tid >> 3)) * SEQ + (tid & 7) * 8) * 2u;
        const unsigned qgo = (unsigned)((tid >> 5) * NQK + h * 256 + (tid & 31) * 8) * 2u;
        const unsigned ego = (unsigned)(h * 256 + 4 * (tid & 63)) * 4u;
        const unsigned vgo = (unsigned)((dv0 + fr) * SEQ + 8 * fq) * 2u;
        const unsigned zto = (unsigned)((tid >> 4) * DI + h * 1024 + slice * 128) * 2u + (unsigned)(tid & 15) * 16u;
        const unsigned ztl = (unsigned)(tid >> 4) * 272u + (unsigned)(tid & 15) * 16u, zfl = (unsigned)fr * 272u + (unsigned)(16 * w + 4 * fq) * 2u;
        const unsigned kl = (tid >> 3) * 144 + (tid & 7) * 16, ql = (tid >> 5) * 528 + (tid & 31) * 16;
        f32x4 S[16];
#pragma unroll
        for (int kt = 0; kt < 16; ++kt) S[kt] = (f32x4){0.f, 0.f, 0.f, 0.f};
        if (P2) {
            for (int sp = 0; sp < seg; ++sp) {
                const float* dp = DSEG + sp * 1024 + h * 256 + 4 * fq;
                const float* se = SEND + ((size_t)(((h * 8 + slice) * 8 + sp) * 8 + w) * 16) * 256 + lane * 4;
                f32x4 dd[16], ee[16];
#pragma unroll
                for (int kt = 0; kt < 16; ++kt) { dd[kt] = *(const f32x4*)(dp + 16 * kt); ee[kt] = *(const f32x4*)(se + kt * 256); }
#pragma unroll
                for (int kt = 0; kt < 16; ++kt) S[kt] = S[kt] * dd[kt] + ee[kt];
            }
        } else if (slice == 0 && tid < 256) {
            float pr = 1.0f;
            for (int c = 0; c < 16; ++c) pr *= etot[(c0 + c) * 1024 + h * 256 + tid];
            DSEG[seg * 1024 + h * 256 + tid] = pr;
        }
        f32x4 g4 = {0.f, 0.f, 0.f, 0.f};
        if (P2) g4 = *(const f32x4*)(ng + dv0 + 4 * fq);
        u32x4 rk[4], rq[4]; f32x4 re = {0.f, 0.f, 0.f, 0.f}; bf16x8 rv0, rv1; u32x4 rz2[2] = {};
#define SC_LOAD(c) do { const int c_ = (c); \
        _Pragma("unroll") for (int i = 0; i < 4; ++i) rk[i] = *(const u32x4*)((const char*)KT + (kgo + (unsigned)(i * 64 * SEQ + c_ * 64) * 2u)); \
        if (P2) { _Pragma("unroll") for (int i = 0; i < 4; ++i) rq[i] = *(const u32x4*)((const char*)QS + (qgo + (unsigned)((c_ * 64 + 16 * i) * NQK) * 2u)); } \
        if (tid < 64) re = *(const f32x4*)((const char*)etot + (ego + (unsigned)c_ * 4096u)); \
        if (P2) { rz2[0] = *(const u32x4*)((const char*)ZS + (zto + (unsigned)(c_ * 64 * DI) * 2u)); rz2[1] = *(const u32x4*)((const char*)ZS + (zto + (unsigned)((c_ * 64 + 32) * DI) * 2u)); } \
        } while (0)
#define SC_LOADV(c) do { const int cv_ = (c); rv0 = *(const bf16x8*)((const char*)VT + (vgo + (unsigned)cv_ * 128u)); rv1 = *(const bf16x8*)((const char*)VT + (vgo + (unsigned)cv_ * 128u + 64u)); } while (0)
        SC_LOAD(c0); SC_LOADV(c0);
#pragma nounroll
        for (int cc = 0; cc < 16; ++cc) {
            const int c = c0 + cc;
            __syncthreads();
            if (P2 && cc > 0) {
#pragma unroll
                for (int i = 0; i < 2; ++i) { const u32x4 yv4 = *(const LAS u32x4*)(YT + ztl + i * 32 * 272); *(u32x4*)((char*)Y + (zto + (unsigned)(((c - 1) * 64 + 32 * i) * DI) * 2u)) = yv4; } }
            if (P2 && cc > 0 && tid < 64) { float sm = 0.f;
#pragma unroll
                for (int ww = 0; ww < 8; ++ww) sm += SQ[ww * 64 + tid];
                part[(((size_t)(c - 1) * 4 + h) * 8 + slice) * 64 + tid] = sm; }
#pragma unroll
            for (int i = 0; i < 4; ++i) *(LAS u32x4*)(KD + kl + i * 9216) = rk[i];
            if (P2) {
#pragma unroll
                for (int i = 0; i < 4; ++i) *(LAS u32x4*)(QP + ql + i * 8448) = rq[i]; }
            if (tid < 64) *(LAS f32x4*)(ET + 4 * tid) = re;
            if (P2) { *(LAS u32x4*)(ZT + ztl) = rz2[0]; *(LAS u32x4*)(ZT + ztl + 32 * 272) = rz2[1]; }
            __syncthreads();
            if (cc + 1 < 16) SC_LOAD(c + 1);
#pragma unroll
            for (int kb = 0; kb < 4; ++kb) {
                f32x4 e[4]; bf16x8 a0[4], a1[4];
#pragma unroll
                for (int i = 0; i < 4; ++i) { const int kt = 4 * kb + i;
                    e[i] = *(const LAS f32x4*)(ET + 16 * kt + 4 * fq);
                    a0[i] = *(const LAS bf16x8*)(KD + (16 * kt + fr) * 144 + fq * 16); a1[i] = *(const LAS bf16x8*)(KD + (16 * kt + fr) * 144 + 64 + fq * 16); }
                __builtin_amdgcn_sched_barrier(0);
#pragma unroll
                for (int i = 0; i < 4; ++i) { const int kt = 4 * kb + i;
                    S[kt] *= e[i];
                    S[kt] = __builtin_amdgcn_mfma_f32_16x16x32_bf16(a0[i], rv0, S[kt], 0, 0, 0);
                    S[kt] = __builtin_amdgcn_mfma_f32_16x16x32_bf16(a1[i], rv1, S[kt], 0, 0, 0); }
                __builtin_amdgcn_sched_barrier(0);
            }
            if (cc + 1 < 16) SC_LOADV(c + 1);
            if (P2) {
                bf16x8 sb[8];
#pragma unroll
                for (int q = 0; q < 8; ++q) { u32x4 t4; t4.x = pk2(S[2 * q][0], S[2 * q][1]); t4.y = pk2(S[2 * q][2], S[2 * q][3]); t4.z = pk2(S[2 * q + 1][0], S[2 * q + 1][1]); t4.w = pk2(S[2 * q + 1][2], S[2 * q + 1][3]); sb[q] = __builtin_bit_cast(bf16x8, t4); }
#pragma unroll
                for (int tt = 0; tt < 4; ++tt) {
                    f32x4 o = {0.f, 0.f, 0.f, 0.f}, o2 = o;
#pragma unroll
                    for (int qh = 0; qh < 2; ++qh) {
                        bf16x8 qf[4];
#pragma unroll
                        for (int q = 0; q < 4; ++q) qf[q] = *(const LAS bf16x8*)(QP + (16 * tt + fr) * 528 + (4 * qh + q) * 64 + fq * 16);
                        __builtin_amdgcn_sched_barrier(0);
#pragma unroll
                        for (int q = 0; q < 4; q += 2) { o = __builtin_amdgcn_mfma_f32_16x16x32_bf16(sb[4 * qh + q], qf[q], o, 0, 0, 0); o2 = __builtin_amdgcn_mfma_f32_16x16x32_bf16(sb[4 * qh + q + 1], qf[q + 1], o2, 0, 0, 0); }
                        __builtin_amdgcn_sched_barrier(0);
                    }
                    o += o2;
                    float sq = (o[0] * o[0] + o[1] * o[1]) + (o[2] * o[2] + o[3] * o[3]);
                    sq += __shfl_xor(sq, 16); sq += __shfl_xor(sq, 32);
                    if (fq == 0) SQ[w * 64 + 16 * tt + fr] = sq;
                    const u32x2 zt = *(const LAS u32x2*)(ZT + zfl + tt * 16 * 272);
                    u32x2 yv; yv.x = pk2(o[0] * g4[0] * bflo(zt.x), o[1] * g4[1] * bfhi(zt.x)); yv.y = pk2(o[2] * g4[2] * bflo(zt.y), o[3] * g4[3] * bfhi(zt.y));
                    *(LAS u32x2*)(YT + zfl + tt * 16 * 272) = yv;
                }
            }
        }
#undef SC_LOAD
#undef SC_LOADV
        if (P2) { __syncthreads();
#pragma unroll
            for (int i = 0; i < 2; ++i) { const u32x4 yv4 = *(const LAS u32x4*)(YT + ztl + i * 32 * 272); *(u32x4*)((char*)Y + (zto + (unsigned)(((c0 + 15) * 64 + 32 * i) * DI) * 2u)) = yv4; }
            if (tid < 64) { float sm = 0.f;
#pragma unroll
                for (int ww = 0; ww < 8; ++ww) sm += SQ[ww * 64 + tid];
                part[(((size_t)(c0 + 15) * 4 + h) * 8 + slice) * 64 + tid] = sm; } }
        if (!P2) {
            float* se = SEND + ((size_t)(((h * 8 + slice) * 8 + seg) * 8 + w) * 16) * 256 + lane * 4;
#pragma unroll
            for (int kt = 0; kt < 16; ++kt) *(f32x4*)(se + kt * 256) = S[kt];
        }
        __syncthreads();
    }
}

__device__ __forceinline__ void gla_rms(const Ctx cx, KP p, LAS unsigned char* lds) {
    const int tid = cx.tid, G = cx.G;
    bf16_t* Y = (bf16_t*)(p->ws + WS_ACT + ACT_YB); const float* part = (const float*)(p->ws + WS_ACT + ACT_SSQ);
    LAS float* ps = (LAS float*)lds;
    LAS float* rsd = ps + 512;
    for (int it = cx.bid; it < 256; it += G) {
        const int c = it >> 1, half = it & 1;
        { const int h = tid >> 7, sg = (tid >> 5) & 3, tl = tid & 31;
          const float* pp = part + (((size_t)c * 4 + h) * 8 + sg * 2) * 64 + half * 32 + tl;
          float s = pp[0] + pp[64];
          __syncthreads();
          ps[tid] = s;
          __syncthreads();
          if (tid < 128) { const int hh = tid >> 5, t2 = tid & 31; const float tot = ps[hh * 128 + t2] + ps[hh * 128 + 32 + t2] + ps[hh * 128 + 64 + t2] + ps[hh * 128 + 96 + t2];
              rsd[tid] = rsqrtf(tot * (1.0f / 1024.0f) + 1e-6f); }
          __syncthreads(); }
        const int t0 = c * 64 + half * 32;
        for (int b = 0; b < 4; ++b) {
            u32x4 y[8];
#pragma unroll
            for (int i = 0; i < 8; ++i) { const int v = tid + (b * 8 + i) * NT; y[i] = *(const u32x4*)(Y + (size_t)(t0 + (v >> 9)) * DI + (v & 511) * 8); }
#pragma unroll
            for (int i = 0; i < 8; ++i) {
                const int v = tid + (b * 8 + i) * NT, tl = v >> 9, col = (v & 511) * 8; const float rs = rsd[(col >> 10) * 32 + tl];
                u32x4 o; o.x = pk2(bflo(y[i].x) * rs, bfhi(y[i].x) * rs); o.y = pk2(bflo(y[i].y) * rs, bfhi(y[i].y) * rs); o.z = pk2(bflo(y[i].z) * rs, bfhi(y[i].z) * rs); o.w = pk2(bflo(y[i].w) * rs, bfhi(y[i].w) * rs);
                *(u32x4*)(Y + (size_t)(t0 + tl) * DI + col) = o; }
        }
    }
}

__device__ __forceinline__ void ln_phase(const Ctx cx, KP p, const int layer) {
    const int tid = cx.tid, w = tid >> 6, lane = tid & 63;
    const float* R = (const float*)(p->ws + WS_ACT + ACT_E); float* Xo = (layer == 3) ? p->out : (float*)(p->ws + WS_X);
    bf16_t* U = (bf16_t*)(p->ws + WS_U);
    const float* g = p->ln_g + layer * DM; const float* b = p->ln_b + layer * DM;
    const float* mod = (const float*)(p->ws + WS_MOD) + (layer < 3 ? (layer + 1) * 6144 : 0);
    for (int row = cx.bid * 8 + w; row < SEQ; row += cx.G * 8) {
        f32x4 v[8]; float s = 0.f;
#pragma unroll
        for (int i = 0; i < 8; ++i) { v[i] = *(const f32x4*)(R + (size_t)row * DM + 256 * i + 4 * lane); s += (v[i][0] + v[i][1]) + (v[i][2] + v[i][3]); }
        s = wave_sum(s); const float mu = s * (1.0f / 2048.0f);
        float q = 0.f;
#pragma unroll
        for (int i = 0; i < 8; ++i) { const f32x4 d = v[i] - mu; q += (d[0] * d[0] + d[1] * d[1]) + (d[2] * d[2] + d[3] * d[3]); }
        q = wave_sum(q); const float rs = rsqrtf(q * (1.0f / 2048.0f) + 1e-5f);
#pragma unroll
        for (int i = 0; i < 8; ++i) {
            const int col = 256 * i + 4 * lane;
            const f32x4 y = (v[i] - mu) * rs * *(const f32x4*)(g + col) + *(const f32x4*)(b + col);
            *(f32x4*)(Xo + (size_t)row * DM + col) = y;
            if (layer < 3) { const f32x4 uv = y * (*(const f32x4*)(mod + 2048 + col) + 1.0f) + *(const f32x4*)(mod + col);
                u32x2 wv; wv.x = pk2(uv[0], uv[1]); wv.y = pk2(uv[2], uv[3]); *(u32x2*)(U + (size_t)row * DM + col) = wv; }
        }
    }
}

__device__ __forceinline__ void s5_carry(const Ctx cx, KP p, LAS unsigned char* lds) {
    const int tid = cx.tid, w = __builtin_amdgcn_readfirstlane(tid >> 6), lane = tid & 63;
    const float* E = (const float*)(p->ws + WS_ACT + ACT_E); bf16_t* UC = (bf16_t*)(p->ws + WS_ACT + ACT_UCAT); const float* LT = (const float*)(p->ws + WS_LAMT);
    LAS float* endst = (LAS float*)lds;
    for (int g = cx.bid; g < 256; g += cx.G) {
        const float lr = LT[g * 128 + lane], li = LT[g * 128 + 64 + lane];
        const float* Eg = E + ((size_t)g * 512 + 64 * w) * 128 + lane;
        float xr = 0.f, xi = 0.f;
        for (int b = 0; b < 2; ++b) {
            float er[32], ei[32];
#pragma unroll
            for (int s = 0; s < 32; ++s) { er[s] = Eg[(32 * b + s) * 128]; ei[s] = Eg[(32 * b + s) * 128 + 64]; }
#pragma unroll
            for (int s = 0; s < 32; ++s) { const float nr = lr * xr - li * xi + er[s], ni = lr * xi + li * xr + ei[s]; xr = nr; xi = ni; }
        }
        __syncthreads();
        endst[w * 128 + lane] = xr; endst[w * 128 + 64 + lane] = xi;
        float pr = lr, pi = li;
#pragma unroll
        for (int q = 0; q < 6; ++q) { const float nr = pr * pr - pi * pi, ni = 2.0f * pr * pi; pr = nr; pi = ni; }
        __syncthreads();
        float cr = 0.f, ci = 0.f;
        for (int ww = 0; ww < w; ++ww) { const float tr = pr * cr - pi * ci + endst[ww * 128 + lane], ti = pr * ci + pi * cr + endst[ww * 128 + 64 + lane]; cr = tr; ci = ti; }
        xr = cr; xi = ci;
        bf16_t* Ug = UC + ((size_t)g * 512 + 64 * w) * 384 + 256 + lane;
        for (int b = 0; b < 2; ++b) {
            float er[32], ei[32];
#pragma unroll
            for (int s = 0; s < 32; ++s) { er[s] = Eg[(32 * b + s) * 128]; ei[s] = Eg[(32 * b + s) * 128 + 64]; }
#pragma unroll
            for (int s = 0; s < 32; ++s) {
                Ug[(size_t)(32 * b + s) * 384] = (bf16_t)(pk2(xr, 0.f) & 0xffffu); Ug[(size_t)(32 * b + s) * 384 + 64] = (bf16_t)(pk2(xi, 0.f) & 0xffffu);
                const float nr = lr * xr - li * xi + er[s], ni = lr * xi + li * xr + ei[s]; xr = nr; xi = ni; }
        }
    }
}

#define XB_TMO      128
#define XB_XCNT(j)  (256  + 64 * (j))
#define XB_XSUB(j)  (1280 + 64 * (j))
#define XB_XGEN(j)  (2304 + 64 * (j))
#define XB_TOP      3328
#define XB_TOPGEN   3392
#define XCD_BAR_WORDS 3456
#define XB_SPIN_CAP (1u << 18)
__device__ __forceinline__ unsigned xb_ld(unsigned* p)              { return __hip_atomic_load(p, __ATOMIC_RELAXED, __HIP_MEMORY_SCOPE_AGENT); }
__device__ __forceinline__ unsigned xb_add(unsigned* p, unsigned v) { return __hip_atomic_fetch_add(p, v, __ATOMIC_RELAXED, __HIP_MEMORY_SCOPE_AGENT); }
__device__ __forceinline__ unsigned xb_xcc_id() { return (unsigned)__builtin_amdgcn_s_getreg((3 << 11) | 20) & 0xFu; }
#define XB_SPIN(cond, bar) do { unsigned _sp = 0; while (cond) { __builtin_amdgcn_s_sleep(1); \
    if ((++_sp & 255u) == 0u) { if (xb_ld(&(bar)[XB_TMO])) break; if (_sp > XB_SPIN_CAP) { atomicAdd(&(bar)[XB_TMO], 1u); break; } } } } while (0)
struct XcdBarrier { unsigned* bar; unsigned x; volatile LAS unsigned* st; };
__device__ __forceinline__ XcdBarrier xcd_barrier_post(unsigned* bar, volatile LAS unsigned* st) {
    XcdBarrier b; b.bar = bar; b.x = xb_xcc_id(); b.st = st;
    if (threadIdx.x == 0) (void)xb_add(&bar[XB_XCNT(b.x)], 1u);
    return b;
}
__device__ __forceinline__ void xcd_barrier_complete(unsigned* bar, unsigned x, unsigned& nloc, unsigned& nx) {
    const unsigned G = gridDim.x * gridDim.y * gridDim.z;
    unsigned sum, cnt, mine, sp = 0u;
    for (;;) {
        sum = 0u; cnt = 0u; mine = 0u;
#pragma unroll
        for (unsigned j = 0; j < 16; ++j) { const unsigned c = xb_ld(&bar[XB_XCNT(j)]); sum += c; cnt += (c > 0u) ? 1u : 0u; mine = (j == x) ? c : mine; }
        if (sum == G) break;
        __builtin_amdgcn_s_sleep(1);
        if ((++sp & 255u) == 0u) { if (xb_ld(&bar[XB_TMO])) break; if (sp > XB_SPIN_CAP) { atomicAdd(&bar[XB_TMO], 1u); break; } }
    }
    nloc = mine > 0u ? mine : 1u; nx = cnt > 0u ? cnt : 1u;
}
__device__ __forceinline__ void xcd_barrier(const XcdBarrier& b) {
    asm volatile("s_waitcnt vmcnt(0)" ::: "memory");
    __syncthreads();
    if (threadIdx.x == 0) {
        unsigned* bar = b.bar;
        __builtin_amdgcn_s_waitcnt(0);
        unsigned nloc = b.st[0], nx = b.st[1];
        if (nloc == 0u) { xcd_barrier_complete(bar, b.x, nloc, nx); b.st[0] = nloc; b.st[1] = nx; }
        const unsigned old = xb_add(&bar[XB_XSUB(b.x)], 1u);
        const unsigned gen = old / nloc;
        if (old + 1u == (gen + 1u) * nloc) {
            __builtin_amdgcn_fence(__ATOMIC_RELEASE, "agent");
            asm volatile("s_waitcnt vmcnt(0)" ::: "memory");
            const unsigned og = xb_add(&bar[XB_TOP], 1u);
            const unsigned tg = og / nx;
            if (og + 1u == (tg + 1u) * nx) xb_add(&bar[XB_TOPGEN], 1u);
            else XB_SPIN(xb_ld(&bar[XB_TOPGEN]) == tg, bar);
            __builtin_amdgcn_fence(__ATOMIC_ACQUIRE, "agent");
            xb_add(&bar[XB_XGEN(b.x)], 1u);
            asm volatile("s_waitcnt vmcnt(0)" ::: "memory");
        } else {
            XB_SPIN(xb_ld(&bar[XB_XGEN(b.x)]) == gen, bar);
            __builtin_amdgcn_fence(__ATOMIC_ACQUIRE, "agent");
            asm volatile("s_waitcnt vmcnt(0)" ::: "memory");
        }
    }
    __syncthreads();
}

__device__ __forceinline__ void run_phase(const Ctx cx, KP p, LAS unsigned char* lds, const int ph) {
    const int G = cx.G, c = cx.bid;
    if (ph == 0) { phase_prep(cx, p, lds); return; }
    if (ph == 1) { phase_mod_u0(cx, p); return; }
    const int layer = (ph - 2) / 7, q = (ph - 2) % 7;
    const int j = layer >> 1;
    const float* Xcur = (layer == 0) ? p->x : (const float*)(p->ws + WS_X);
    const float* gate = (const float*)(p->ws + WS_MOD) + layer * 6144 + 4096;
    unsigned char* act = p->ws + WS_ACT;
    if ((layer & 1) == 0) {
        if (q == 0) {
            gla_glr(cx, p, j);
            SchedGlaIn S{(const char*)(p->ws + WS_U), (const char*)(p->ws + WS_WG + (size_t)j * 10240 * DM * 2), G, c};
            EpiGlaIn E{(bf16_t*)(act + ACT_QS), (bf16_t*)(act + ACT_ZS), (bf16_t*)(act + ACT_KT), (bf16_t*)(act + ACT_Y2)};
            pg8::gemm_phase(cx, lds, DM, DM, DM, 1, S, E);
        } else if (q == 1) { gla_decay(cx, p, lds, j); if (MK_PROBE_DECAY && layer == 0) { asm volatile("" ::: "memory"); gla_decay(cx, p, lds, j); } if (layer == 2) s5_tables(cx, p, lds, 1); }
        else if (q == 2) gla_scan2<false>(cx, p, lds, j);
        else if (q == 3) gla_scan2<true>(cx, p, lds, j);
        else if (q == 4) { if (cx.G != 256) gla_rms(cx, p, lds); }
        else if (q == 5) {
            SchedPlain S{(const char*)(act + ACT_YB), (const char*)(p->ws + WS_WGO + (size_t)j * DM * DI * 2), 32, 8, G, c, (size_t)256 * DI * 2, (size_t)256 * DI * 2, 0};
            if (cx.G == 256) {
                EpiOutLn<true> E{(const float*)(act + ACT_SSQ), Xcur, (layer == 3) ? p->out : (float*)nullptr, (bf16_t*)(p->ws + WS_U), gate, p->ln_g + layer * DM, p->ln_b + layer * DM,
                           (layer < 3) ? (const float*)(p->ws + WS_MOD) + (layer + 1) * 6144 : (const float*)nullptr, (unsigned long long*)(p->ws + WS_XBUF), (unsigned*)(p->ws + WS_CNT) + layer * 2048, (const float*)(p->ws + WS_X)};
                pg8::gemm_phase(cx, lds, DI, DI, DI, 1, S, E);
            } else { EpiOut E{Xcur, (float*)(act + ACT_E), gate}; pg8::gemm_phase(cx, lds, DI, DI, DI, 1, S, E); }
        } else if (cx.G != 256) ln_phase(cx, p, layer);
    } else {
        if (q == 0) {
            SchedPlain S{(const char*)(p->ws + WS_U), (const char*)(p->ws + WS_WSI + (size_t)j * 8192 * DM * 2), 32, 32, G, c, (size_t)256 * DM * 2, (size_t)256 * DM * 2, 1};
            EpiS5In E{(bf16_t*)(act + ACT_UCAT), (bf16_t*)(act + ACT_ZS)};
            pg8::gemm_phase(cx, lds, DM, DM, DM, 1, S, E);
        } else if (q == 1) {
            if (cx.G == 256) {
                { SchedGroupLocal S{(const char*)(act + ACT_UCAT), (const char*)(p->ws + WS_WE), (size_t)512 * 384 * 2, (size_t)128 * 256 * 2, (size_t)256 * 384 * 2, cx.bid};
                  EpiS5E E{(float*)(act + ACT_E)};
                  pg8::gemm_phase(cx, lds, 256, 384, 256, 0, S, E); }
                asm volatile("s_waitcnt vmcnt(0)" ::: "memory"); __syncthreads();
                s5_carry(cx, p, lds);
                asm volatile("s_waitcnt vmcnt(0)" ::: "memory"); __syncthreads();
                { SchedGroupLocal S{(const char*)(act + ACT_UCAT), (const char*)(p->ws + WS_MG), (size_t)512 * 384 * 2, (size_t)256 * 384 * 2, (size_t)256 * 384 * 2, cx.bid};
                  EpiS5Y E{(const bf16_t*)(act + ACT_UCAT), (bf16_t*)(act + ACT_YB), p->s5_d + (size_t)j * DI};
                  pg8::gemm_phase(cx, lds, 384, 384, 384, 1, S, E); }
            } else {
                SchedGroup S{(const char*)(act + ACT_UCAT), (const char*)(p->ws + WS_WE), (size_t)512 * 384 * 2, (size_t)128 * 256 * 2, (size_t)256 * 384 * 2, G, c};
                EpiS5E E{(float*)(act + ACT_E)};
                pg8::gemm_phase(cx, lds, 256, 384, 256, 0, S, E);
            }
        } else if (q == 2) { if (cx.G != 256) s5_carry(cx, p, lds); }
        else if (q == 3) {
            if (cx.G != 256) {
                SchedGroup S{(const char*)(act + ACT_UCAT), (const char*)(p->ws + WS_MG), (size_t)512 * 384 * 2, (size_t)256 * 384 * 2, (size_t)256 * 384 * 2, G, c};
                EpiS5Y E{(const bf16_t*)(act + ACT_UCAT), (bf16_t*)(act + ACT_YB), p->s5_d + (size_t)j * DI};
                pg8::gemm_phase(cx, lds, 384, 384, 384, 1, S, E);
            }
        } else if (q == 4) {
            SchedPlain S{(const char*)(act + ACT_YB), (const char*)(p->ws + WS_WGLU + (size_t)j * DI * DI * 2), 32, 16, G, c, (size_t)256 * DI * 2, (size_t)256 * DI * 2, 0};
            EpiGlu E{(const bf16_t*)(act + ACT_YB), (const bf16_t*)(act + ACT_ZS), (bf16_t*)(act + ACT_Y2), p->s5_b_glu + (size_t)j * DI};
            pg8::gemm_phase<EpiGlu, SchedPlain, MK_KREP_GLU>(cx, lds, DI, DI, DI, 1, S, E);
        } else if (q == 5) {
            SchedPlain S{(const char*)(act + ACT_Y2), (const char*)(p->ws + WS_WSO + (size_t)j * DM * DI * 2), 32, 8, G, c, (size_t)256 * DI * 2, (size_t)256 * DI * 2, 0};
            if (cx.G == 256) {
                EpiOutLn<false> E{(const float*)nullptr, Xcur, (layer == 3) ? p->out : (float*)nullptr, (bf16_t*)(p->ws + WS_U), gate, p->ln_g + layer * DM, p->ln_b + layer * DM,
                           (layer < 3) ? (const float*)(p->ws + WS_MOD) + (layer + 1) * 6144 : (const float*)nullptr, (unsigned long long*)(p->ws + WS_XBUF), (unsigned*)(p->ws + WS_CNT) + layer * 2048, (const float*)(p->ws + WS_X)};
                pg8::gemm_phase(cx, lds, DI, DI, DI, 1, S, E);
            } else { EpiOut E{Xcur, (float*)(act + ACT_E), gate}; pg8::gemm_phase(cx, lds, DI, DI, DI, 1, S, E); }
        } else if (cx.G != 256) ln_phase(cx, p, layer);
    }
}

__global__ void __launch_bounds__(NT, 2) fwd_megakernel(Params p_unused) {
    extern __shared__ __attribute__((aligned(16))) unsigned char lds_raw[];
    LAS unsigned char* lds = (LAS unsigned char*)lds_raw;
    KP kp0 = (KP)__builtin_amdgcn_kernarg_segment_ptr();
    const int ph_lo = kp0->ph_lo, ph_hi = kp0->ph_hi, coop = kp0->coop;
    XcdBarrier bar; bar.bar = (unsigned*)(kp0->ws + WS_BAR); bar.x = 0; bar.st = (volatile LAS unsigned*)(lds + LDS_STAGE);
    if (coop) { if (threadIdx.x < 4) ((LAS unsigned*)(lds + LDS_STAGE))[threadIdx.x] = 0u; __syncthreads(); bar = xcd_barrier_post((unsigned*)(kp0->ws + WS_BAR), (volatile LAS unsigned*)(lds + LDS_STAGE)); }
    for (int ph = ph_lo; ph < ph_hi; ++ph) {
        if (gridDim.x == 256 && ph >= 2 && ((ph - 2) % 7 == 6 || ((ph - 2) % 7 == 4 && (((ph - 2) / 7) & 1) == 0) || (((ph - 2) % 7 == 2 || (ph - 2) % 7 == 3) && (((ph - 2) / 7) & 1) == 1))) continue;
#if MK_REPEAT_MASK
        for (int rep = 0; rep < ((MK_REPEAT_MASK >> ph) & 1) + 1; ++rep)
#endif
        {
            KP kp = kp0; asm volatile("" : "+s"(kp));
            Ctx cx; cx.tid = threadIdx.x; cx.bid = blockIdx.x; cx.G = gridDim.x;
            asm volatile("" : "+v"(cx.tid)); asm volatile("" : "+s"(cx.bid)); asm volatile("" : "+s"(cx.G));
            run_phase(cx, kp, lds, ph);
        }
        if (coop && ph + 1 < ph_hi) { if (coop == 2) cg::this_grid().sync(); else xcd_barrier(bar); }
    }
}

#ifndef MK_ONE_LAUNCH
#define MK_ONE_LAUNCH 1
#endif

extern "C" void kernel_launch(void* const* d_in, const int* in_sizes, int n_in, void* d_out, int out_size, void* d_ws, size_t ws_size, hipStream_t stream) {
    static int grid = 0;
    if (grid == 0) {
        if (n_in != 23 || ws_size < WS_END) { fprintf(stderr, "kernel_launch: need 23 inputs and %zu bytes of workspace, got %d / %zu\n", (size_t)WS_END, n_in, ws_size); grid = -1; return; }
        int dev = 0, cus = 0, per_cu = 0;
        hipGetDevice(&dev); hipDeviceGetAttribute(&cus, hipDeviceAttributeMultiprocessorCount, dev);
        if (hipFuncSetAttribute((const void*)fwd_megakernel, hipFuncAttributeMaxDynamicSharedMemorySize, LDS_BYTES) != hipSuccess) { fprintf(stderr, "kernel_launch: hipFuncSetAttribute failed\n"); grid = -1; return; }
        if (hipOccupancyMaxActiveBlocksPerMultiprocessor(&per_cu, (const void*)fwd_megakernel, NT, LDS_BYTES) != hipSuccess || per_cu < 1) { fprintf(stderr, "kernel_launch: occupancy query gave %d\n", per_cu); per_cu = 1; }
        (void)hipGetLastError();
        grid = cus;
    }
    if (grid < 0) return;
    Params hp{};
    const float** pp = (const float**)&hp;
    for (int i = 0; i < 23; ++i) pp[i] = (const float*)d_in[i];
    hp.out = (float*)d_out; hp.ws = (unsigned char*)d_ws; hp.pad = 0;
#if MK_ONE_LAUNCH
    if (hipMemsetAsync((char*)d_ws + WS_BAR, 0, 16384 + 32768, stream) != hipSuccess) { fprintf(stderr, "kernel_launch: memset of the barrier words failed\n"); return; }
    hp.ph_lo = 0; hp.ph_hi = NPH; hp.coop = 1;
    void* args[] = {&hp};
    hipError_t e = hipLaunchCooperativeKernel((const void*)fwd_megakernel, dim3(grid), dim3(NT), args, LDS_BYTES, stream);
    if (e != hipSuccess) fprintf(stderr, "cooperative launch failed: %s (grid %d)\n", hipGetErrorString(e), grid);
#else
    hp.coop = 0;
    for (int ph = 0; ph < NPH; ++ph) { hp.ph_lo = ph; hp.ph_hi = ph + 1; hipLaunchKernelGGL(fwd_megakernel, dim3(grid), dim3(NT), LDS_BYTES, stream, hp); }
#endif
}
```
